# Optimizing an MI355X kernel written in HIP

```python
import math
import jax, jax.numpy as jnp
from jax import lax
import numpy as np

D_MODEL = 4096
BATCH = 4
SEQ = 2048
DEPTH = 1
DEC_BATCH = 128
DEC_SEQ = 4
PAST_LEN = 16384
PAGE_SIZE = 128

D_MIX = 2 * D_MODEL
D_M = D_MIX // 2
D_S = D_MIX - D_M
M_HEADS = 8
M_HEAD_IN = D_M // M_HEADS
M_V_DIM = D_M // M_HEADS
M_QK_DIM = M_V_DIM // 2
S_HEAD_DIM = 64
S_HEADS = D_S // S_HEAD_DIM
S_STATE = 128
S_GROUPS = 8
S_HPG = S_HEADS // S_GROUPS
CONV_DIM = D_S + 2 * S_GROUPS * S_STATE
CONV_K = 4
CHUNK = 64
PLE_DIM = 256
GATE_CAP = 15.0
EPS = 1e-6
IN_SIZES = (D_M, D_M, D_M, D_M, M_HEADS, M_HEADS, D_S, CONV_DIM, S_HEADS)
IN_COLS = 4 * D_M + 2 * M_HEADS + D_S + CONV_DIM + S_HEADS

kernel_name = "hybrid_mlstm_ssd_decode_step"


def _rmsnorm(x, g):
    xf = x.astype(jnp.float32)
    y = xf * lax.rsqrt(jnp.mean(xf * xf, axis=-1, keepdims=True) + EPS)
    return (y * g.astype(jnp.float32)).astype(x.dtype)


def _softcap(x):
    return GATE_CAP * jnp.tanh(x / GATE_CAP)


def _causal_conv(u, buf, w, b):
    L = u.shape[1]
    full = jnp.concatenate([buf.astype(u.dtype), u], axis=1)
    y = b
    for j in range(CONV_K):
        y = y + full[:, j:j + L] * w[j]
    return y, full[:, full.shape[1] - (CONV_K - 1):]


def _to_chunks(t, nc, c):
    return jnp.moveaxis(t.reshape(t.shape[0], nc, c, *t.shape[2:]), 1, 0)


def _mlstm(q, k, v, ig, lf, C0, n0, m0):
    bsz, L = q.shape[:2]
    c = math.gcd(L, CHUNK)
    nc = L // c
    causal = jnp.tril(jnp.ones((c, c), dtype=bool))

    def step(carry, inp):
        C, n, m = carry
        qc, kc, vc, igc, lfc = inp
        b = jnp.cumsum(lfc, axis=1)
        dmat = jnp.where(causal[None, :, :, None],
                         b[:, :, None, :] - b[:, None, :, :] + igc[:, None, :, :], -jnp.inf)
        inter = b + m[:, None, :]
        m_t = jnp.maximum(inter, jnp.max(dmat, axis=2))
        w = jnp.exp(dmat - m_t[:, :, None, :])
        a_inter = jnp.exp(inter - m_t)
        s = jnp.einsum('bthd,bshd->btsh', qc, kc) * w
        num = jnp.einsum('btsh,bshv->bthv', s, vc) + a_inter[..., None] * jnp.einsum('bthd,bhdv->bthv', qc, C)
        den = jnp.sum(s, axis=2) + a_inter * jnp.einsum('bthd,bhd->bth', qc, n)
        h = num / jnp.maximum(jnp.abs(den), jnp.exp(-m_t))[..., None]
        b_end = b[:, -1]
        lw = b_end[:, None, :] - b + igc
        m_new = jnp.maximum(b_end + m, jnp.max(lw, axis=1))
        wk = jnp.exp(lw - m_new[:, None, :])
        decay = jnp.exp(b_end + m - m_new)
        C_new = decay[..., None, None] * C + jnp.einsum('bsh,bshd,bshv->bhdv', wk, kc, vc)
        n_new = decay[..., None] * n + jnp.einsum('bsh,bshd->bhd', wk, kc)
        return (C_new, n_new, m_new), h

    f32 = jnp.float32
    xs = tuple(_to_chunks(t.astype(f32), nc, c) for t in (q, k, v, ig, lf))
    (C, n, m), h = lax.scan(step, (C0.astype(f32), n0.astype(f32), m0.astype(f32)), xs)
    return jnp.moveaxis(h, 0, 1).reshape(bsz, L, M_HEADS, M_V_DIM), C, n, m


def _ssd(x, dt, la, bm, cm, h0):
    bsz, L = x.shape[:2]
    c = math.gcd(L, CHUNK)
    nc = L // c
    causal = jnp.tril(jnp.ones((c, c), dtype=bool))

    def step(h, inp):
        xc, dtc, lac, bc, cc = inp
        a = jnp.cumsum(lac, axis=1)
        decay = jnp.exp(jnp.where(causal[None, :, :, None, None], a[:, :, None] - a[:, None], -jnp.inf))
        xdt = xc * dtc[..., None]
        cb = jnp.einsum('btgn,bsgn->btsg', cc, bc)
        y = (jnp.einsum('btsg,btsgr,bsgrp->btgrp', cb, decay, xdt)
             + jnp.exp(a)[..., None] * jnp.einsum('btgn,bgrpn->btgrp', cc, h))
        a_end = a[:, -1]
        h_new = (jnp.exp(a_end)[..., None, None] * h
                 + jnp.einsum('bsgr,bsgrp,bsgn->bgrpn', jnp.exp(a_end[:, None] - a), xdt, bc))
        return h_new, y

    f32 = jnp.float32
    xs = tuple(_to_chunks(t.astype(f32), nc, c) for t in (x, dt, la, bm, cm))
    h, y = lax.scan(step, h0.astype(f32), xs)
    return jnp.moveaxis(y, 0, 1).reshape(bsz, L, S_GROUPS, S_HPG, S_HEAD_DIM), h


def _layer(x, p, m_conv0, m_C0, m_n0, m_m0, s_conv0, s_h0, w):
    (norm_in, w_in, b_ig, b_fg, m_conv_w, m_conv_b, w_q, w_k, m_norm,
     s_conv_w, s_conv_b, dt_bias, a_log, d_skip, s_norm, w_out, ple_proj, ple_gate, ple_norm) = w
    bsz, L, _ = x.shape
    f32 = jnp.float32
    xn = _rmsnorm(x, norm_in)
    proj = xn @ w_in
    u_m, v_m, o_m, z_m, ig, fg, z_s, xbc, dt = jnp.split(proj, np.cumsum(IN_SIZES)[:-1].tolist(), axis=-1)

    uc, m_conv1 = _causal_conv(u_m, m_conv0, m_conv_w, m_conv_b)
    uc = jax.nn.silu(uc).reshape(bsz, L, M_HEADS, M_HEAD_IN)
    q = jnp.einsum('blhe,hed->blhd', uc, w_q)
    k = jnp.einsum('blhe,hed->blhd', uc, w_k) * (M_QK_DIM ** -0.5)
    v = v_m.reshape(bsz, L, M_HEADS, M_V_DIM)
    ig = _softcap(ig.astype(f32) + b_ig)
    lf = jax.nn.log_sigmoid(_softcap(fg.astype(f32) + b_fg))
    hm, m_C1, m_n1, m_m1 = _mlstm(q, k, v, ig, lf, m_C0, m_n0, m_m0)
    hm = jax.nn.sigmoid(o_m.astype(f32)).reshape(bsz, L, M_HEADS, M_V_DIM) * hm
    hm = _rmsnorm(hm, m_norm.reshape(M_HEADS, M_V_DIM)).reshape(bsz, L, D_M).astype(x.dtype)
    hm = hm * jax.nn.silu(z_m)

    xc, s_conv1 = _causal_conv(xbc, s_conv0, s_conv_w, s_conv_b)
    xc = jax.nn.silu(xc)
    xs, bm, cm = jnp.split(xc, [D_S, D_S + S_GROUPS * S_STATE], axis=-1)
    xs = xs.reshape(bsz, L, S_GROUPS, S_HPG, S_HEAD_DIM).astype(f32)
    bm = bm.reshape(bsz, L, S_GROUPS, S_STATE)
    cm = cm.reshape(bsz, L, S_GROUPS, S_STATE)
    dt = jax.nn.softplus(dt.astype(f32) + dt_bias).reshape(bsz, L, S_GROUPS, S_HPG)
    a = -jnp.exp(a_log.astype(f32)).reshape(S_GROUPS, S_HPG)
    ys, s_h1 = _ssd(xs, dt, dt * a, bm, cm, s_h0.reshape(bsz, S_GROUPS, S_HPG, S_HEAD_DIM, S_STATE))
    ys = ys + d_skip.astype(f32).reshape(S_GROUPS, S_HPG, 1) * xs
    ys = ys.reshape(bsz, L, D_S).astype(x.dtype) * jax.nn.silu(z_s)
    ys = _rmsnorm(ys.reshape(bsz, L, S_GROUPS, D_S // S_GROUPS),
                  s_norm.reshape(S_GROUPS, D_S // S_GROUPS)).reshape(bsz, L, D_S)

    x = x + jnp.concatenate([hm, ys], axis=-1) @ w_out
    gate = jax.nn.sigmoid(_rmsnorm(x, ple_norm) @ ple_gate)
    x = x + gate * (p.astype(x.dtype) @ ple_proj)
    return x, (m_C1, m_n1, m_m1, m_conv1, s_h1.reshape(bsz, S_HEADS, S_HEAD_DIM, S_STATE), s_conv1)


def setup_inputs(seed: int = 0) -> dict:
    key = jax.random.key(seed)
    ks = jax.random.split(key, 32)
    nrm = jax.random.normal
    f32 = jnp.float32
    dt0 = jnp.exp(jax.random.uniform(ks[20], (DEPTH, S_HEADS), f32, math.log(1e-3), math.log(1e-1)))
    return {
        "x_prompt": nrm(ks[0], (BATCH, SEQ, D_MODEL), f32),
        "x_sample": nrm(ks[1], (DEC_BATCH, DEC_SEQ, D_MODEL), f32),
        "p_prompt": nrm(ks[2], (DEPTH, BATCH, SEQ, PLE_DIM), f32),
        "p_sample": nrm(ks[3], (DEPTH, DEC_BATCH, DEC_SEQ, PLE_DIM), f32),
        "state_m_C": 0.05 * nrm(ks[4], (DEPTH, DEC_BATCH, M_HEADS, M_QK_DIM, M_V_DIM), f32),
        "state_m_n": 0.05 * nrm(ks[5], (DEPTH, DEC_BATCH, M_HEADS, M_QK_DIM), f32),
        "state_m_m": nrm(ks[6], (DEPTH, DEC_BATCH, M_HEADS), f32),
        "state_m_conv": nrm(ks[7], (DEPTH, DEC_BATCH, CONV_K - 1, D_M), f32),
        "state_s_ssm": 0.1 * nrm(ks[8], (DEPTH, DEC_BATCH, S_HEADS, S_HEAD_DIM, S_STATE), f32),
        "state_s_conv": nrm(ks[9], (DEPTH, DEC_BATCH, CONV_K - 1, CONV_DIM), f32),
        "norm_in": 1.0 + 0.02 * nrm(ks[10], (DEPTH, D_MODEL), f32),
        "w_in": nrm(ks[11], (DEPTH, D_MODEL, IN_COLS), f32) * D_MODEL ** -0.5,
        "b_ig": -1.0 + 0.5 * nrm(ks[12], (DEPTH, M_HEADS), f32),
        "b_fg": 3.0 + 0.5 * nrm(ks[13], (DEPTH, M_HEADS), f32),
        "m_conv_w": 0.5 * nrm(ks[14], (DEPTH, CONV_K, D_M), f32),
        "m_conv_b": 0.02 * nrm(ks[15], (DEPTH, D_M), f32),
        "w_q": nrm(ks[16], (DEPTH, M_HEADS, M_HEAD_IN, M_QK_DIM), f32) * M_HEAD_IN ** -0.5,
        "w_k": nrm(ks[17], (DEPTH, M_HEADS, M_HEAD_IN, M_QK_DIM), f32) * M_HEAD_IN ** -0.5,
        "m_norm": 1.0 + 0.02 * nrm(ks[18], (DEPTH, D_M), f32),
        "s_conv_w": 0.5 * nrm(ks[19], (DEPTH, CONV_K, CONV_DIM), f32),
        "s_conv_b": 0.02 * nrm(ks[21], (DEPTH, CONV_DIM), f32),
        "dt_bias": dt0 + jnp.log(-jnp.expm1(-dt0)),
        "a_log": jnp.log(jax.random.uniform(ks[22], (DEPTH, S_HEADS), f32, 1.0, 16.0)),
        "d_skip": 1.0 + 0.1 * nrm(ks[23], (DEPTH, S_HEADS), f32),
        "s_norm": 1.0 + 0.02 * nrm(ks[24], (DEPTH, D_S), f32),
        "w_out": nrm(ks[25], (DEPTH, D_MIX, D_MODEL), f32) * D_MIX ** -0.5,
        "ple_proj": nrm(ks[26], (DEPTH, PLE_DIM, D_MODEL), f32) * PLE_DIM ** -0.5,
        "ple_gate": nrm(ks[27], (DEPTH, D_MODEL, D_MODEL), f32) * D_MODEL ** -0.5,
        "ple_norm": 1.0 + 0.02 * nrm(ks[28], (DEPTH, D_MODEL), f32),
        "final_norm": 1.0 + 0.02 * nrm(ks[29], (D_MODEL,), f32),
    }


def reference(x_prompt, x_sample, p_prompt, p_sample, state_m_C, state_m_n, state_m_m, state_m_conv,
              state_s_ssm, state_s_conv, norm_in, w_in, b_ig, b_fg, m_conv_w, m_conv_b, w_q, w_k, m_norm,
              s_conv_w, s_conv_b, dt_bias, a_log, d_skip, s_norm, w_out, ple_proj, ple_gate, ple_norm,
              final_norm):
    f32 = jnp.float32
    bp = x_prompt.shape[0]
    yp, ysm = x_prompt, x_sample
    new_p = [[] for _ in range(6)]
    new_s = [[] for _ in range(6)]
    for i in range(DEPTH):
        w = (norm_in[i], w_in[i], b_ig[i], b_fg[i], m_conv_w[i], m_conv_b[i], w_q[i], w_k[i], m_norm[i],
             s_conv_w[i], s_conv_b[i], dt_bias[i], a_log[i], d_skip[i], s_norm[i], w_out[i],
             ple_proj[i], ple_gate[i], ple_norm[i])
        yp, sp = _layer(yp, p_prompt[i],
                        jnp.zeros((bp, CONV_K - 1, D_M), x_prompt.dtype),
                        jnp.zeros((bp, M_HEADS, M_QK_DIM, M_V_DIM), f32),
                        jnp.zeros((bp, M_HEADS, M_QK_DIM), f32),
                        jnp.full((bp, M_HEADS), -jnp.inf, f32),
                        jnp.zeros((bp, CONV_K - 1, CONV_DIM), x_prompt.dtype),
                        jnp.zeros((bp, S_HEADS, S_HEAD_DIM, S_STATE), f32), w)
        ysm, ss = _layer(ysm, p_sample[i], state_m_conv[i], state_m_C[i], state_m_n[i], state_m_m[i],
                         state_s_conv[i], state_s_ssm[i], w)
        for lst, st in zip(new_p, sp):
            lst.append(st)
        for lst, st in zip(new_s, ss):
            lst.append(st)
    y_prompt = _rmsnorm(yp, final_norm)
    y_sample = _rmsnorm(ysm, final_norm)
    p_C, p_n, p_m, p_mconv, p_ssm, p_sconv = (jnp.stack(l) for l in new_p)
    s_C, s_n, s_m, s_mconv, s_ssm, s_sconv = (jnp.stack(l) for l in new_s)
    return (y_prompt, y_sample, p_C, p_n, p_m, p_mconv, p_ssm, p_sconv, s_C, s_n, s_m, s_mconv, s_ssm, s_sconv)
```

```cpp
#include <hip/hip_runtime.h>
#include <cstdio>

#ifndef MK_N_LAUNCHES
#define MK_N_LAUNCHES 1
#endif

#define GAS __attribute__((address_space(1)))
#define LAS __attribute__((address_space(3)))
typedef unsigned short bf16;
typedef unsigned v4u __attribute__((ext_vector_type(4)));
typedef unsigned v2u __attribute__((ext_vector_type(2)));
typedef float f32x4 __attribute__((ext_vector_type(4)));
typedef float f32x2 __attribute__((ext_vector_type(2)));
typedef short bf16x8 __attribute__((ext_vector_type(8)));

constexpr int NWAVES = 8, NTHREADS = 512;
constexpr int MTOK = 8704, MPR = 8192, DM = 4096, SEQ = 2048;
constexpr int NPROJ = 26624, NW1 = 26880, INCOLS = 26704;
constexpr float EPS = 1e-6f;
enum { I_XP = 0, I_XS, I_PP, I_PS, I_MC, I_MN, I_MM, I_MCONV, I_SSSM, I_SCONV, I_NORMIN, I_WIN, I_BIG, I_BFG, I_MCW, I_MCB, I_WQ, I_WK, I_MNORM,
       I_SCW, I_SCB, I_DTB, I_ALOG, I_DSKIP, I_SNORM, I_WOUT, I_PLEPROJ, I_PLEGATE, I_PLENORM, I_FNORM, N_IN };
constexpr size_t O_Y = 0, O_PC = 35651584, O_PN = 39845888, O_PM = 39854080, O_PMCONV = 39854112, O_PSSM = 39903264, O_PSCONV = 42000416,
                 O_SC = 42074144, O_SN = 176291872, O_SM = 176554016, O_SMCONV = 176555040, O_SSSM = 178127904, O_SSCONV = 245236768, O_END = 247596064;
constexpr size_t MiB = 1u << 20;
constexpr size_t WS_CTL = 0, CTL_ZERO_BYTES = 4 * MiB;
constexpr size_t WS_NRM = 1 * MiB, WS_RS1 = 2 * MiB, WS_RS2 = 2 * MiB + 65536;
constexpr size_t WS_W1T = 4 * MiB, WS_W2T = 214 * MiB, WS_WGT = 278 * MiB, WS_WPT = 310 * MiB, WS_WQK = 312 * MiB, WS_XN = 316 * MiB, WS_PB = 384 * MiB,
                 WS_PROJ = 389 * MiB, WS_GATES = 831 * MiB, WS_UC = 840 * MiB, WS_QK = 908 * MiB, WS_XBC = 976 * MiB, WS_MG = 1078 * MiB, WS_SG = 1080 * MiB,
                 WS_MIX = 1085 * MiB, WS_X1 = 1221 * MiB, WS_X1G = 1357 * MiB, WS_PPB = 1425 * MiB, WS_END = 1493 * MiB;
constexpr int CW_TMO = 0, CW_BAR = 4096;
constexpr int LDSCTL_OFF = 131072, LDS_BYTES = 147456;

__device__ __forceinline__ unsigned f2bf(float f) { unsigned u = __builtin_bit_cast(unsigned, f); return (u + 0x7fffu + ((u >> 16) & 1u)) >> 16; }
__device__ __forceinline__ unsigned pk2(float lo, float hi) { unsigned r; asm volatile("v_cvt_pk_bf16_f32 %0, %1, %2" : "=v"(r) : "v"(lo), "v"(hi)); return r; }
__device__ __forceinline__ float bflo(unsigned w) { return __builtin_bit_cast(float, w << 16); }
__device__ __forceinline__ float bfhi(unsigned w) { return __builtin_bit_cast(float, w & 0xffff0000u); }
__device__ __forceinline__ float bf2f(bf16 b) { return __builtin_bit_cast(float, (unsigned)b << 16); }
__device__ __forceinline__ float sigm(float x) { return 1.f / (1.f + __expf(-x)); }
__device__ __forceinline__ float silu(float x) { return x / (1.f + __expf(-x)); }
__device__ __forceinline__ float softplus(float x) { return fmaxf(x, 0.f) + log1pf(__expf(-fabsf(x))); }
__device__ __forceinline__ float softcap(float x) { return 15.f * tanhf(x * (1.f / 15.f)); }
__device__ __forceinline__ float wave_sum(float v) {
#pragma unroll
    for (int o = 1; o < 64; o <<= 1) v += __shfl_xor(v, o);
    return v;
}
#define LDS_WAIT() asm volatile("s_waitcnt lgkmcnt(0)" ::: "memory")

namespace pg8 {
constexpr int BM = 256, BK = 64, HALF = 128, HTB = HALF * BK * 2, STAGE_BYTES = 8 * HTB, NXCD = 8, WGM = 8;
__host__ __device__ __forceinline__ int lds_byte(int r, int c) { const int st = (r >> 4) * 2 + (c >> 5), rr = r & 15, cc = c & 31, ob = rr * 64 + cc * 2; return st * 1024 + (ob ^ (((ob >> 9) & 1) << 5)); }
__host__ __device__ __forceinline__ void stage_rc(int b, int& R, int& C) { const int st = b / 1024, sb = b % 1024, swz = sb ^ (((sb >> 9) & 1) << 5); R = (st >> 1) * 16 + swz / 64; C = (st & 1) * 32 + (swz % 64) / 2; }
__host__ __device__ __forceinline__ int perm32(int rho) { const int n = rho >> 4, i = rho & 15; return 8 * (i >> 2) + 4 * n + (i & 3); }
struct Unit { int pm, pn; };
struct Gemm { const bf16* A; const bf16* Bt; int lda, ldb, K; };
struct Order {
    int nM, nN, nwg, G, c, kshift, kmul;
    __device__ void init(int nM_, int nN_, int G_, int c_, int kshift_ = 0, int kmul_ = 0) { nM = nM_; nN = nN_; nwg = nM * nN; G = G_; c = c_; kshift = kshift_; kmul = kmul_; }
    __device__ bool next(int i, Unit& u) const {
        const long L = (long)i * G + c; if (L >= nwg) return false;
        int wgid = (int)L; { const int q = nwg / NXCD, r = nwg % NXCD, xcd = wgid % NXCD, off = wgid / NXCD; wgid = (xcd < r ? xcd * (q + 1) : r * (q + 1) + (xcd - r) * q) + off; }
        const int nig = WGM * nN, gid = wgid / nig, fm = gid * WGM, gsz = (nM - fm) < WGM ? (nM - fm) : WGM;
        u.pm = fm + ((wgid % nig) % gsz); u.pn = (wgid % nig) / gsz; return true;
    }
    __device__ __forceinline__ int a_koff(const Unit& u) const { return (u.pn >> kshift) * kmul; }
    __device__ __forceinline__ void a_ready(const Unit&) const {}
    __device__ __forceinline__ void done(const Unit&) const {}
};

template <class Epi, class Sched, bool ALIGN_EPI = true>
__device__ __forceinline__ void gemm_phase(LAS unsigned char* lds, const Gemm g, const Sched& S, const Epi& E) {
    const int tid = threadIdx.x, wid = __builtin_amdgcn_readfirstlane(tid >> 6), lane = tid & 63, wr = wid >> 2, wc = wid & 3, fr = lane & 15, fq = lane >> 4;
    const int K = g.K, nt = K / BK;
    unsigned voffA[2], voffB[2];
#pragma unroll
    for (int i = 0; i < 2; ++i) { int R, C; stage_rc(tid * 16 + i * 8192, R, C); const int Rb = Epi::PERM ? ((R & ~31) + perm32(R & 31)) : R;
        voffA[i] = (unsigned)(R * g.lda + C) * 2u; voffB[i] = (unsigned)(Rb * g.ldb + C) * 2u; }
    const size_t kstep = (size_t)(BK * 2);
    const size_t hstepA = (size_t)HALF * g.lda * 2, hstepB = (size_t)HALF * g.ldb * 2;
    const size_t tstepA = 2 * hstepA, tstepB = 2 * hstepB;
    const unsigned ldsw = (unsigned)wid * 1024u;
    const int aoff = lds_byte(wr * 64 + fr, fq * 8), boff = lds_byte(wc * 32 + fr, fq * 8);
#define PG8_SA(b, h) (((b) * 2 + (h)) * HTB)
#define PG8_SB(b, h) ((4 + (b) * 2 + (h)) * HTB)
#define PG8_STAGE(bufoff, gbase, voff) do { _Pragma("unroll") for (int _i = 0; _i < 2; ++_i) \
        __builtin_amdgcn_global_load_lds((const unsigned*)((const char*)(gbase) + (voff)[_i]), (LAS unsigned*)(lds + (bufoff) + ldsw + _i * 8192), 16, 0, 0); } while (0)
#define PG8_LDA(dst, b, h) do { _Pragma("unroll") for (int m = 0; m < 4; ++m) _Pragma("unroll") for (int k = 0; k < 2; ++k) dst[m][k] = *(const LAS bf16x8*)(lds + PG8_SA(b, h) + aoff + m * 2048 + k * 1024); } while (0)
#define PG8_LDB(dst, b, h) do { _Pragma("unroll") for (int n = 0; n < 2; ++n) _Pragma("unroll") for (int k = 0; k < 2; ++k) dst[n][k] = *(const LAS bf16x8*)(lds + PG8_SB(b, h) + boff + n * 2048 + k * 1024); } while (0)
#define PG8_MMA(ai, bj, At, Bt) do { __builtin_amdgcn_s_setprio(1); _Pragma("unroll") for (int m = 0; m < 4; ++m) _Pragma("unroll") for (int n = 0; n < 2; ++n) _Pragma("unroll") for (int k = 0; k < 2; ++k) \
        acc[ai][bj][m][n] = __builtin_amdgcn_mfma_f32_16x16x32_bf16(Bt[n][k], At[m][k], acc[ai][bj][m][n], 0, 0, 0); __builtin_amdgcn_s_setprio(0); } while (0)
#define PG8_WAIT_V(n) asm volatile("s_waitcnt vmcnt(" #n ")" ::: "memory")
#define PG8_WAIT_L(n) asm volatile("s_waitcnt lgkmcnt(" #n ")" ::: "memory")
#define PG8_BAR __builtin_amdgcn_s_barrier()
#define PG8_SCHED __builtin_amdgcn_sched_barrier(0)
    Unit cur, nxt; int ui = 0;
    if (!S.next(0, cur)) return;
    f32x4 acc[2][2][4][2];
#pragma unroll
    for (int a = 0; a < 2; ++a)
#pragma unroll
        for (int b = 0; b < 2; ++b)
#pragma unroll
            for (int m = 0; m < 4; ++m)
#pragma unroll
                for (int n = 0; n < 2; ++n) acc[a][b][m][n] = (f32x4){0.f, 0.f, 0.f, 0.f};
    bf16x8 At[4][2], B0[2][2], B1[2][2];
    const char* cA = (const char*)g.A + (size_t)cur.pm * tstepA + (size_t)S.a_koff(cur) * 2; const char* cB = (const char*)g.Bt + (size_t)cur.pn * tstepB;
    S.a_ready(cur);
    PG8_STAGE(PG8_SB(0, 0), cB, voffB); PG8_STAGE(PG8_SB(0, 1), cB + hstepB, voffB); PG8_STAGE(PG8_SA(0, 0), cA, voffA); PG8_STAGE(PG8_SA(0, 1), cA + hstepA, voffA);
    if (wr == 1) PG8_BAR;
    PG8_WAIT_V(2); PG8_BAR;
    PG8_STAGE(PG8_SB(1, 0), cB + kstep, voffB); PG8_STAGE(PG8_SA(1, 0), cA + kstep, voffA); PG8_STAGE(PG8_SB(1, 1), cB + hstepB + kstep, voffB);
    PG8_WAIT_V(6); PG8_BAR;
    for (;;) {
        const bool has_next = S.next(ui + 1, nxt);
        const char* nA = has_next ? (const char*)g.A + (size_t)nxt.pm * tstepA + (size_t)S.a_koff(nxt) * 2 : cA; const char* nB = has_next ? (const char*)g.Bt + (size_t)nxt.pn * tstepB : cB;
        for (int t = 0; t < nt; t += 2) {
            const bool last = (t == nt - 2);
            const char* a1 = cA + (size_t)(t + 1) * kstep;
            const char* a2 = last ? nA : cA + (size_t)(t + 2) * kstep; const char* b2 = last ? nB : cB + (size_t)(t + 2) * kstep;
            const char* a3 = a2 + kstep; const char* b3 = b2 + kstep;
            if (last && has_next) S.a_ready(nxt);
            PG8_LDB(B0, 0, 0); PG8_LDB(B1, 0, 1); PG8_SCHED; PG8_LDA(At, 0, 0); PG8_STAGE(PG8_SA(1, 1), a1 + hstepA, voffA);
            PG8_WAIT_V(8); PG8_WAIT_L(0); PG8_BAR; PG8_MMA(0, 0, At, B0); PG8_MMA(0, 1, At, B1); PG8_BAR; PG8_SCHED;
            PG8_LDA(At, 0, 1); PG8_STAGE(PG8_SB(0, 0), b2, voffB); PG8_STAGE(PG8_SB(0, 1), b2 + hstepB, voffB); PG8_STAGE(PG8_SA(0, 0), a2, voffA);
            PG8_WAIT_V(8); PG8_WAIT_L(0); PG8_BAR; PG8_MMA(1, 0, At, B0); PG8_MMA(1, 1, At, B1); PG8_BAR; PG8_SCHED;
            PG8_LDB(B0, 1, 0); PG8_LDB(B1, 1, 1); PG8_SCHED; PG8_LDA(At, 1, 0); PG8_STAGE(PG8_SA(0, 1), a2 + hstepA, voffA);
            PG8_WAIT_V(8); PG8_WAIT_L(0); PG8_BAR; PG8_MMA(0, 0, At, B0); PG8_MMA(0, 1, At, B1); PG8_BAR; PG8_SCHED;
            PG8_LDA(At, 1, 1); PG8_STAGE(PG8_SB(1, 0), b3, voffB); PG8_STAGE(PG8_SB(1, 1), b3 + hstepB, voffB); PG8_STAGE(PG8_SA(1, 0), a3, voffA);
            PG8_WAIT_V(8); PG8_WAIT_L(0); PG8_BAR; PG8_MMA(1, 0, At, B0); PG8_MMA(1, 1, At, B1); PG8_BAR; PG8_SCHED;
        }
        if constexpr (ALIGN_EPI) { if (wr == 0) PG8_BAR; }
        E(acc, cur, wr, wc, fr, fq); S.done(cur);
        if (!has_next) break;
#pragma unroll
        for (int a = 0; a < 2; ++a)
#pragma unroll
            for (int b = 0; b < 2; ++b)
#pragma unroll
                for (int m = 0; m < 4; ++m)
#pragma unroll
                    for (int n = 0; n < 2; ++n) acc[a][b][m][n] = (f32x4){0.f, 0.f, 0.f, 0.f};
        cur = nxt; cA = nA; cB = nB; ++ui;
        if constexpr (ALIGN_EPI) { if (wr == 1) PG8_BAR; }
    }
    PG8_WAIT_V(0);
    if constexpr (!ALIGN_EPI) { if (wr == 0) PG8_BAR; }
    PG8_BAR;
#undef PG8_SA
#undef PG8_SB
#undef PG8_STAGE
#undef PG8_LDA
#undef PG8_LDB
#undef PG8_MMA
#undef PG8_WAIT_V
#undef PG8_WAIT_L
#undef PG8_BAR
#undef PG8_SCHED
}

struct EpiBf16 {
    static constexpr bool PERM = true;
    bf16* O; int ldc;
    __device__ __forceinline__ void operator()(const f32x4 (&acc)[2][2][4][2], const Unit& u, int wr, int wc, int fr, int fq) const {
        const int row0 = u.pm * BM + wr * 64 + fr, col0 = u.pn * BM + wc * 32 + 8 * fq;
#pragma unroll
        for (int ai = 0; ai < 2; ++ai)
#pragma unroll
            for (int m = 0; m < 4; ++m) { bf16* rowp = O + (size_t)(row0 + ai * HALF + m * 16) * ldc + col0;
#pragma unroll
                for (int bj = 0; bj < 2; ++bj) { const f32x4 v0 = acc[ai][bj][m][0], v1 = acc[ai][bj][m][1];
                    v4u w; w.x = pk2(v0[0], v0[1]); w.y = pk2(v0[2], v0[3]); w.z = pk2(v1[0], v1[1]); w.w = pk2(v1[2], v1[3]);
                    *(v4u*)(rowp + bj * HALF) = w; } }
    }
};
struct EpiProj {
    static constexpr bool PERM = true;
    bf16* O; float* Gt;
    __device__ __forceinline__ void operator()(const f32x4 (&acc)[2][2][4][2], const Unit& u, int wr, int wc, int fr, int fq) const {
        const int row0 = u.pm * BM + wr * 64 + fr;
        if (u.pn < 104) {
            const int col0 = u.pn * BM + wc * 32 + 8 * fq;
#pragma unroll
            for (int ai = 0; ai < 2; ++ai)
#pragma unroll
                for (int m = 0; m < 4; ++m) { bf16* rowp = O + (size_t)(row0 + ai * HALF + m * 16) * NPROJ + col0;
#pragma unroll
                    for (int bj = 0; bj < 2; ++bj) { const f32x4 v0 = acc[ai][bj][m][0], v1 = acc[ai][bj][m][1];
                        v4u w; w.x = pk2(v0[0], v0[1]); w.y = pk2(v0[2], v0[3]); w.z = pk2(v1[0], v1[1]); w.w = pk2(v1[2], v1[3]);
                        *(v4u*)(rowp + bj * HALF) = w; } }
        } else {
            const int col0 = wc * 32 + 8 * fq;
#pragma unroll
            for (int ai = 0; ai < 2; ++ai)
#pragma unroll
                for (int m = 0; m < 4; ++m) { float* rowp = Gt + (size_t)(row0 + ai * HALF + m * 16) * 256 + col0;
#pragma unroll
                    for (int bj = 0; bj < 2; ++bj)
#pragma unroll
                        for (int n = 0; n < 2; ++n) *(f32x4*)(rowp + bj * HALF + 4 * n) = acc[ai][bj][m][n]; }
        }
    }
};
struct EpiX1 {
    static constexpr bool PERM = false;
    const float* xp; const float* xs; const float* gn; float* X1; bf16* X1G; float* RS;
    __device__ __forceinline__ void operator()(const f32x4 (&acc)[2][2][4][2], const Unit& u, int wr, int wc, int fr, int fq) const {
        const int row0 = u.pm * BM + wr * 64 + fr, col0 = u.pn * BM + wc * 32 + 4 * fq;
#pragma unroll
        for (int ai = 0; ai < 2; ++ai)
#pragma unroll
            for (int m = 0; m < 4; ++m) { const int row = row0 + ai * HALF + m * 16;
                const float* xrow = (row < MPR ? xp + (size_t)row * DM : xs + (size_t)(row - MPR) * DM) + col0; const size_t off = (size_t)row * DM + col0; float ss = 0.f;
#pragma unroll
                for (int bj = 0; bj < 2; ++bj)
#pragma unroll
                    for (int n = 0; n < 2; ++n) { const int co = bj * HALF + n * 16; const f32x4 v = *(const f32x4*)(xrow + co) + acc[ai][bj][m][n];
                        *(f32x4*)(X1 + off + co) = v; ss += (v[0] * v[0] + v[1] * v[1]) + (v[2] * v[2] + v[3] * v[3]);
                        const f32x4 gv = *(const f32x4*)(gn + col0 + co); v2u w; w.x = pk2(v[0] * gv[0], v[1] * gv[1]); w.y = pk2(v[2] * gv[2], v[3] * gv[3]);
                        *(v2u*)(X1G + off + co) = w; }
                ss += __shfl_xor(ss, 16); ss += __shfl_xor(ss, 32);
                if (fq == 0) atomicAdd(RS + row, ss); }
    }
};
struct EpiGate {
    static constexpr bool PERM = false;
    const float* X1; const bf16* PP; const float* RS1; float* out; float* RS2;
    __device__ __forceinline__ void operator()(const f32x4 (&acc)[2][2][4][2], const Unit& u, int wr, int wc, int fr, int fq) const {
        const int row0 = u.pm * BM + wr * 64 + fr, col0 = u.pn * BM + wc * 32 + 4 * fq;
#pragma unroll
        for (int ai = 0; ai < 2; ++ai)
#pragma unroll
            for (int m = 0; m < 4; ++m) { const int row = row0 + ai * HALF + m * 16; const size_t off = (size_t)row * DM + col0; float ss = 0.f;
                const float rstd = rsqrtf(RS1[row] * (1.f / DM) + EPS);
#pragma unroll
                for (int bj = 0; bj < 2; ++bj)
#pragma unroll
                    for (int n = 0; n < 2; ++n) { const int co = bj * HALF + n * 16; const f32x4 a = acc[ai][bj][m][n] * rstd; const v2u pw = *(const v2u*)(PP + off + co);
                        const f32x4 x1 = *(const f32x4*)(X1 + off + co); f32x4 v;
                        v[0] = x1[0] + sigm(a[0]) * bflo(pw.x); v[1] = x1[1] + sigm(a[1]) * bfhi(pw.x); v[2] = x1[2] + sigm(a[2]) * bflo(pw.y); v[3] = x1[3] + sigm(a[3]) * bfhi(pw.y);
                        *(f32x4*)(out + off + co) = v; ss += (v[0] * v[0] + v[1] * v[1]) + (v[2] * v[2] + v[3] * v[3]); }
                ss += __shfl_xor(ss, 16); ss += __shfl_xor(ss, 32);
                if (fq == 0) atomicAdd(RS2 + row, ss); }
    }
};
}

#define XB_TMO      128
#define XB_XCNT(j)  (256  + 64 * (j))
#define XB_XSUB(j)  (1280 + 64 * (j))
#define XB_XGEN(j)  (2304 + 64 * (j))
#define XB_TOP      3328
#define XB_TOPGEN   3392
#define XCD_BAR_WORDS 3456
#define XB_SPIN_CAP (1u << 18)
__device__ __forceinline__ unsigned xb_ld(unsigned* p)              { return __hip_atomic_load(p, __ATOMIC_RELAXED, __HIP_MEMORY_SCOPE_AGENT); }
__device__ __forceinline__ unsigned xb_add(unsigned* p, unsigned v) { return __hip_atomic_fetch_add(p, v, __ATOMIC_RELAXED, __HIP_MEMORY_SCOPE_AGENT); }
__device__ __forceinline__ unsigned xb_xcc_id() { return (unsigned)__builtin_amdgcn_s_getreg((3 << 11) | 20) & 0xFu; }
#define XB_SPIN(cond, bar) do { unsigned _sp = 0; while (cond) { __builtin_amdgcn_s_sleep(1); \
    if ((++_sp & 255u) == 0u) { if (xb_ld(&(bar)[XB_TMO])) break; if (_sp > XB_SPIN_CAP) { atomicAdd(&(bar)[XB_TMO], 1u); break; } } } } while (0)
struct XcdBarrier { unsigned* bar; unsigned x; volatile LAS unsigned* st; };
__device__ __forceinline__ XcdBarrier xcd_barrier_post(unsigned* bar, volatile LAS unsigned* st) {
    XcdBarrier b; b.bar = bar; b.x = xb_xcc_id(); b.st = st;
    if (threadIdx.x == 0) (void)xb_add(&bar[XB_XCNT(b.x)], 1u);
    return b;
}
__device__ __forceinline__ void xcd_barrier_complete(unsigned* bar, unsigned x, unsigned& nloc, unsigned& nx) {
    const unsigned G = gridDim.x * gridDim.y * gridDim.z;
    unsigned sum, cnt, mine, sp = 0u;
    for (;;) {
        sum = 0u; cnt = 0u; mine = 0u;
#pragma unroll
        for (unsigned j = 0; j < 16; ++j) { const unsigned c = xb_ld(&bar[XB_XCNT(j)]); sum += c; cnt += (c > 0u) ? 1u : 0u; mine = (j == x) ? c : mine; }
        if (sum == G) break;
        __builtin_amdgcn_s_sleep(1);
        if ((++sp & 255u) == 0u) { if (xb_ld(&bar[XB_TMO])) break; if (sp > XB_SPIN_CAP) { atomicAdd(&bar[XB_TMO], 1u); break; } }
    }
    nloc = mine > 0u ? mine : 1u; nx = cnt > 0u ? cnt : 1u;
}
__device__ __forceinline__ void xcd_barrier(const XcdBarrier& b) {
    asm volatile("s_waitcnt vmcnt(0)" ::: "memory");
    __syncthreads();
    if (threadIdx.x == 0) {
        unsigned* bar = b.bar;
        __builtin_amdgcn_s_waitcnt(0);
        unsigned nloc = b.st[0], nx = b.st[1];
        if (nloc == 0u) { xcd_barrier_complete(bar, b.x, nloc, nx); b.st[0] = nloc; b.st[1] = nx; }
        const unsigned old = xb_add(&bar[XB_XSUB(b.x)], 1u);
        const unsigned gen = old / nloc;
        if (old + 1u == (gen + 1u) * nloc) {
            __builtin_amdgcn_fence(__ATOMIC_RELEASE, "agent");
            asm volatile("s_waitcnt vmcnt(0)" ::: "memory");
            const unsigned og = xb_add(&bar[XB_TOP], 1u);
            const unsigned tg = og / nx;
            if (og + 1u == (tg + 1u) * nx) xb_add(&bar[XB_TOPGEN], 1u);
            else XB_SPIN(xb_ld(&bar[XB_TOPGEN]) == tg, bar);
            __builtin_amdgcn_fence(__ATOMIC_ACQUIRE, "agent");
            xb_add(&bar[XB_XGEN(b.x)], 1u);
            asm volatile("s_waitcnt vmcnt(0)" ::: "memory");
        } else {
            XB_SPIN(xb_ld(&bar[XB_XGEN(b.x)]) == gen, bar);
            __builtin_amdgcn_fence(__ATOMIC_ACQUIRE, "agent");
            asm volatile("s_waitcnt vmcnt(0)" ::: "memory");
        }
    }
    __syncthreads();
}

struct Args { const float* in[N_IN]; float* out; unsigned char* ws; int ph_lo, ph_hi; };

template <int K>
__device__ __forceinline__ f32x4 mma_nt(const LAS bf16* X, int ldx, const LAS bf16* Y, int ldy, f32x4 acc, int lane) {
    const int r = lane & 15, kq = (lane >> 4) * 8;
#pragma unroll
    for (int k0 = 0; k0 < K; k0 += 32) {
        const bf16x8 a = *(const LAS bf16x8*)(X + r * ldx + k0 + kq);
        const bf16x8 b = *(const LAS bf16x8*)(Y + r * ldy + k0 + kq);
        acc = __builtin_amdgcn_mfma_f32_16x16x32_bf16(a, b, acc, 0, 0, 0);
    }
    return acc;
}

__device__ __forceinline__ int w1_colmap(int n) { return n < 16384 ? n : (n < 26624 ? n + 16 : (n < 26640 ? n - 26624 + 16384 : (n < INCOLS ? n : -1))); }
template <bool MAP>
__device__ __forceinline__ void transpose_item(const float* W, int ldw, bf16* WT, int ldt, int k0, int n0, LAS float* scr, int lane, float scale) {
    const int nn = n0 + (lane & 31); const int oc = MAP ? w1_colmap(nn) : nn;
    const float* src = W + (size_t)k0 * ldw + (oc >= 0 ? oc : 0);
#pragma unroll 8
    for (int i = 0; i < 32; ++i) { const int kk = 2 * i + (lane >> 5); const float v = src[(size_t)kk * ldw]; scr[kk * 33 + (lane & 31)] = (oc >= 0) ? v * scale : 0.f; }
    LDS_WAIT(); asm volatile("" ::: "memory");
    const int c = lane & 7;
#pragma unroll
    for (int j = 0; j < 4; ++j) { const int n = (lane >> 3) + 8 * j; const LAS float* s = scr + (8 * c) * 33 + n;
        v4u o; o.x = pk2(s[0 * 33], s[1 * 33]); o.y = pk2(s[2 * 33], s[3 * 33]); o.z = pk2(s[4 * 33], s[5 * 33]); o.w = pk2(s[6 * 33], s[7 * 33]);
        *(v4u*)(WT + (size_t)(n0 + n) * ldt + k0 + 8 * c) = o; }
    LDS_WAIT(); asm volatile("" ::: "memory");
}
__device__ __forceinline__ void p0_prologue(const Args& A, LAS unsigned char* lds, int gw, int NGW, int lane, int wave) {
    LAS float* scr = (LAS float*)(lds + wave * 16384);
    unsigned char* ws = A.ws;
    constexpr int I1 = 64 * 840, I2 = 128 * 128, I3 = 64 * 128, I4 = 4 * 128, I5 = 1024;
    for (int it = gw; it < I1 + I2 + I3 + I4 + I5; it += NGW) {
        int r = it;
        if (r < I1) { transpose_item<true>(A.in[I_WIN], INCOLS, (bf16*)(ws + WS_W1T), DM, (r / 840) * 64, (r % 840) * 32, scr, lane, 1.f); continue; } r -= I1;
        if (r < I2) { transpose_item<false>(A.in[I_WOUT], DM, (bf16*)(ws + WS_W2T), 8192, (r / 128) * 64, (r % 128) * 32, scr, lane, 1.f); continue; } r -= I2;
        if (r < I3) { transpose_item<false>(A.in[I_PLEGATE], DM, (bf16*)(ws + WS_WGT), DM, (r / 128) * 64, (r % 128) * 32, scr, lane, 1.f); continue; } r -= I3;
        if (r < I4) { transpose_item<false>(A.in[I_PLEPROJ], DM, (bf16*)(ws + WS_WPT), 256, (r / 128) * 64, (r % 128) * 32, scr, lane, 1.f); continue; } r -= I4;
        { const int hw = r >> 6, h = hw >> 1, which = hw & 1, q = r & 63;
          const float* W = (which ? A.in[I_WK] : A.in[I_WQ]) + (size_t)h * 512 * 256;
          transpose_item<false>(W, 256, (bf16*)(ws + WS_WQK) + (size_t)(h * 512 + which * 256) * 512, 512, (q >> 3) * 64, (q & 7) * 32, scr, lane, which ? 0.0625f : 1.f); }
    }
    const float* gn = A.in[I_NORMIN];
    for (int m = gw; m < MTOK; m += NGW) {
        const float* xrow = m < MPR ? A.in[I_XP] + (size_t)m * DM : A.in[I_XS] + (size_t)(m - MPR) * DM;
        f32x4 v[16]; float s = 0.f;
#pragma unroll
        for (int j = 0; j < 16; ++j) { v[j] = ((const f32x4*)xrow)[lane + 64 * j]; s += (v[j][0] * v[j][0] + v[j][1] * v[j][1]) + (v[j][2] * v[j][2] + v[j][3] * v[j][3]); }
        const float rstd = rsqrtf(wave_sum(s) * (1.f / DM) + EPS);
        bf16* orow = (bf16*)(ws + WS_XN) + (size_t)m * DM;
#pragma unroll
        for (int j = 0; j < 16; ++j) { const f32x4 g4 = ((const f32x4*)gn)[lane + 64 * j]; v2u w; w.x = pk2(v[j][0] * rstd * g4[0], v[j][1] * rstd * g4[1]); w.y = pk2(v[j][2] * rstd * g4[2], v[j][3] * rstd * g4[3]);
            ((v2u*)orow)[lane + 64 * j] = w; }
    }
    { const int gt = gw * 64 + lane, NGT = NGW * 64;
      for (int i = gt; i < MTOK * 32; i += NGT) { const int row = i >> 5, c8 = (i & 31) * 8;
          const float* src = (row < MPR ? A.in[I_PP] + (size_t)row * 256 : A.in[I_PS] + (size_t)(row - MPR) * 256) + c8;
          const f32x4 a = *(const f32x4*)src, b = *(const f32x4*)(src + 4);
          v4u w; w.x = pk2(a[0], a[1]); w.y = pk2(a[2], a[3]); w.z = pk2(b[0], b[1]); w.w = pk2(b[2], b[3]);
          *(v4u*)((bf16*)(ws + WS_PB) + (size_t)row * 256 + c8) = w; } }
}

template <int NCH>
__device__ __forceinline__ void conv_phase(const bf16* src  , const float* state_in, const float* w, const float* bias, bf16* dst, float* out_p, float* out_s, int gt, int NGT) {
    constexpr int CG = NCH / 8;
    constexpr int NP = 4 * 128 * CG, NS = 128 * CG;
    for (int it = gt; it < NP + NS; it += NGT) {
        const bool prompt = it < NP; const int r = prompt ? it : it - NP; const int cg = r % CG, q = r / CG;
        const int c0 = cg * 8;
        float wv[4][8], bv[8], win[3][8];
#pragma unroll
        for (int j = 0; j < 4; ++j) { const f32x4 a = *(const f32x4*)(w + j * NCH + c0), b = *(const f32x4*)(w + j * NCH + c0 + 4);
#pragma unroll
            for (int e = 0; e < 4; ++e) { wv[j][e] = a[e]; wv[j][4 + e] = b[e]; } }
        { const f32x4 a = *(const f32x4*)(bias + c0), b = *(const f32x4*)(bias + c0 + 4);
#pragma unroll
          for (int e = 0; e < 4; ++e) { bv[e] = a[e]; bv[4 + e] = b[e]; } }
        int row0, nt; bool lastblk = false; int seq;
        if (prompt) { seq = q >> 7; const int blk = q & 127; row0 = seq * SEQ + blk * 16; nt = 16; lastblk = (blk == 127);
#pragma unroll
            for (int j = 0; j < 3; ++j) { if (blk == 0) {
#pragma unroll
                    for (int e = 0; e < 8; ++e) win[j][e] = 0.f; }
                else { const v4u v = *(const v4u*)(src + (size_t)(row0 - 3 + j) * NPROJ + c0);
                    win[j][0] = bflo(v.x); win[j][1] = bfhi(v.x); win[j][2] = bflo(v.y); win[j][3] = bfhi(v.y); win[j][4] = bflo(v.z); win[j][5] = bfhi(v.z); win[j][6] = bflo(v.w); win[j][7] = bfhi(v.w); } }
        } else { seq = q; row0 = MPR + seq * 4; nt = 4;
#pragma unroll
            for (int j = 0; j < 3; ++j) { const float* sp = state_in + ((size_t)seq * 3 + j) * NCH + c0; const f32x4 a = *(const f32x4*)sp, b = *(const f32x4*)(sp + 4);
#pragma unroll
                for (int e = 0; e < 4; ++e) { win[j][e] = a[e]; win[j][4 + e] = b[e]; } }
        }
        for (int i = 0; i < nt; ++i) {
            const v4u v = *(const v4u*)(src + (size_t)(row0 + i) * NPROJ + c0);
            float cur[8] = {bflo(v.x), bfhi(v.x), bflo(v.y), bfhi(v.y), bflo(v.z), bfhi(v.z), bflo(v.w), bfhi(v.w)};
            float y[8];
#pragma unroll
            for (int e = 0; e < 8; ++e) { y[e] = silu(bv[e] + wv[0][e] * win[0][e] + wv[1][e] * win[1][e] + wv[2][e] * win[2][e] + wv[3][e] * cur[e]); win[0][e] = win[1][e]; win[1][e] = win[2][e]; win[2][e] = cur[e]; }
            v4u o; o.x = pk2(y[0], y[1]); o.y = pk2(y[2], y[3]); o.z = pk2(y[4], y[5]); o.w = pk2(y[6], y[7]);
            *(v4u*)(dst + (size_t)(row0 + i) * NCH + c0) = o;
        }
        if (!prompt || lastblk) { float* op = (prompt ? out_p : out_s) + (size_t)seq * 3 * NCH + c0;
#pragma unroll
            for (int j = 0; j < 3; ++j) { *(f32x4*)(op + j * NCH) = (f32x4){win[j][0], win[j][1], win[j][2], win[j][3]}; *(f32x4*)(op + j * NCH + 4) = (f32x4){win[j][4], win[j][5], win[j][6], win[j][7]}; } }
    }
}
__device__ __forceinline__ float scan_add(float v, int lane) {
#pragma unroll
    for (int o = 1; o < 64; o <<= 1) { const float t = __shfl_up(v, o); if (lane >= o) v += t; }
    return v;
}
__device__ __forceinline__ float scan_max(float v, int lane) {
#pragma unroll
    for (int o = 1; o < 64; o <<= 1) { const float t = __shfl_up(v, o); if (lane >= o) v = fmaxf(v, t); }
    return v;
}
__device__ __forceinline__ void gate_scans(const Args& A, int gw, int NGW, int lane) {
    const float* GT = (const float*)(A.ws + WS_GATES);
    f32x4* MG = (f32x4*)(A.ws + WS_MG); f32x2* SG = (f32x2*)(A.ws + WS_SG);
    for (int it = gw; it < 32 + 1024; it += NGW) {
        const bool prompt = it < 32; const int q = prompt ? it : it - 32; const int seq = q >> 3, h = q & 7;
        const int nch = prompt ? 32 : 1, clen = prompt ? 64 : 4, rowbase = prompt ? seq * SEQ : MPR + seq * 4;
        float m = prompt ? -INFINITY : A.in[I_MM][seq * 8 + h];
        const float big = A.in[I_BIG][h], bfg = A.in[I_BFG][h];
        for (int c = 0; c < nch; ++c) {
            const bool act = lane < clen; const int row = rowbase + c * 64 + (act ? lane : 0);
            const float gi = GT[(size_t)row * 256 + h], gf = GT[(size_t)row * 256 + 8 + h];
            const float ig = act ? softcap(gi + big) : -INFINITY;
            const float lf = act ? -softplus(-softcap(gf + bfg)) : 0.f;
            const float bc = scan_add(lf, lane);
            const float g = ig - bc;
            const float gmax = scan_max(g, lane);
            const float mm = fmaxf(m, gmax);
            const float alpha = -mm, a = __expf(m - mm), ex = __expf(alpha - bc);
            if (act) MG[(size_t)row * 8 + h] = (f32x4){alpha, g, a, ex};
            m = __shfl(bc + mm, clen - 1);
        }
        if (lane == 0) A.out[(prompt ? O_PM : O_SM) + seq * 8 + h] = m;
    }
    for (int it = gw; it < 256; it += NGW) {
        const int seq = it >> 6, hd = it & 63; const float dtb = A.in[I_DTB][hd], Aneg = -__expf(A.in[I_ALOG][hd]);
        for (int c = 0; c < 32; ++c) { const int row = seq * SEQ + c * 64 + lane;
            const float dt = softplus(GT[(size_t)row * 256 + 16 + hd] + dtb);
            const float ac = scan_add(dt * Aneg, lane);
            SG[(size_t)row * 64 + hd] = (f32x2){dt, ac}; }
    }
    for (int it = gw; it < 128; it += NGW) {
        const int hd = lane; const float dtb = A.in[I_DTB][hd], Aneg = -__expf(A.in[I_ALOG][hd]); float ac = 0.f;
        for (int t = 0; t < 4; ++t) { const int row = MPR + it * 4 + t;
            const float dt = softplus(GT[(size_t)row * 256 + 16 + hd] + dtb); ac += dt * Aneg;
            SG[(size_t)row * 64 + hd] = (f32x2){dt, ac}; }
    }
}

constexpr int ML_Q = 0, ML_K = 33792, ML_VT = 70656, ML_P = 79872, ML_CT = 89088, ML_N = 122880, ML_GATE = 123904, ML_DEN = 124928, ML_WK = 125184;
__device__ __forceinline__ void mlstm_prompt_item(const Args& A, LAS unsigned char* lds, int item, int tid, int lane, int wave) {
    const int b = item >> 6, h = (item >> 3) & 7, j = item & 7;
    LAS bf16* Qs = (LAS bf16*)(lds + ML_Q); LAS bf16* Ks = (LAS bf16*)(lds + ML_K); LAS bf16* Kw = Ks;
    LAS bf16* Vt = (LAS bf16*)(lds + ML_VT); LAS bf16* Ps = (LAS bf16*)(lds + ML_P); LAS bf16* Ct = (LAS bf16*)(lds + ML_CT);
    LAS float* nS = (LAS float*)(lds + ML_N); LAS float* gA = (LAS float*)(lds + ML_GATE); LAS float* gG = gA + 64; LAS float* gAi = gA + 128; LAS float* gEx = gA + 192;
    LAS float* denS = (LAS float*)(lds + ML_DEN); LAS float* wkS = (LAS float*)(lds + ML_WK);
    const bf16* QK = (const bf16*)(A.ws + WS_QK); const bf16* PROJ = (const bf16*)(A.ws + WS_PROJ); const float* MG = (const float*)(A.ws + WS_MG);
    bf16* MIX = (bf16*)(A.ws + WS_MIX); float* NRM = (float*)(A.ws + WS_NRM); const float* mnorm = A.in[I_MNORM];
    for (int i = tid; i < 64 * 264 / 2; i += NTHREADS) ((LAS unsigned*)Ct)[i] = 0u;
    if (tid < 256) nS[tid] = 0.f;
    f32x4 cacc[8];
#pragma unroll
    for (int i = 0; i < 8; ++i) cacc[i] = (f32x4){0.f, 0.f, 0.f, 0.f};
    __syncthreads();
    const int vt = wave & 3, dtb = (wave >> 2) * 8, l4 = lane >> 4, l15 = lane & 15;
    for (int c = 0; c < 32; ++c) {
        const int row0 = b * SEQ + c * 64;
#pragma unroll
        for (int i = 0; i < 4; ++i) { const int piece = tid + NTHREADS * i, r = piece >> 5, cc = piece & 31;
            const bf16* sp = QK + (size_t)(row0 + r) * DM + h * 512 + cc * 8;
            const v4u q = *(const v4u*)sp, k = *(const v4u*)(sp + 256);
            *(LAS v4u*)(Qs + r * 264 + cc * 8) = q; *(LAS v4u*)(Ks + r * 264 + cc * 8) = k; }
        { const int r = tid >> 3, cc = tid & 7; const v4u v = *(const v4u*)(PROJ + (size_t)(row0 + r) * NPROJ + 4096 + h * 512 + j * 64 + cc * 8);
          const unsigned w[4] = {v.x, v.y, v.z, v.w};
#pragma unroll
          for (int e = 0; e < 4; ++e) { Vt[(cc * 8 + 2 * e) * 72 + r] = (bf16)(w[e] & 0xffffu); Vt[(cc * 8 + 2 * e + 1) * 72 + r] = (bf16)(w[e] >> 16); } }
        if (tid < 256) { const int q = tid >> 6, t = tid & 63; gA[q * 64 + t] = MG[((size_t)(row0 + t) * 8 + h) * 4 + q]; }
        __syncthreads();
        if (tid < 64) wkS[tid] = __expf(gA[63] + gG[tid]);
        const float decay = gAi[63];
        { const int mt = wave >> 1;
#pragma unroll
          for (int e = 0; e < 2; ++e) { const int nt = (wave & 1) * 2 + e;
              f32x4 acc = mma_nt<256>(Qs + mt * 16 * 264, 264, Ks + nt * 16 * 264, 264, (f32x4){0.f, 0.f, 0.f, 0.f}, lane);
#pragma unroll
              for (int i = 0; i < 4; ++i) { const int t = mt * 16 + 4 * l4 + i, s = nt * 16 + l15;
                  const float p = (s <= t) ? acc[i] * __expf(gA[t] + gG[s]) : 0.f; Ps[t * 72 + s] = (bf16)f2bf(p); } } }
        unsigned kreg[4][4];
#pragma unroll
        for (int i = 0; i < 4; ++i) { const int pair = tid + NTHREADS * i, d = pair & 255, sg = pair >> 8;
#pragma unroll
            for (int e = 0; e < 4; ++e) kreg[i][e] = (unsigned)Ks[(sg * 8 + 2 * e) * 264 + d] | ((unsigned)Ks[(sg * 8 + 2 * e + 1) * 264 + d] << 16); }
        __syncthreads();
#pragma unroll
        for (int i = 0; i < 4; ++i) { const int pair = tid + NTHREADS * i, d = pair & 255, sg = pair >> 8; v4u w; unsigned ww[4];
#pragma unroll
            for (int e = 0; e < 4; ++e) ww[e] = pk2(bflo(kreg[i][e]) * wkS[sg * 8 + 2 * e], bfhi(kreg[i][e]) * wkS[sg * 8 + 2 * e + 1]);
            w.x = ww[0]; w.y = ww[1]; w.z = ww[2]; w.w = ww[3]; *(LAS v4u*)(Kw + d * 72 + sg * 8) = w; }
        { const int t = tid >> 3, sg = tid & 7;
          const v4u pv = *(const LAS v4u*)(Ps + t * 72 + sg * 8);
          float ps = (bflo(pv.x) + bfhi(pv.x)) + (bflo(pv.y) + bfhi(pv.y)) + (bflo(pv.z) + bfhi(pv.z)) + (bflo(pv.w) + bfhi(pv.w)); float qn = 0.f;
#pragma unroll
          for (int i = 0; i < 4; ++i) { const v4u qv = *(const LAS v4u*)(Qs + t * 264 + sg * 32 + i * 8); const f32x4 n0 = *(const LAS f32x4*)(nS + sg * 32 + i * 8), n1 = *(const LAS f32x4*)(nS + sg * 32 + i * 8 + 4);
              qn += bflo(qv.x) * n0[0] + bfhi(qv.x) * n0[1] + bflo(qv.y) * n0[2] + bfhi(qv.y) * n0[3] + bflo(qv.z) * n1[0] + bfhi(qv.z) * n1[1] + bflo(qv.w) * n1[2] + bfhi(qv.w) * n1[3]; }
          ps += __shfl_xor(ps, 1); ps += __shfl_xor(ps, 2); ps += __shfl_xor(ps, 4); qn += __shfl_xor(qn, 1); qn += __shfl_xor(qn, 2); qn += __shfl_xor(qn, 4);
          if (sg == 0) denS[t] = ps + gAi[t] * qn; }
        __syncthreads();
        { const int tt = wave >> 1;
#pragma unroll
          for (int e = 0; e < 2; ++e) { const int v2 = (wave & 1) * 2 + e;
              const f32x4 acc1 = mma_nt<64>(Ps + tt * 16 * 72, 72, Vt + v2 * 16 * 72, 72, (f32x4){0.f, 0.f, 0.f, 0.f}, lane);
              const f32x4 acc2 = mma_nt<256>(Qs + tt * 16 * 264, 264, Ct + v2 * 16 * 264, 264, (f32x4){0.f, 0.f, 0.f, 0.f}, lane);
#pragma unroll
              for (int i = 0; i < 4; ++i) { const int t = tt * 16 + 4 * l4 + i, v = v2 * 16 + l15; const int row = row0 + t, col = h * 512 + j * 64 + v;
                  const float num = acc1[i] + gAi[t] * acc2[i]; const float hv = num / fmaxf(fabsf(denS[t]), gEx[t]);
                  const float o = bf2f(PROJ[(size_t)row * NPROJ + 8192 + col]), z = bf2f(PROJ[(size_t)row * NPROJ + 12288 + col]);
                  const float pre = hv * sigm(o); float ss = pre * pre;
                  ss += __shfl_xor(ss, 1); ss += __shfl_xor(ss, 2); ss += __shfl_xor(ss, 4); ss += __shfl_xor(ss, 8);
                  if (l15 == 0) atomicAdd(NRM + (size_t)row * 16 + h, ss);
                  MIX[(size_t)row * 8192 + col] = (bf16)f2bf(pre * mnorm[col] * silu(z)); } } }
        __syncthreads();
#pragma unroll
        for (int i = 0; i < 8; ++i) { cacc[i] = cacc[i] * decay;
            cacc[i] = mma_nt<64>(Vt + vt * 16 * 72, 72, Kw + (dtb + i) * 16 * 72, 72, cacc[i], lane);
#pragma unroll
            for (int r = 0; r < 4; ++r) Ct[(vt * 16 + 4 * l4 + r) * 264 + (dtb + i) * 16 + l15] = (bf16)f2bf(cacc[i][r]); }
        if (tid < 256) { float s = 0.f;
#pragma unroll
            for (int i = 0; i < 8; ++i) { const v4u kv = *(const LAS v4u*)(Kw + tid * 72 + i * 8); s += (bflo(kv.x) + bfhi(kv.x)) + (bflo(kv.y) + bfhi(kv.y)) + (bflo(kv.z) + bfhi(kv.z)) + (bflo(kv.w) + bfhi(kv.w)); }
            nS[tid] = decay * nS[tid] + s; }
        __syncthreads();
    }
    float* pC = A.out + O_PC + (size_t)((b * 8 + h) * 256) * 512 + j * 64;
#pragma unroll
    for (int i = 0; i < 8; ++i)
#pragma unroll
        for (int r = 0; r < 4; ++r) pC[(size_t)((dtb + i) * 16 + l15) * 512 + vt * 16 + 4 * l4 + r] = cacc[i][r];
    if (j == 0 && tid < 256) A.out[O_PN + (b * 8 + h) * 256 + tid] = nS[tid];
    __syncthreads();
}

constexpr int SS_C = 0, SS_B = 17408, SS_BT = 34816, SS_XT = 53248, SS_XW = 62464, SS_G = 71680, SS_H = 80896, SS_DT = 98304, SS_AC = 98560;
__device__ __forceinline__ void ssd_prompt_item(const Args& A, LAS unsigned char* lds, int item, int tid, int lane, int wave) {
    const int b = item >> 6, hd = item & 63, gi = hd >> 3;
    LAS bf16* Cs = (LAS bf16*)(lds + SS_C); LAS bf16* Bs = (LAS bf16*)(lds + SS_B); LAS bf16* Bt = (LAS bf16*)(lds + SS_BT); LAS bf16* Xt = (LAS bf16*)(lds + SS_XT);
    LAS bf16* Xw = (LAS bf16*)(lds + SS_XW); LAS bf16* Gs = (LAS bf16*)(lds + SS_G); LAS bf16* Hb = (LAS bf16*)(lds + SS_H);
    LAS float* dtS = (LAS float*)(lds + SS_DT); LAS float* acS = (LAS float*)(lds + SS_AC);
    const bf16* XBC = (const bf16*)(A.ws + WS_XBC); const bf16* PROJ = (const bf16*)(A.ws + WS_PROJ); const f32x2* SG = (const f32x2*)(A.ws + WS_SG);
    bf16* MIX = (bf16*)(A.ws + WS_MIX); float* NRM = (float*)(A.ws + WS_NRM); const float* snorm = A.in[I_SNORM]; const float dskip = A.in[I_DSKIP][hd];
    for (int i = tid; i < 64 * 136 / 2; i += NTHREADS) ((LAS unsigned*)Hb)[i] = 0u;
    f32x4 hacc[4];
#pragma unroll
    for (int i = 0; i < 4; ++i) hacc[i] = (f32x4){0.f, 0.f, 0.f, 0.f};
    __syncthreads();
    const int pt = wave & 3, ntb = (wave >> 2) * 4, l4 = lane >> 4, l15 = lane & 15;
    for (int c = 0; c < 32; ++c) {
        const int row0 = b * SEQ + c * 64;
        const float a_end = SG[(size_t)(row0 + 63) * 64 + hd][1];
#pragma unroll
        for (int i = 0; i < 2; ++i) { const int piece = tid + NTHREADS * i, r = piece >> 4, cc = piece & 15;
            const bf16* sp = XBC + (size_t)(row0 + r) * 6144 + 4096 + gi * 128 + cc * 8;
            const v4u bm = *(const v4u*)sp, cm = *(const v4u*)(sp + 1024);
            *(LAS v4u*)(Cs + r * 136 + cc * 8) = cm; *(LAS v4u*)(Bs + r * 136 + cc * 8) = bm;
            const unsigned w[4] = {bm.x, bm.y, bm.z, bm.w};
#pragma unroll
            for (int e = 0; e < 4; ++e) { Bt[(cc * 8 + 2 * e) * 72 + r] = (bf16)(w[e] & 0xffffu); Bt[(cc * 8 + 2 * e + 1) * 72 + r] = (bf16)(w[e] >> 16); } }
        { const int r = tid >> 3, cc = tid & 7; const v4u xv = *(const v4u*)(XBC + (size_t)(row0 + r) * 6144 + hd * 64 + cc * 8);
          const f32x2 sg = SG[(size_t)(row0 + r) * 64 + hd]; const float wgt = sg[0] * __expf(a_end - sg[1]);
          const unsigned w[4] = {xv.x, xv.y, xv.z, xv.w};
#pragma unroll
          for (int e = 0; e < 4; ++e) { const int p0 = cc * 8 + 2 * e; Xt[p0 * 72 + r] = (bf16)(w[e] & 0xffffu); Xt[(p0 + 1) * 72 + r] = (bf16)(w[e] >> 16);
              Xw[p0 * 72 + r] = (bf16)f2bf(bflo(w[e]) * wgt); Xw[(p0 + 1) * 72 + r] = (bf16)f2bf(bfhi(w[e]) * wgt); }
          if (cc == 0) { dtS[r] = sg[0]; acS[r] = sg[1]; } }
        __syncthreads();
        { const int mt = wave >> 1;
#pragma unroll
          for (int e = 0; e < 2; ++e) { const int nt = (wave & 1) * 2 + e;
              const f32x4 acc = mma_nt<128>(Cs + mt * 16 * 136, 136, Bs + nt * 16 * 136, 136, (f32x4){0.f, 0.f, 0.f, 0.f}, lane);
#pragma unroll
              for (int i = 0; i < 4; ++i) { const int t = mt * 16 + 4 * l4 + i, s = nt * 16 + l15;
                  const float gv = (s <= t) ? acc[i] * __expf(acS[t] - acS[s]) * dtS[s] : 0.f; Gs[t * 72 + s] = (bf16)f2bf(gv); } } }
        __syncthreads();
        { const int tt = wave >> 1;
#pragma unroll
          for (int e = 0; e < 2; ++e) { const int p2 = (wave & 1) * 2 + e;
              const f32x4 acc1 = mma_nt<64>(Gs + tt * 16 * 72, 72, Xt + p2 * 16 * 72, 72, (f32x4){0.f, 0.f, 0.f, 0.f}, lane);
              const f32x4 acc2 = mma_nt<128>(Cs + tt * 16 * 136, 136, Hb + p2 * 16 * 136, 136, (f32x4){0.f, 0.f, 0.f, 0.f}, lane);
#pragma unroll
              for (int i = 0; i < 4; ++i) { const int t = tt * 16 + 4 * l4 + i, p = p2 * 16 + l15; const int row = row0 + t, col = hd * 64 + p;
                  const float y = acc1[i] + __expf(acS[t]) * acc2[i] + dskip * bf2f(Xt[p * 72 + t]);
                  const float z = bf2f(PROJ[(size_t)row * NPROJ + 16384 + col]); const float pre = y * silu(z); float ss = pre * pre;
                  ss += __shfl_xor(ss, 1); ss += __shfl_xor(ss, 2); ss += __shfl_xor(ss, 4); ss += __shfl_xor(ss, 8);
                  if (l15 == 0) atomicAdd(NRM + (size_t)row * 16 + 8 + gi, ss);
                  MIX[(size_t)row * 8192 + 4096 + col] = (bf16)f2bf(pre * snorm[col]); } } }
        __syncthreads();
        { const float ea = __expf(a_end);
#pragma unroll
          for (int i = 0; i < 4; ++i) { hacc[i] = hacc[i] * ea;
              hacc[i] = mma_nt<64>(Xw + pt * 16 * 72, 72, Bt + (ntb + i) * 16 * 72, 72, hacc[i], lane);
#pragma unroll
              for (int r = 0; r < 4; ++r) Hb[(pt * 16 + 4 * l4 + r) * 136 + (ntb + i) * 16 + l15] = (bf16)f2bf(hacc[i][r]); } }
        __syncthreads();
    }
    float* pH = A.out + O_PSSM + (size_t)((b * 64 + hd) * 64) * 128;
#pragma unroll
    for (int i = 0; i < 4; ++i)
#pragma unroll
        for (int r = 0; r < 4; ++r) pH[(size_t)(pt * 16 + 4 * l4 + r) * 128 + (ntb + i) * 16 + l15] = hacc[i][r];
    __syncthreads();
}

__device__ __forceinline__ void mlstm_sample_item(const Args& A, LAS unsigned char* lds, int item, int tid, int lane, int wave) {
    const int seq = item >> 3, h = item & 7;
    LAS float* qT = (LAS float*)lds; LAS float* kT = qT + 1024; LAS float* kwT = qT + 2048; LAS float* vS = qT + 3072; LAS float* n0S = qT + 5120; LAS float* gt = qT + 5376;
    LAS float* SSd = qT + 5408; LAS float* PSd = qT + 5440; LAS float* denS = qT + 5472; LAS float* wkS = qT + 5480; LAS float* accl = qT + 6144;
    const bf16* QK = (const bf16*)(A.ws + WS_QK); const bf16* PROJ = (const bf16*)(A.ws + WS_PROJ); const float* MG = (const float*)(A.ws + WS_MG);
    bf16* MIX = (bf16*)(A.ws + WS_MIX); float* NRM = (float*)(A.ws + WS_NRM); const float* mnorm = A.in[I_MNORM];
    const int rowb = MPR + seq * 4;
    { const int idx = tid * 2, t = idx >> 8, d = idx & 255; const bf16* sp = QK + (size_t)(rowb + t) * DM + h * 512 + d;
      const unsigned qw = *(const unsigned*)sp, kw = *(const unsigned*)(sp + 256);
      qT[d * 4 + t] = bflo(qw); qT[(d + 1) * 4 + t] = bfhi(qw); kT[d * 4 + t] = bflo(kw); kT[(d + 1) * 4 + t] = bfhi(kw); }
    { const int idx = tid * 4, t = idx >> 9, v = idx & 511; const v2u vw = *(const v2u*)(PROJ + (size_t)(rowb + t) * NPROJ + 4096 + h * 512 + v);
      *(LAS f32x4*)(vS + t * 512 + v) = (f32x4){bflo(vw.x), bfhi(vw.x), bflo(vw.y), bfhi(vw.y)}; }
    if (tid < 256) n0S[tid] = A.in[I_MN][(size_t)(seq * 8 + h) * 256 + tid];
    if (tid < 16) { const int comp = tid >> 2, t = tid & 3; gt[comp * 4 + t] = MG[((size_t)(rowb + t) * 8 + h) * 4 + comp]; }
    __syncthreads();
    for (int pp = wave; pp < 20; pp += NWAVES) { float part = 0.f;
        if (pp < 16) { const int t = pp >> 2, s = pp & 3;
#pragma unroll
            for (int i = 0; i < 4; ++i) part += qT[(lane + 64 * i) * 4 + t] * kT[(lane + 64 * i) * 4 + s]; }
        else { const int t = pp - 16;
#pragma unroll
            for (int i = 0; i < 4; ++i) part += qT[(lane + 64 * i) * 4 + t] * n0S[lane + 64 * i]; }
        part = wave_sum(part); if (lane == 0) SSd[pp] = part; }
    __syncthreads();
    if (tid < 16) { const int t = tid >> 2, s = tid & 3; PSd[tid] = (s <= t) ? SSd[tid] * __expf(gt[t] + gt[4 + s]) : 0.f; }
    if (tid >= 64 && tid < 68) { const int s = tid - 64; wkS[s] = __expf(gt[3] + gt[4 + s]); }
    __syncthreads();
    if (tid < 4) denS[tid] = (PSd[tid * 4] + PSd[tid * 4 + 1]) + (PSd[tid * 4 + 2] + PSd[tid * 4 + 3]) + gt[8 + tid] * SSd[16 + tid];
    { const int i0 = tid * 2; kwT[i0] = kT[i0] * wkS[i0 & 3]; kwT[i0 + 1] = kT[i0 + 1] * wkS[(i0 + 1) & 3]; }
    __syncthreads();
    const float decay = gt[8 + 3];
    const int dr = tid >> 7, v4 = (tid & 127) * 4;
    f32x4 vv[4], acc[4];
#pragma unroll
    for (int s = 0; s < 4; ++s) { vv[s] = *(const LAS f32x4*)(vS + s * 512 + v4); acc[s] = (f32x4){0.f, 0.f, 0.f, 0.f}; }
    const float* C0 = A.in[I_MC] + (size_t)((seq * 8 + h) * 256) * 512 + v4; float* C1 = A.out + O_SC + (size_t)((seq * 8 + h) * 256) * 512 + v4;
#pragma unroll 8
    for (int i = 0; i < 64; ++i) { const int d = dr + 4 * i;
        const f32x4 c0 = __builtin_nontemporal_load((const f32x4*)(C0 + (size_t)d * 512));
        const f32x4 q4 = *(const LAS f32x4*)(qT + d * 4), kw4 = *(const LAS f32x4*)(kwT + d * 4);
#pragma unroll
        for (int t = 0; t < 4; ++t) acc[t] += q4[t] * c0;
        const f32x4 cn = decay * c0 + kw4[0] * vv[0] + kw4[1] * vv[1] + kw4[2] * vv[2] + kw4[3] * vv[3];
        __builtin_nontemporal_store(cn, (f32x4*)(C1 + (size_t)d * 512)); }
#pragma unroll
    for (int t = 0; t < 4; ++t) *(LAS f32x4*)(accl + (dr * 4 + t) * 512 + v4) = acc[t];
    __syncthreads();
    { const int t = dr; f32x4 a = (f32x4){0.f, 0.f, 0.f, 0.f};
#pragma unroll
      for (int r = 0; r < 4; ++r) a += *(const LAS f32x4*)(accl + (r * 4 + t) * 512 + v4);
      f32x4 num = gt[8 + t] * a;
#pragma unroll
      for (int s = 0; s < 4; ++s) num += PSd[t * 4 + s] * vv[s];
      const float dn = fmaxf(fabsf(denS[t]), gt[12 + t]); const int row = rowb + t, col = h * 512 + v4;
      const v2u ow = *(const v2u*)(PROJ + (size_t)row * NPROJ + 8192 + col), zw = *(const v2u*)(PROJ + (size_t)row * NPROJ + 12288 + col);
      const f32x4 o4 = (f32x4){bflo(ow.x), bfhi(ow.x), bflo(ow.y), bfhi(ow.y)}, z4 = (f32x4){bflo(zw.x), bfhi(zw.x), bflo(zw.y), bfhi(zw.y)}; const f32x4 mn = *(const f32x4*)(mnorm + col);
      f32x4 pre; float ss = 0.f; float val[4];
#pragma unroll
      for (int e = 0; e < 4; ++e) { pre[e] = (num[e] / dn) * sigm(o4[e]); ss += pre[e] * pre[e]; val[e] = pre[e] * mn[e] * silu(z4[e]); }
      ss = wave_sum(ss); if (lane == 0) atomicAdd(NRM + (size_t)row * 16 + h, ss);
      v2u w; w.x = pk2(val[0], val[1]); w.y = pk2(val[2], val[3]); *(v2u*)(MIX + (size_t)row * 8192 + col) = w; }
    if (tid < 256) { const f32x4 kw = *(const LAS f32x4*)(kwT + tid * 4); A.out[O_SN + (size_t)(seq * 8 + h) * 256 + tid] = decay * n0S[tid] + ((kw[0] + kw[1]) + (kw[2] + kw[3])); }
    __syncthreads();
}

__device__ __forceinline__ void ssd_sample_item(const Args& A, LAS unsigned char* lds, int item, int tid, int lane, int wave) {
    const int seq = item >> 3, gi = item & 7, hd = gi * 8 + wave;
    LAS float* Cf = (LAS float*)lds; LAS float* Bf = Cf + 512; LAS float* xf = Cf + 1024; LAS float* dtS = Cf + 3072; LAS float* acS = Cf + 3104; LAS float* CBs = Cf + 3136;
    LAS float* xw = Cf + 3200; LAS float* yp = Cf + 5248;
    const bf16* XBC = (const bf16*)(A.ws + WS_XBC); const bf16* PROJ = (const bf16*)(A.ws + WS_PROJ); const f32x2* SG = (const f32x2*)(A.ws + WS_SG);
    bf16* MIX = (bf16*)(A.ws + WS_MIX); float* NRM = (float*)(A.ws + WS_NRM); const float* snorm = A.in[I_SNORM];
    const int rowb = MPR + seq * 4;
    { const int t = tid >> 7, n = tid & 127; const bf16* sp = XBC + (size_t)(rowb + t) * 6144 + 4096 + gi * 128 + n; Bf[t * 128 + n] = bf2f(sp[0]); Cf[t * 128 + n] = bf2f(sp[1024]); }
    { const int idx = tid * 4, t = idx >> 9, cidx = idx & 511; const v2u xv = *(const v2u*)(XBC + (size_t)(rowb + t) * 6144 + gi * 512 + cidx);
      *(LAS f32x4*)(xf + t * 512 + cidx) = (f32x4){bflo(xv.x), bfhi(xv.x), bflo(xv.y), bfhi(xv.y)}; }
    if (tid < 32) { const int hh = tid >> 2, t = tid & 3; const f32x2 sg = SG[(size_t)(rowb + t) * 64 + gi * 8 + hh]; dtS[hh * 4 + t] = sg[0]; acS[hh * 4 + t] = sg[1]; }
    __syncthreads();
#pragma unroll
    for (int e = 0; e < 2; ++e) { const int pp = wave * 2 + e, t = pp >> 2, s = pp & 3;
        float part = Cf[t * 128 + lane] * Bf[s * 128 + lane] + Cf[t * 128 + 64 + lane] * Bf[s * 128 + 64 + lane];
        part = wave_sum(part); if (lane == 0) CBs[pp] = part; }
#pragma unroll
    for (int i = 0; i < 4; ++i) { const int idx = tid + NTHREADS * i, hh = idx >> 8, p = (idx >> 2) & 63, s = idx & 3;
        xw[idx] = xf[s * 512 + hh * 64 + p] * dtS[hh * 4 + s] * __expf(acS[hh * 4 + 3] - acS[hh * 4 + s]); }
    __syncthreads();
    { const int n4 = (lane & 31) * 4, half = lane >> 5; f32x4 c4[4], b4[4];
#pragma unroll
      for (int t = 0; t < 4; ++t) { c4[t] = *(const LAS f32x4*)(Cf + t * 128 + n4); b4[t] = *(const LAS f32x4*)(Bf + t * 128 + n4); }
      const float ea = __expf(acS[wave * 4 + 3]);
      const float* H0 = A.in[I_SSSM] + (size_t)((seq * 64 + hd) * 64) * 128 + n4; float* H1 = A.out + O_SSSM + (size_t)((seq * 64 + hd) * 64) * 128 + n4;
#pragma unroll 4
      for (int i = 0; i < 32; ++i) { const int p = half + 2 * i;
          const f32x4 h4 = __builtin_nontemporal_load((const f32x4*)(H0 + (size_t)p * 128));
          const f32x4 xw4 = *(const LAS f32x4*)(xw + (wave * 64 + p) * 4);
          const f32x4 hn = ea * h4 + xw4[0] * b4[0] + xw4[1] * b4[1] + xw4[2] * b4[2] + xw4[3] * b4[3];
          __builtin_nontemporal_store(hn, (f32x4*)(H1 + (size_t)p * 128));
          float part[4];
#pragma unroll
          for (int t = 0; t < 4; ++t) { part[t] = (c4[t][0] * h4[0] + c4[t][1] * h4[1]) + (c4[t][2] * h4[2] + c4[t][3] * h4[3]);
              part[t] += __shfl_xor(part[t], 1); part[t] += __shfl_xor(part[t], 2); part[t] += __shfl_xor(part[t], 4); part[t] += __shfl_xor(part[t], 8); part[t] += __shfl_xor(part[t], 16); }
          if ((lane & 31) == 0) {
#pragma unroll
              for (int t = 0; t < 4; ++t) yp[(wave * 4 + t) * 64 + p] = part[t]; } } }
    __syncthreads();
    { const int p = lane; const float dskip = A.in[I_DSKIP][hd];
#pragma unroll
      for (int t = 0; t < 4; ++t) { float y = __expf(acS[wave * 4 + t]) * yp[(wave * 4 + t) * 64 + p];
#pragma unroll
          for (int s = 0; s < 4; ++s) if (s <= t) y += CBs[t * 4 + s] * __expf(acS[wave * 4 + t] - acS[wave * 4 + s]) * dtS[wave * 4 + s] * xf[s * 512 + wave * 64 + p];
          y += dskip * xf[t * 512 + wave * 64 + p];
          const int row = rowb + t, col = hd * 64 + p; const float z = bf2f(PROJ[(size_t)row * NPROJ + 16384 + col]); const float pre = y * silu(z);
          const float ss = wave_sum(pre * pre); if (lane == 0) atomicAdd(NRM + (size_t)row * 16 + 8 + gi, ss);
          MIX[(size_t)row * 8192 + 4096 + col] = (bf16)f2bf(pre * snorm[col]); } }
    __syncthreads();
}

__global__ void __launch_bounds__(NTHREADS, 2) mk_fwd(Args args) {
    extern __shared__ __attribute__((aligned(16))) unsigned char lds_raw[];
    LAS unsigned char* lds = (LAS unsigned char*)lds_raw;
    volatile LAS unsigned* MISC = (volatile LAS unsigned*)(lds + LDSCTL_OFF);
    const int tid = threadIdx.x, lane = tid & 63, wave = __builtin_amdgcn_readfirstlane(tid >> 6);
    const int G = gridDim.x, bid = blockIdx.x;
    const int gw = bid * NWAVES + wave, NGW = G * NWAVES, gt = bid * NTHREADS + tid, NGT = G * NTHREADS;
    unsigned char* ws = args.ws;
    unsigned* ctl = (unsigned*)(ws + WS_CTL);
    if (tid < 64) MISC[tid] = 0u;
    __syncthreads();
    XcdBarrier bar; bar.bar = ctl + CW_BAR; bar.x = 0; bar.st = nullptr;
    if (MK_N_LAUNCHES == 1) bar = xcd_barrier_post(ctl + CW_BAR, MISC + 8);
#define GRID_BAR() do { if (MK_N_LAUNCHES == 1) xcd_barrier(bar); } while (0)
    const int lo = args.ph_lo, hi = args.ph_hi;
#define IN(k) (lo <= (k) && (k) < hi)
#define BOTH(k) (IN(k) && IN((k) + 1))

    if (IN(0)) { p0_prologue(args, lds, gw, NGW, lane, wave); if (BOTH(0)) GRID_BAR(); }
    if (IN(1)) {
        pg8::Gemm g{(const bf16*)(ws + WS_XN), (const bf16*)(ws + WS_W1T), DM, DM, DM}; pg8::Order S; S.init(MTOK / 256, NW1 / 256, G, bid);
        pg8::EpiProj E{(bf16*)(ws + WS_PROJ), (float*)(ws + WS_GATES)};
        pg8::gemm_phase<pg8::EpiProj, pg8::Order>(lds, g, S, E);
        if (BOTH(1)) GRID_BAR();
    }
    if (IN(2)) {
        const bf16* PROJ = (const bf16*)(ws + WS_PROJ);
        conv_phase<4096>(PROJ, args.in[I_MCONV], args.in[I_MCW], args.in[I_MCB], (bf16*)(ws + WS_UC), args.out + O_PMCONV, args.out + O_SMCONV, gt, NGT);
        conv_phase<6144>(PROJ + 20480, args.in[I_SCONV], args.in[I_SCW], args.in[I_SCB], (bf16*)(ws + WS_XBC), args.out + O_PSCONV, args.out + O_SSCONV, gt, NGT);
        gate_scans(args, gw, NGW, lane);
        if (BOTH(2)) GRID_BAR();
    }
    if (IN(3)) {
        { pg8::Gemm g{(const bf16*)(ws + WS_UC), (const bf16*)(ws + WS_WQK), DM, 512, 512}; pg8::Order S; S.init(MTOK / 256, 16, G, bid, 1, 512);
          pg8::EpiBf16 E{(bf16*)(ws + WS_QK), DM};
          pg8::gemm_phase<pg8::EpiBf16, pg8::Order>(lds, g, S, E); }
        { pg8::Gemm g{(const bf16*)(ws + WS_PB), (const bf16*)(ws + WS_WPT), 256, 256, 256}; pg8::Order S; S.init(MTOK / 256, 16, G, bid);
          pg8::EpiBf16 E{(bf16*)(ws + WS_PPB), DM};
          pg8::gemm_phase<pg8::EpiBf16, pg8::Order>(lds, g, S, E); }
        if (BOTH(3)) GRID_BAR();
    }
    if (IN(4)) {
        for (int it = bid; it < 256; it += G) mlstm_prompt_item(args, lds, it, tid, lane, wave);
        for (int it = bid; it < 256; it += G) ssd_prompt_item(args, lds, it, tid, lane, wave);
        for (int it = bid; it < 1024; it += G) mlstm_sample_item(args, lds, it, tid, lane, wave);
        for (int it = bid; it < 1024; it += G) ssd_sample_item(args, lds, it, tid, lane, wave);
        if (BOTH(4)) GRID_BAR();
    }
    if (IN(5)) {
        bf16* MIX = (bf16*)(ws + WS_MIX); const float* NRM = (const float*)(ws + WS_NRM);
        for (int i = gt; i < MTOK * 1024; i += NGT) { const int row = i >> 10, ch = i & 1023, grp = ch >> 6;
            const float rstd = rsqrtf(NRM[(size_t)row * 16 + grp] * (1.f / 512.f) + EPS);
            v4u v = *(v4u*)(MIX + (size_t)row * 8192 + ch * 8);
            v.x = pk2(bflo(v.x) * rstd, bfhi(v.x) * rstd); v.y = pk2(bflo(v.y) * rstd, bfhi(v.y) * rstd); v.z = pk2(bflo(v.z) * rstd, bfhi(v.z) * rstd); v.w = pk2(bflo(v.w) * rstd, bfhi(v.w) * rstd);
            *(v4u*)(MIX + (size_t)row * 8192 + ch * 8) = v; }
        if (BOTH(5)) GRID_BAR();
    }
    if (IN(6)) {
        pg8::Gemm g{(const bf16*)(ws + WS_MIX), (const bf16*)(ws + WS_W2T), 8192, 8192, 8192}; pg8::Order S; S.init(MTOK / 256, 16, G, bid);
        pg8::EpiX1 E{args.in[I_XP], args.in[I_XS], args.in[I_PLENORM], (float*)(ws + WS_X1), (bf16*)(ws + WS_X1G), (float*)(ws + WS_RS1)};
        pg8::gemm_phase<pg8::EpiX1, pg8::Order>(lds, g, S, E);
        if (BOTH(6)) GRID_BAR();
    }
    if (IN(7)) {
        pg8::Gemm g{(const bf16*)(ws + WS_X1G), (const bf16*)(ws + WS_WGT), DM, DM, DM}; pg8::Order S; S.init(MTOK / 256, 16, G, bid);
        pg8::EpiGate E{(const float*)(ws + WS_X1), (const bf16*)(ws + WS_PPB), (const float*)(ws + WS_RS1), args.out + O_Y, (float*)(ws + WS_RS2)};
        pg8::gemm_phase<pg8::EpiGate, pg8::Order>(lds, g, S, E);
        if (BOTH(7)) GRID_BAR();
    }
    if (IN(8)) {
        const float* RS2 = (const float*)(ws + WS_RS2); const float* fn = args.in[I_FNORM]; float* Y = args.out + O_Y;
        for (int i = gt; i < MTOK * 1024; i += NGT) { const int row = i >> 10, c4 = (i & 1023) * 4;
            const float rstd = rsqrtf(RS2[row] * (1.f / DM) + EPS);
            const f32x4 g4 = *(const f32x4*)(fn + c4); f32x4 v = *(f32x4*)(Y + (size_t)row * DM + c4);
            v = v * rstd * g4; *(f32x4*)(Y + (size_t)row * DM + c4) = v; }
    }
#undef IN
#undef BOTH
#undef GRID_BAR
}

extern "C" void kernel_launch(void* const* d_in, const int* in_sizes, int n_in, void* d_out, int out_size, void* d_ws, size_t ws_size, hipStream_t stream) {
    static int grid = 0;
    if (grid == 0) {
        if (n_in != N_IN || (size_t)out_size != O_END || ws_size < WS_END) { fprintf(stderr, "kernel_launch: unexpected sizes n_in %d out %d ws %zu\n", n_in, out_size, ws_size); grid = -1; return; }
        int dev = 0, cus = 0, per_cu = 0;
        if (hipGetDevice(&dev) != hipSuccess || hipDeviceGetAttribute(&cus, hipDeviceAttributeMultiprocessorCount, dev) != hipSuccess) { grid = -1; return; }
        if (hipFuncSetAttribute((const void*)mk_fwd, hipFuncAttributeMaxDynamicSharedMemorySize, LDS_BYTES) != hipSuccess) { fprintf(stderr, "kernel_launch: hipFuncSetAttribute failed\n"); grid = -1; return; }
        if (hipOccupancyMaxActiveBlocksPerMultiprocessor(&per_cu, (const void*)mk_fwd, NTHREADS, LDS_BYTES) != hipSuccess || per_cu < 1) { fprintf(stderr, "kernel_launch: occupancy query says %d\n", per_cu); }
        (void)hipGetLastError();
        grid = cus;
    }
    if (grid < 0) return;
    if (hipMemsetAsync((char*)d_ws + WS_CTL, 0, CTL_ZERO_BYTES, stream) != hipSuccess) return;
    Args a{};
    for (int i = 0; i < N_IN; ++i) a.in[i] = (const float*)d_in[i];
    a.out = (float*)d_out; a.ws = (unsigned char*)d_ws;
    constexpr int NPH = 9;
    if (MK_N_LAUNCHES == 1) { a.ph_lo = 0; a.ph_hi = NPH; hipLaunchKernelGGL(mk_fwd, dim3(grid), dim3(NTHREADS), LDS_BYTES, stream, a); }
    else for (int p = 0; p < NPH; ++p) { a.ph_lo = p; a.ph_hi = p + 1; hipLaunchKernelGGL(mk_fwd, dim3(grid), dim3(NTHREADS), LDS_BYTES, stream, a); }
}
```

```cpp
#include <hip/hip_runtime.h>
#include <cstdio>

#ifndef PROBE_DUP
#define PROBE_DUP -1
#endif
#ifndef MK_N_LAUNCHES
#define MK_N_LAUNCHES 1
#endif

#define GAS __attribute__((address_space(1)))
#define LAS __attribute__((address_space(3)))
typedef unsigned short bf16;
typedef unsigned v4u __attribute__((ext_vector_type(4)));
typedef unsigned v2u __attribute__((ext_vector_type(2)));
typedef float f32x4 __attribute__((ext_vector_type(4)));
typedef float f32x2 __attribute__((ext_vector_type(2)));
typedef short bf16x8 __attribute__((ext_vector_type(8)));

constexpr int NWAVES = 8, NTHREADS = 512;
constexpr int MTOK = 8704, MPR = 8192, DM = 4096, SEQ = 2048;
constexpr int NPROJ = 26624, NW1 = 26880, INCOLS = 26704;
constexpr float EPS = 1e-6f;
enum { I_XP = 0, I_XS, I_PP, I_PS, I_MC, I_MN, I_MM, I_MCONV, I_SSSM, I_SCONV, I_NORMIN, I_WIN, I_BIG, I_BFG, I_MCW, I_MCB, I_WQ, I_WK, I_MNORM,
       I_SCW, I_SCB, I_DTB, I_ALOG, I_DSKIP, I_SNORM, I_WOUT, I_PLEPROJ, I_PLEGATE, I_PLENORM, I_FNORM, N_IN };
constexpr size_t O_Y = 0, O_PC = 35651584, O_PN = 39845888, O_PM = 39854080, O_PMCONV = 39854112, O_PSSM = 39903264, O_PSCONV = 42000416,
                 O_SC = 42074144, O_SN = 176291872, O_SM = 176554016, O_SMCONV = 176555040, O_SSSM = 178127904, O_SSCONV = 245236768, O_END = 247596064;
constexpr size_t MiB = 1u << 20;
constexpr size_t WS_CTL = 0, CTL_ZERO_BYTES = 4 * MiB;
constexpr size_t WS_NRM = 1 * MiB, WS_RS1 = 2 * MiB, WS_RS2 = 2 * MiB + 65536;
constexpr size_t WS_W1T = 4 * MiB, WS_W2T = 214 * MiB, WS_WGT = 278 * MiB, WS_WPT = 310 * MiB, WS_WQK = 312 * MiB, WS_XN = 316 * MiB, WS_PB = 384 * MiB,
                 WS_PROJ = 389 * MiB, WS_GATES = 831 * MiB, WS_UC = 840 * MiB, WS_QK = 908 * MiB, WS_XBC = 976 * MiB, WS_MG = 1078 * MiB, WS_SG = 1080 * MiB,
                 WS_MIX = 1085 * MiB, WS_X1 = 1221 * MiB, WS_X1G = 1357 * MiB, WS_PPB = 1425 * MiB,
                 WS_KWT = 1493 * MiB, WS_XWT = 1525 * MiB, WS_BMT = 1589 * MiB, WS_KWS = 1605 * MiB, WS_NALL = 1606 * MiB, WS_DENI = 1607 * MiB, WS_CS = 1608 * MiB, WS_MPD = 1609 * MiB, WS_END = 1610 * MiB;
constexpr size_t WS_NUMI = WS_UC, WS_INTER = WS_XN, WS_YI = WS_W1T, WS_YS = WS_W1T + 64 * MiB, WS_VT = WS_W1T + 128 * MiB;
constexpr int CW_TMO = 0, CW_BAR = 4096;
constexpr int LDSCTL_OFF = 131072, LDS_BYTES = 147456;

__device__ __forceinline__ unsigned f2bf(float f) { unsigned u = __builtin_bit_cast(unsigned, f); return (u + 0x7fffu + ((u >> 16) & 1u)) >> 16; }
typedef __bf16 bf16x2_t __attribute__((ext_vector_type(2)));
__device__ __forceinline__ unsigned pk2(float lo, float hi) { const f32x2 v = {lo, hi}; return __builtin_bit_cast(unsigned, __builtin_convertvector(v, bf16x2_t)); }
__device__ __forceinline__ float bflo(unsigned w) { return __builtin_bit_cast(float, w << 16); }
__device__ __forceinline__ float bfhi(unsigned w) { return __builtin_bit_cast(float, w & 0xffff0000u); }
__device__ __forceinline__ float bf2f(bf16 b) { return __builtin_bit_cast(float, (unsigned)b << 16); }
__device__ __forceinline__ float sigm(float x) { return 1.f / (1.f + __expf(-x)); }
__device__ __forceinline__ float silu(float x) { return x / (1.f + __expf(-x)); }
__device__ __forceinline__ float softplus(float x) { return fmaxf(x, 0.f) + log1pf(__expf(-fabsf(x))); }
__device__ __forceinline__ float softcap(float x) { return 15.f * tanhf(x * (1.f / 15.f)); }
__device__ __forceinline__ float wave_sum(float v) {
#pragma unroll
    for (int o = 1; o < 64; o <<= 1) v += __shfl_xor(v, o);
    return v;
}
#define LDS_WAIT() asm volatile("s_waitcnt lgkmcnt(0)" ::: "memory")

namespace pg8 {
constexpr int BM = 256, BK = 64, HALF = 128, HTB = HALF * BK * 2, STAGE_BYTES = 8 * HTB, NXCD = 8, WGM = 8;
__host__ __device__ __forceinline__ int lds_byte(int r, int c) { const int st = (r >> 4) * 2 + (c >> 5), rr = r & 15, cc = c & 31, ob = rr * 64 + cc * 2; return st * 1024 + (ob ^ (((ob >> 9) & 1) << 5)); }
__host__ __device__ __forceinline__ void stage_rc(int b, int& R, int& C) { const int st = b / 1024, sb = b % 1024, swz = sb ^ (((sb >> 9) & 1) << 5); R = (st >> 1) * 16 + swz / 64; C = (st & 1) * 32 + (swz % 64) / 2; }
__host__ __device__ __forceinline__ int perm32(int rho) { const int n = rho >> 4, i = rho & 15; return 8 * (i >> 2) + 4 * n + (i & 3); }
struct Unit { int pm, pn; };
struct Gemm { const bf16* A; const bf16* Bt; int lda, ldb, K; };
struct Order {
    int nM, nN, nwg, G, c, kshift, kmul, rep;
    __device__ void init(int nM_, int nN_, int G_, int c_, int kshift_ = 0, int kmul_ = 0, int rep_ = 1) { nM = nM_; nN = nN_; nwg = nM * nN; G = G_; c = c_; kshift = kshift_; kmul = kmul_; rep = rep_; }
    __device__ bool next(int i, Unit& u) const {
        const int L = i * G + c; if (L >= nwg * rep) return false;
        int wgid = (rep == 1) ? L : (L % nwg); { const int q = nwg / NXCD, r = nwg % NXCD, xcd = wgid % NXCD, off = wgid / NXCD; wgid = (xcd < r ? xcd * (q + 1) : r * (q + 1) + (xcd - r) * q) + off; }
        const int nig = WGM * nN, gid = wgid / nig, fm = gid * WGM, gsz = (nM - fm) < WGM ? (nM - fm) : WGM;
        u.pm = fm + ((wgid % nig) % gsz); u.pn = (wgid % nig) / gsz; return true;
    }
    __device__ __forceinline__ int a_koff(const Unit& u) const { return (u.pn >> kshift) * kmul; }
    __device__ __forceinline__ void a_ready(const Unit&) const {}
    __device__ __forceinline__ void done(const Unit&) const {}
};

template <class Epi, class Sched, bool ALIGN_EPI = true>
__device__ __forceinline__ void gemm_phase(LAS unsigned char* lds, const Gemm g, const Sched& S, const Epi& E) {
    const int tid = threadIdx.x, wid = __builtin_amdgcn_readfirstlane(tid >> 6), lane = tid & 63, wr = wid >> 2, wc = wid & 3, fr = lane & 15, fq = lane >> 4;
    const int K = g.K, nt = K / BK;
    unsigned voffA[2], voffB[2];
#pragma unroll
    for (int i = 0; i < 2; ++i) { int R, C; stage_rc(tid * 16 + i * 8192, R, C); const int Rb = Epi::PERM ? ((R & ~31) + perm32(R & 31)) : R;
        voffA[i] = (unsigned)(R * g.lda + C) * 2u; voffB[i] = (unsigned)(Rb * g.ldb + C) * 2u; }
    const size_t kstep = (size_t)(BK * 2);
    const size_t hstepA = (size_t)HALF * g.lda * 2, hstepB = (size_t)HALF * g.ldb * 2;
    const size_t tstepA = 2 * hstepA, tstepB = 2 * hstepB;
    const unsigned ldsw = (unsigned)wid * 1024u;
    const int aoff = lds_byte(wr * 64 + fr, fq * 8), boff = lds_byte(wc * 32 + fr, fq * 8);
#define PG8_SA(b, h) (((b) * 2 + (h)) * HTB)
#define PG8_SB(b, h) ((4 + (b) * 2 + (h)) * HTB)
#define PG8_STAGE(bufoff, gbase, voff) do { _Pragma("unroll") for (int _i = 0; _i < 2; ++_i) \
        __builtin_amdgcn_global_load_lds((const unsigned*)((const char*)(gbase) + (voff)[_i]), (LAS unsigned*)(lds + (bufoff) + ldsw + _i * 8192), 16, 0, 0); } while (0)
#define PG8_LDA(dst, b, h) do { _Pragma("unroll") for (int m = 0; m < 4; ++m) _Pragma("unroll") for (int k = 0; k < 2; ++k) dst[m][k] = *(const LAS bf16x8*)(lds + PG8_SA(b, h) + aoff + m * 2048 + k * 1024); } while (0)
#define PG8_LDB(dst, b, h) do { _Pragma("unroll") for (int n = 0; n < 2; ++n) _Pragma("unroll") for (int k = 0; k < 2; ++k) dst[n][k] = *(const LAS bf16x8*)(lds + PG8_SB(b, h) + boff + n * 2048 + k * 1024); } while (0)
#define PG8_MMA(ai, bj, At, Bt) do { __builtin_amdgcn_s_setprio(1); _Pragma("unroll") for (int m = 0; m < 4; ++m) _Pragma("unroll") for (int n = 0; n < 2; ++n) _Pragma("unroll") for (int k = 0; k < 2; ++k) \
        acc[ai][bj][m][n] = __builtin_amdgcn_mfma_f32_16x16x32_bf16(Bt[n][k], At[m][k], acc[ai][bj][m][n], 0, 0, 0); __builtin_amdgcn_s_setprio(0); } while (0)
#define PG8_WAIT_V(n) asm volatile("s_waitcnt vmcnt(" #n ")" ::: "memory")
#define PG8_WAIT_L(n) asm volatile("s_waitcnt lgkmcnt(" #n ")" ::: "memory")
#define PG8_BAR __builtin_amdgcn_s_barrier()
#define PG8_SCHED __builtin_amdgcn_sched_barrier(0)
    Unit cur, nxt; int ui = 0;
    if (!S.next(0, cur)) return;
    f32x4 acc[2][2][4][2];
#pragma unroll
    for (int a = 0; a < 2; ++a)
#pragma unroll
        for (int b = 0; b < 2; ++b)
#pragma unroll
            for (int m = 0; m < 4; ++m)
#pragma unroll
                for (int n = 0; n < 2; ++n) acc[a][b][m][n] = (f32x4){0.f, 0.f, 0.f, 0.f};
    bf16x8 At[4][2], B0[2][2], B1[2][2];
    const char* cA = (const char*)g.A + (size_t)cur.pm * tstepA + (size_t)S.a_koff(cur) * 2; const char* cB = (const char*)g.Bt + (size_t)cur.pn * tstepB;
    S.a_ready(cur);
    PG8_STAGE(PG8_SB(0, 0), cB, voffB); PG8_STAGE(PG8_SB(0, 1), cB + hstepB, voffB); PG8_STAGE(PG8_SA(0, 0), cA, voffA); PG8_STAGE(PG8_SA(0, 1), cA + hstepA, voffA);
    if (wr == 1) PG8_BAR;
    PG8_WAIT_V(2); PG8_BAR;
    PG8_STAGE(PG8_SB(1, 0), cB + kstep, voffB); PG8_STAGE(PG8_SA(1, 0), cA + kstep, voffA); PG8_STAGE(PG8_SB(1, 1), cB + hstepB + kstep, voffB);
    PG8_WAIT_V(6); PG8_BAR;
    for (;;) {
        const bool has_next = S.next(ui + 1, nxt);
        const char* nA = has_next ? (const char*)g.A + (size_t)nxt.pm * tstepA + (size_t)S.a_koff(nxt) * 2 : cA; const char* nB = has_next ? (const char*)g.Bt + (size_t)nxt.pn * tstepB : cB;
        for (int t = 0; t < nt; t += 2) {
            const bool last = (t == nt - 2);
            const char* a1 = cA + (size_t)(t + 1) * kstep;
            const char* a2 = last ? nA : cA + (size_t)(t + 2) * kstep; const char* b2 = last ? nB : cB + (size_t)(t + 2) * kstep;
            const char* a3 = a2 + kstep; const char* b3 = b2 + kstep;
            if (last && has_next) S.a_ready(nxt);
            PG8_LDB(B0, 0, 0); PG8_LDB(B1, 0, 1); PG8_SCHED; PG8_LDA(At, 0, 0); PG8_STAGE(PG8_SA(1, 1), a1 + hstepA, voffA);
            PG8_WAIT_V(8); PG8_WAIT_L(0); PG8_BAR; PG8_MMA(0, 0, At, B0); PG8_MMA(0, 1, At, B1); PG8_BAR; PG8_SCHED;
            PG8_LDA(At, 0, 1); PG8_STAGE(PG8_SB(0, 0), b2, voffB); PG8_STAGE(PG8_SB(0, 1), b2 + hstepB, voffB); PG8_STAGE(PG8_SA(0, 0), a2, voffA);
            PG8_WAIT_V(8); PG8_WAIT_L(0); PG8_BAR; PG8_MMA(1, 0, At, B0); PG8_MMA(1, 1, At, B1); PG8_BAR; PG8_SCHED;
            PG8_LDB(B0, 1, 0); PG8_LDB(B1, 1, 1); PG8_SCHED; PG8_LDA(At, 1, 0); PG8_STAGE(PG8_SA(0, 1), a2 + hstepA, voffA);
            PG8_WAIT_V(8); PG8_WAIT_L(0); PG8_BAR; PG8_MMA(0, 0, At, B0); PG8_MMA(0, 1, At, B1); PG8_BAR; PG8_SCHED;
            PG8_LDA(At, 1, 1); PG8_STAGE(PG8_SB(1, 0), b3, voffB); PG8_STAGE(PG8_SB(1, 1), b3 + hstepB, voffB); PG8_STAGE(PG8_SA(1, 0), a3, voffA);
            PG8_WAIT_V(8); PG8_WAIT_L(0); PG8_BAR; PG8_MMA(1, 0, At, B0); PG8_MMA(1, 1, At, B1); PG8_BAR; PG8_SCHED;
        }
        if constexpr (ALIGN_EPI) { if (wr == 0) PG8_BAR; }
        E(acc, cur, wr, wc, fr, fq); S.done(cur);
        if (!has_next) break;
#pragma unroll
        for (int a = 0; a < 2; ++a)
#pragma unroll
            for (int b = 0; b < 2; ++b)
#pragma unroll
                for (int m = 0; m < 4; ++m)
#pragma unroll
                    for (int n = 0; n < 2; ++n) acc[a][b][m][n] = (f32x4){0.f, 0.f, 0.f, 0.f};
        cur = nxt; cA = nA; cB = nB; ++ui;
        if constexpr (ALIGN_EPI) { if (wr == 1) PG8_BAR; }
    }
    PG8_WAIT_V(0);
    if constexpr (!ALIGN_EPI) { if (wr == 0) PG8_BAR; }
    PG8_BAR;
#undef PG8_SA
#undef PG8_SB
#undef PG8_STAGE
#undef PG8_LDA
#undef PG8_LDB
#undef PG8_MMA
#undef PG8_WAIT_V
#undef PG8_WAIT_L
#undef PG8_BAR
#undef PG8_SCHED
}

struct EpiBf16 {
    static constexpr bool PERM = true;
    bf16* O; int ldc;
    __device__ __forceinline__ void operator()(const f32x4 (&acc)[2][2][4][2], const Unit& u, int wr, int wc, int fr, int fq) const {
        const int row0 = u.pm * BM + wr * 64 + fr, col0 = u.pn * BM + wc * 32 + 8 * fq;
#pragma unroll
        for (int ai = 0; ai < 2; ++ai)
#pragma unroll
            for (int m = 0; m < 4; ++m) { bf16* rowp = O + (size_t)(row0 + ai * HALF + m * 16) * ldc + col0;
#pragma unroll
                for (int bj = 0; bj < 2; ++bj) { const f32x4 v0 = acc[ai][bj][m][0], v1 = acc[ai][bj][m][1];
                    v4u w; w.x = pk2(v0[0], v0[1]); w.y = pk2(v0[2], v0[3]); w.z = pk2(v1[0], v1[1]); w.w = pk2(v1[2], v1[3]);
                    *(v4u*)(rowp + bj * HALF) = w; } }
    }
};
struct EpiProj {
    static constexpr bool PERM = true;
    bf16* O; float* Gt;
    __device__ __forceinline__ void operator()(const f32x4 (&acc)[2][2][4][2], const Unit& u, int wr, int wc, int fr, int fq) const {
        const int row0 = u.pm * BM + wr * 64 + fr;
        if (u.pn < 104) {
            const int col0 = u.pn * BM + wc * 32 + 8 * fq;
#pragma unroll
            for (int ai = 0; ai < 2; ++ai)
#pragma unroll
                for (int m = 0; m < 4; ++m) { bf16* rowp = O + (size_t)(row0 + ai * HALF + m * 16) * NPROJ + col0;
#pragma unroll
                    for (int bj = 0; bj < 2; ++bj) { const f32x4 v0 = acc[ai][bj][m][0], v1 = acc[ai][bj][m][1];
                        v4u w; w.x = pk2(v0[0], v0[1]); w.y = pk2(v0[2], v0[3]); w.z = pk2(v1[0], v1[1]); w.w = pk2(v1[2], v1[3]);
                        *(v4u*)(rowp + bj * HALF) = w; } }
        } else {
            const int col0 = wc * 32 + 8 * fq;
#pragma unroll
            for (int ai = 0; ai < 2; ++ai)
#pragma unroll
                for (int m = 0; m < 4; ++m) { float* rowp = Gt + (size_t)(row0 + ai * HALF + m * 16) * 256 + col0;
#pragma unroll
                    for (int bj = 0; bj < 2; ++bj)
#pragma unroll
                        for (int n = 0; n < 2; ++n) *(f32x4*)(rowp + bj * HALF + 4 * n) = acc[ai][bj][m][n]; }
        }
    }
};
struct EpiX1 {
    static constexpr bool PERM = false;
    const float* xp; const float* xs; const float* gn; float* X1; bf16* X1G; float* RS; float ssw;
    __device__ __forceinline__ void operator()(const f32x4 (&acc)[2][2][4][2], const Unit& u, int wr, int wc, int fr, int fq) const {
        const int row0 = u.pm * BM + wr * 64 + fr, col0 = u.pn * BM + wc * 32 + 4 * fq;
#pragma unroll
        for (int ai = 0; ai < 2; ++ai)
#pragma unroll
            for (int m = 0; m < 4; ++m) { const int row = row0 + ai * HALF + m * 16;
                const float* xrow = (row < MPR ? xp + (size_t)row * DM : xs + (size_t)(row - MPR) * DM) + col0; const size_t off = (size_t)row * DM + col0; float ss = 0.f;
#pragma unroll
                for (int bj = 0; bj < 2; ++bj)
#pragma unroll
                    for (int n = 0; n < 2; ++n) { const int co = bj * HALF + n * 16; const f32x4 v = *(const f32x4*)(xrow + co) + acc[ai][bj][m][n];
                        *(f32x4*)(X1 + off + co) = v; ss += (v[0] * v[0] + v[1] * v[1]) + (v[2] * v[2] + v[3] * v[3]);
                        const f32x4 gv = *(const f32x4*)(gn + col0 + co); v2u w; w.x = pk2(v[0] * gv[0], v[1] * gv[1]); w.y = pk2(v[2] * gv[2], v[3] * gv[3]);
                        *(v2u*)(X1G + off + co) = w; }
                ss += __shfl_xor(ss, 16); ss += __shfl_xor(ss, 32);
                if (fq == 0) atomicAdd(RS + row, ss * ssw); }
    }
};
struct EpiGate {
    static constexpr bool PERM = false;
    const float* X1; const bf16* PP; const float* RS1; float* out; float* RS2; float ssw;
    __device__ __forceinline__ void operator()(const f32x4 (&acc)[2][2][4][2], const Unit& u, int wr, int wc, int fr, int fq) const {
        const int row0 = u.pm * BM + wr * 64 + fr, col0 = u.pn * BM + wc * 32 + 4 * fq;
#pragma unroll
        for (int ai = 0; ai < 2; ++ai)
#pragma unroll
            for (int m = 0; m < 4; ++m) { const int row = row0 + ai * HALF + m * 16; const size_t off = (size_t)row * DM + col0; float ss = 0.f;
                const float rstd = rsqrtf(RS1[row] * (1.f / DM) + EPS);
#pragma unroll
                for (int bj = 0; bj < 2; ++bj)
#pragma unroll
                    for (int n = 0; n < 2; ++n) { const int co = bj * HALF + n * 16; const f32x4 a = acc[ai][bj][m][n] * rstd; const v2u pw = *(const v2u*)(PP + off + co);
                        const f32x4 x1 = *(const f32x4*)(X1 + off + co); f32x4 v;
                        v[0] = x1[0] + sigm(a[0]) * bflo(pw.x); v[1] = x1[1] + sigm(a[1]) * bfhi(pw.x); v[2] = x1[2] + sigm(a[2]) * bflo(pw.y); v[3] = x1[3] + sigm(a[3]) * bfhi(pw.y);
                        *(f32x4*)(out + off + co) = v; ss += (v[0] * v[0] + v[1] * v[1]) + (v[2] * v[2] + v[3] * v[3]); }
                ss += __shfl_xor(ss, 16); ss += __shfl_xor(ss, 32);
                if (fq == 0) atomicAdd(RS2 + row, ss * ssw); }
    }
};
}

#define XB_TMO      128
#define XB_XCNT(j)  (256  + 64 * (j))
#define XB_XSUB(j)  (1280 + 64 * (j))
#define XB_XGEN(j)  (2304 + 64 * (j))
#define XB_TOP      3328
#define XB_TOPGEN   3392
#define XCD_BAR_WORDS 3456
#define XB_SPIN_CAP (1u << 18)
__device__ __forceinline__ unsigned xb_ld(unsigned* p)              { return __hip_atomic_load(p, __ATOMIC_RELAXED, __HIP_MEMORY_SCOPE_AGENT); }
__device__ __forceinline__ unsigned xb_add(unsigned* p, unsigned v) { return __hip_atomic_fetch_add(p, v, __ATOMIC_RELAXED, __HIP_MEMORY_SCOPE_AGENT); }
__device__ __forceinline__ unsigned xb_xcc_id() { return (unsigned)__builtin_amdgcn_s_getreg((3 << 11) | 20) & 0xFu; }
#define XB_SPIN(cond, bar) do { unsigned _sp = 0; while (cond) { __builtin_amdgcn_s_sleep(1); \
    if ((++_sp & 255u) == 0u) { if (xb_ld(&(bar)[XB_TMO])) break; if (_sp > XB_SPIN_CAP) { atomicAdd(&(bar)[XB_TMO], 1u); break; } } } } while (0)
struct XcdBarrier { unsigned* bar; unsigned x; volatile LAS unsigned* st; };
__device__ __forceinline__ XcdBarrier xcd_barrier_post(unsigned* bar, volatile LAS unsigned* st) {
    XcdBarrier b; b.bar = bar; b.x = xb_xcc_id(); b.st = st;
    if (threadIdx.x == 0) (void)xb_add(&bar[XB_XCNT(b.x)], 1u);
    return b;
}
__device__ __forceinline__ void xcd_barrier_complete(unsigned* bar, unsigned x, unsigned& nloc, unsigned& nx) {
    const unsigned G = gridDim.x * gridDim.y * gridDim.z;
    unsigned sum, cnt, mine, sp = 0u;
    for (;;) {
        sum = 0u; cnt = 0u; mine = 0u;
#pragma unroll
        for (unsigned j = 0; j < 16; ++j) { const unsigned c = xb_ld(&bar[XB_XCNT(j)]); sum += c; cnt += (c > 0u) ? 1u : 0u; mine = (j == x) ? c : mine; }
        if (sum == G) break;
        __builtin_amdgcn_s_sleep(1);
        if ((++sp & 255u) == 0u) { if (xb_ld(&bar[XB_TMO])) break; if (sp > XB_SPIN_CAP) { atomicAdd(&bar[XB_TMO], 1u); break; } }
    }
    nloc = mine > 0u ? mine : 1u; nx = cnt > 0u ? cnt : 1u;
}
__device__ __forceinline__ void xcd_barrier(const XcdBarrier& b) {
    asm volatile("s_waitcnt vmcnt(0)" ::: "memory");
    __syncthreads();
    if (threadIdx.x == 0) {
        unsigned* bar = b.bar;
        __builtin_amdgcn_s_waitcnt(0);
        unsigned nloc = b.st[0], nx = b.st[1];
        if (nloc == 0u) { xcd_barrier_complete(bar, b.x, nloc, nx); b.st[0] = nloc; b.st[1] = nx; }
        const unsigned old = xb_add(&bar[XB_XSUB(b.x)], 1u);
        const unsigned gen = old / nloc;
        if (old + 1u == (gen + 1u) * nloc) {
            __builtin_amdgcn_fence(__ATOMIC_RELEASE, "agent");
            asm volatile("s_waitcnt vmcnt(0)" ::: "memory");
            const unsigned og = xb_add(&bar[XB_TOP], 1u);
            const unsigned tg = og / nx;
            if (og + 1u == (tg + 1u) * nx) xb_add(&bar[XB_TOPGEN], 1u);
            else XB_SPIN(xb_ld(&bar[XB_TOPGEN]) == tg, bar);
            __builtin_amdgcn_fence(__ATOMIC_ACQUIRE, "agent");
            xb_add(&bar[XB_XGEN(b.x)], 1u);
            asm volatile("s_waitcnt vmcnt(0)" ::: "memory");
        } else {
            XB_SPIN(xb_ld(&bar[XB_XGEN(b.x)]) == gen, bar);
            __builtin_amdgcn_fence(__ATOMIC_ACQUIRE, "agent");
            asm volatile("s_waitcnt vmcnt(0)" ::: "memory");
        }
    }
    __syncthreads();
}

struct Args { const float* in[N_IN]; float* out; unsigned char* ws; int ph_lo, ph_hi; };

template <int K>
__device__ __forceinline__ f32x4 mma_nt(const LAS bf16* X, int ldx, const LAS bf16* Y, int ldy, f32x4 acc, int lane) {
    const int r = lane & 15, kq = (lane >> 4) * 8;
#pragma unroll
    for (int k0 = 0; k0 < K; k0 += 32) {
        const bf16x8 a = *(const LAS bf16x8*)(X + r * ldx + k0 + kq);
        const bf16x8 b = *(const LAS bf16x8*)(Y + r * ldy + k0 + kq);
        acc = __builtin_amdgcn_mfma_f32_16x16x32_bf16(a, b, acc, 0, 0, 0);
    }
    return acc;
}

__device__ __forceinline__ int w1_colmap(int n) { return n < 16384 ? n : (n < 26624 ? n + 16 : (n < 26640 ? n - 26624 + 16384 : (n < INCOLS ? n : -1))); }
template <bool MAP>
__device__ __forceinline__ void transpose_item(const float* W, int ldw, bf16* WT, int ldt, int k0, int n0, LAS float* scr, int lane, float scale) {
    const int nn = n0 + (lane & 31); const int oc = MAP ? w1_colmap(nn) : nn;
    const float* src = W + (size_t)k0 * ldw + (oc >= 0 ? oc : 0);
#pragma unroll 8
    for (int i = 0; i < 32; ++i) { const int kk = 2 * i + (lane >> 5); const float v = src[(size_t)kk * ldw]; scr[kk * 33 + (lane & 31)] = (oc >= 0) ? v * scale : 0.f; }
    LDS_WAIT(); asm volatile("" ::: "memory");
    const int c = lane & 7;
#pragma unroll
    for (int j = 0; j < 4; ++j) { const int n = (lane >> 3) + 8 * j; const LAS float* s = scr + (8 * c) * 33 + n;
        v4u o; o.x = pk2(s[0 * 33], s[1 * 33]); o.y = pk2(s[2 * 33], s[3 * 33]); o.z = pk2(s[4 * 33], s[5 * 33]); o.w = pk2(s[6 * 33], s[7 * 33]);
        *(v4u*)(WT + (size_t)(n0 + n) * ldt + k0 + 8 * c) = o; }
    LDS_WAIT(); asm volatile("" ::: "memory");
}
__device__ __forceinline__ void p0_prologue(const Args& A, LAS unsigned char* lds, int gw, int NGW, int lane, int wave) {
    LAS float* scr = (LAS float*)(lds + wave * 16384);
    unsigned char* ws = A.ws;
    constexpr int I1 = 64 * 840, I2 = 128 * 128, I3 = 64 * 128, I4 = 4 * 128, I5 = 1024;
    for (int it = gw; it < I1 + I2 + I3 + I4 + I5; it += NGW) {
        int r = it;
        if (r < I1) { transpose_item<true>(A.in[I_WIN], INCOLS, (bf16*)(ws + WS_W1T), DM, (r / 840) * 64, (r % 840) * 32, scr, lane, 1.f); continue; } r -= I1;
        if (r < I2) { transpose_item<false>(A.in[I_WOUT], DM, (bf16*)(ws + WS_W2T), 8192, (r / 128) * 64, (r % 128) * 32, scr, lane, 1.f); continue; } r -= I2;
        if (r < I3) { transpose_item<false>(A.in[I_PLEGATE], DM, (bf16*)(ws + WS_WGT), DM, (r / 128) * 64, (r % 128) * 32, scr, lane, 1.f); continue; } r -= I3;
        if (r < I4) { transpose_item<false>(A.in[I_PLEPROJ], DM, (bf16*)(ws + WS_WPT), 256, (r / 128) * 64, (r % 128) * 32, scr, lane, 1.f); continue; } r -= I4;
        { const int hw = r >> 6, h = hw >> 1, which = hw & 1, q = r & 63;
          const float* W = (which ? A.in[I_WK] : A.in[I_WQ]) + (size_t)h * 512 * 256;
          transpose_item<false>(W, 256, (bf16*)(ws + WS_WQK) + (size_t)(h * 512 + which * 256) * 512, 512, (q >> 3) * 64, (q & 7) * 32, scr, lane, which ? 0.0625f : 1.f); }
    }
    const float* gn = A.in[I_NORMIN];
    for (int m = gw; m < MTOK; m += NGW) {
        const float* xrow = m < MPR ? A.in[I_XP] + (size_t)m * DM : A.in[I_XS] + (size_t)(m - MPR) * DM;
        f32x4 v[16]; float s = 0.f;
#pragma unroll
        for (int j = 0; j < 16; ++j) { v[j] = ((const f32x4*)xrow)[lane + 64 * j]; s += (v[j][0] * v[j][0] + v[j][1] * v[j][1]) + (v[j][2] * v[j][2] + v[j][3] * v[j][3]); }
        const float rstd = rsqrtf(wave_sum(s) * (1.f / DM) + EPS);
        bf16* orow = (bf16*)(ws + WS_XN) + (size_t)m * DM;
#pragma unroll
        for (int j = 0; j < 16; ++j) { const f32x4 g4 = ((const f32x4*)gn)[lane + 64 * j]; v2u w; w.x = pk2(v[j][0] * rstd * g4[0], v[j][1] * rstd * g4[1]); w.y = pk2(v[j][2] * rstd * g4[2], v[j][3] * rstd * g4[3]);
            ((v2u*)orow)[lane + 64 * j] = w; }
    }
    { const int gt = gw * 64 + lane, NGT = NGW * 64;
      for (int i = gt; i < MTOK * 32; i += NGT) { const int row = i >> 5, c8 = (i & 31) * 8;
          const float* src = (row < MPR ? A.in[I_PP] + (size_t)row * 256 : A.in[I_PS] + (size_t)(row - MPR) * 256) + c8;
          const f32x4 a = *(const f32x4*)src, b = *(const f32x4*)(src + 4);
          v4u w; w.x = pk2(a[0], a[1]); w.y = pk2(a[2], a[3]); w.z = pk2(b[0], b[1]); w.w = pk2(b[2], b[3]);
          *(v4u*)((bf16*)(ws + WS_PB) + (size_t)row * 256 + c8) = w; } }
}

template <int NCH, int NT, bool PROMPT>
__device__ __forceinline__ void conv_part(const bf16* src  , const float* state_in, const float* w, const float* bias, bf16* dst, float* out_state, int gt, int NGT) {
    constexpr int CG = NCH / 8, NBLK = PROMPT ? SEQ / NT : 1, NSEQ = PROMPT ? 4 : 128;
    for (int it = gt; it < NSEQ * NBLK * CG; it += NGT) {
        const int cg = it % CG, q = it / CG, seq = q / NBLK, blk = q % NBLK, c0 = cg * 8;
        const int row0 = PROMPT ? seq * SEQ + blk * NT : MPR + seq * 4;
        v4u rows[NT]; float win[3][8];
#pragma unroll
        for (int i = 0; i < NT; ++i) rows[i] = *(const v4u*)(src + (size_t)(row0 + i) * NPROJ + c0);
        if (PROMPT) {
#pragma unroll
            for (int j = 0; j < 3; ++j) { v4u v = (v4u){0u, 0u, 0u, 0u}; if (blk != 0) v = *(const v4u*)(src + (size_t)(row0 - 3 + j) * NPROJ + c0);
                win[j][0] = bflo(v.x); win[j][1] = bfhi(v.x); win[j][2] = bflo(v.y); win[j][3] = bfhi(v.y); win[j][4] = bflo(v.z); win[j][5] = bfhi(v.z); win[j][6] = bflo(v.w); win[j][7] = bfhi(v.w); }
        } else {
#pragma unroll
            for (int j = 0; j < 3; ++j) { const float* sp = state_in + ((size_t)seq * 3 + j) * NCH + c0; const f32x4 a = *(const f32x4*)sp, b = *(const f32x4*)(sp + 4);
#pragma unroll
                for (int e = 0; e < 4; ++e) { win[j][e] = a[e]; win[j][4 + e] = b[e]; } }
        }
        float wv[4][8], bv[8];
#pragma unroll
        for (int j = 0; j < 4; ++j) { const f32x4 a = *(const f32x4*)(w + j * NCH + c0), b = *(const f32x4*)(w + j * NCH + c0 + 4);
#pragma unroll
            for (int e = 0; e < 4; ++e) { wv[j][e] = a[e]; wv[j][4 + e] = b[e]; } }
        { const f32x4 a = *(const f32x4*)(bias + c0), b = *(const f32x4*)(bias + c0 + 4);
#pragma unroll
          for (int e = 0; e < 4; ++e) { bv[e] = a[e]; bv[4 + e] = b[e]; } }
#pragma unroll
        for (int i = 0; i < NT; ++i) {
            const v4u v = rows[i];
            const float cur[8] = {bflo(v.x), bfhi(v.x), bflo(v.y), bfhi(v.y), bflo(v.z), bfhi(v.z), bflo(v.w), bfhi(v.w)};
            float y[8];
#pragma unroll
            for (int e = 0; e < 8; ++e) { y[e] = silu(bv[e] + wv[0][e] * win[0][e] + wv[1][e] * win[1][e] + wv[2][e] * win[2][e] + wv[3][e] * cur[e]); win[0][e] = win[1][e]; win[1][e] = win[2][e]; win[2][e] = cur[e]; }
            v4u o; o.x = pk2(y[0], y[1]); o.y = pk2(y[2], y[3]); o.z = pk2(y[4], y[5]); o.w = pk2(y[6], y[7]);
            *(v4u*)(dst + (size_t)(row0 + i) * NCH + c0) = o;
        }
        if (!PROMPT || blk == NBLK - 1) { float* op = out_state + (size_t)seq * 3 * NCH + c0;
#pragma unroll
            for (int j = 0; j < 3; ++j) { *(f32x4*)(op + j * NCH) = (f32x4){win[j][0], win[j][1], win[j][2], win[j][3]}; *(f32x4*)(op + j * NCH + 4) = (f32x4){win[j][4], win[j][5], win[j][6], win[j][7]}; } }
    }
}
template <int W> __device__ __forceinline__ float scan_add(float v, int lane) {
#pragma unroll
    for (int o = 1; o < W; o <<= 1) { const float t = __shfl_up(v, o, W); if ((lane & (W - 1)) >= o) v += t; }
    return v;
}
template <int W> __device__ __forceinline__ float scan_max(float v, int lane) {
#pragma unroll
    for (int o = 1; o < W; o <<= 1) { const float t = __shfl_up(v, o, W); if ((lane & (W - 1)) >= o) v = fmaxf(v, t); }
    return v;
}
__device__ __forceinline__ void gate_scans(const Args& A, int gw, int NGW, int lane) {
    const float* GT = (const float*)(A.ws + WS_GATES);
    f32x4* MG = (f32x4*)(A.ws + WS_MG); f32x2* SG = (f32x2*)(A.ws + WS_SG); f32x2* CS = (f32x2*)(A.ws + WS_CS);
    for (int it = gw; it < 512; it += NGW) {
        if (it < 128) {
            const int seq = it >> 5, c = it & 31, row = seq * SEQ + c * 64 + lane;
            const f32x4 g0 = *(const f32x4*)(GT + (size_t)row * 256), g1 = *(const f32x4*)(GT + (size_t)row * 256 + 4), g2 = *(const f32x4*)(GT + (size_t)row * 256 + 8), g3 = *(const f32x4*)(GT + (size_t)row * 256 + 12);
            const float gi[8] = {g0[0], g0[1], g0[2], g0[3], g1[0], g1[1], g1[2], g1[3]}, gf[8] = {g2[0], g2[1], g2[2], g2[3], g3[0], g3[1], g3[2], g3[3]};
#pragma unroll
            for (int h = 0; h < 8; ++h) {
                const float ig = softcap(gi[h] + A.in[I_BIG][h]), lf = -softplus(-softcap(gf[h] + A.in[I_BFG][h]));
                const float bc = scan_add<64>(lf, lane), g = ig - bc, gmax = scan_max<64>(g, lane);
                MG[(size_t)row * 8 + h] = (f32x4){bc, g, gmax, 0.f};
                if (lane == 63) CS[(seq * 8 + h) * 32 + c] = (f32x2){bc, gmax};
            }
        } else if (it < 256) {
            const int seq = it - 128, h = (lane >> 2) & 7, t = lane & 3, row = MPR + seq * 4 + t;
            const float m = A.in[I_MM][seq * 8 + h];
            const float ig = softcap(GT[(size_t)row * 256 + h] + A.in[I_BIG][h]), lf = -softplus(-softcap(GT[(size_t)row * 256 + 8 + h] + A.in[I_BFG][h]));
            const float bc = scan_add<4>(lf, lane), g = ig - bc, gmax = scan_max<4>(g, lane);
            const float mm = fmaxf(m, gmax), alpha = -mm, a = __expf(m - mm), ex = __expf(alpha - bc);
            if (lane < 32) { MG[(size_t)row * 8 + h] = (f32x4){alpha, g, a, ex}; if (t == 3) A.out[O_SM + seq * 8 + h] = bc + mm; }
        } else if (it < 384) {
            const int q = it - 256, seq = q >> 5, c = q & 31, hd = lane, rowb = seq * SEQ + c * 64;
            const float dtb = A.in[I_DTB][hd], Aneg = -__expf(A.in[I_ALOG][hd]); float ac = 0.f;
#pragma unroll 8
            for (int t = 0; t < 64; ++t) { const float dt = softplus(GT[(size_t)(rowb + t) * 256 + 16 + hd] + dtb); ac += dt * Aneg; SG[(size_t)(rowb + t) * 64 + hd] = (f32x2){dt, ac}; }
        } else {
            const int seq = it - 384, hd = lane; const float dtb = A.in[I_DTB][hd], Aneg = -__expf(A.in[I_ALOG][hd]); float ac = 0.f;
#pragma unroll
            for (int t = 0; t < 4; ++t) { const int row = MPR + seq * 4 + t; const float dt = softplus(GT[(size_t)row * 256 + 16 + hd] + dtb); ac += dt * Aneg; SG[(size_t)row * 64 + hd] = (f32x2){dt, ac}; }
        }
    }
}
__device__ __forceinline__ void mlstm_m_carry(const Args& A, int lane) {
    if (lane < 32) { const f32x2* CS = (const f32x2*)(A.ws + WS_CS); f32x2* MPD = (f32x2*)(A.ws + WS_MPD); float m = -INFINITY;
        for (int c = 0; c < 32; ++c) { const f32x2 cs = CS[lane * 32 + c]; const float mm = fmaxf(m, cs[1]); MPD[lane * 32 + c] = (f32x2){m, __expf(m - mm)}; m = cs[0] + mm; }
        A.out[O_PM + lane] = m; }
}

__device__ __forceinline__ bf16x8 as_bf16x8(v4u v) { return __builtin_bit_cast(bf16x8, v); }
__device__ __forceinline__ f32x4 mfma16(bf16x8 a, bf16x8 b, f32x4 c) { return __builtin_amdgcn_mfma_f32_16x16x32_bf16(a, b, c, 0, 0, 0); }
__device__ __forceinline__ v4u pack8(f32x4 a, f32x4 b) { v4u r; r.x = pk2(a[0], a[1]); r.y = pk2(a[2], a[3]); r.z = pk2(b[0], b[1]); r.w = pk2(b[2], b[3]); return r; }
__device__ __forceinline__ float sum8bf(v4u v) { return ((bflo(v.x) + bfhi(v.x)) + (bflo(v.y) + bfhi(v.y))) + ((bflo(v.z) + bfhi(v.z)) + (bflo(v.w) + bfhi(v.w))); }

constexpr int M1_Q = 0, M1_K = 33792, M1_VT = 70656, M1_P = 107520, M1_G = 116736;
__device__ __forceinline__ void m1_unit(const Args& A, LAS unsigned char* lds, int unit, int tid, int lane, int wave) {
    const int bh = unit >> 5, c = unit & 31, b = bh >> 3, h = bh & 7, row0 = b * SEQ + c * 64;
    LAS bf16* Qs = (LAS bf16*)(lds + M1_Q); LAS bf16* Ks = (LAS bf16*)(lds + M1_K); LAS bf16* Kw = Ks; LAS bf16* Vt = (LAS bf16*)(lds + M1_VT); LAS bf16* Ps = (LAS bf16*)(lds + M1_P);
    LAS float* aS = (LAS float*)(lds + M1_G); LAS float* gS = aS + 64; LAS float* wkS = aS + 128;
    const bf16* QK = (const bf16*)(A.ws + WS_QK); const bf16* PROJ = (const bf16*)(A.ws + WS_PROJ); const f32x4* MG = (const f32x4*)(A.ws + WS_MG); const f32x2* MPD = (const f32x2*)(A.ws + WS_MPD);
    bf16* NUMI = (bf16*)(A.ws + WS_NUMI); bf16* KWT = (bf16*)(A.ws + WS_KWT) + (size_t)unit * 16384; bf16* VTG = (bf16*)(A.ws + WS_VT) + (size_t)unit * 32768;
    float* KWS = (float*)(A.ws + WS_KWS); float* DENI = (float*)(A.ws + WS_DENI);
    const int l4 = lane >> 4, l15 = lane & 15;
    v4u vr0[4], vr1[4];
#pragma unroll
    for (int i = 0; i < 4; ++i) { const int piece = tid + NTHREADS * i, r = piece >> 5, cc = piece & 31;
        const bf16* sp = QK + (size_t)(row0 + r) * DM + h * 512 + cc * 8;
        const v4u q = *(const v4u*)sp, k = *(const v4u*)(sp + 256);
        const bf16* vp = PROJ + (size_t)(row0 + r) * NPROJ + 4096 + h * 512 + cc * 8;
        vr0[i] = *(const v4u*)vp; vr1[i] = *(const v4u*)(vp + 256);
        *(LAS v4u*)(Qs + r * 264 + cc * 8) = q; *(LAS v4u*)(Ks + r * 264 + cc * 8) = k; }
    if (tid < 64) { const f32x4 mg = MG[(size_t)(row0 + tid) * 8 + h]; const float mp = MPD[unit][0]; aS[tid] = -fmaxf(mp, mg[2]); gS[tid] = mg[1]; }
#define M1_VT_WRITE(vr) do { _Pragma("unroll") for (int i = 0; i < 4; ++i) { const int piece = tid + NTHREADS * i, r = piece >> 5, cc = piece & 31; const unsigned w_[4] = {vr[i].x, vr[i].y, vr[i].z, vr[i].w}; \
        _Pragma("unroll") for (int e = 0; e < 4; ++e) { Vt[(cc * 8 + 2 * e) * 72 + r] = (bf16)(w_[e] & 0xffffu); Vt[(cc * 8 + 2 * e + 1) * 72 + r] = (bf16)(w_[e] >> 16); } } } while (0)
    M1_VT_WRITE(vr0);
    __syncthreads();
    if (tid < 64) wkS[tid] = __expf(aS[63] + gS[tid]);
    { const int mt = wave >> 1;
#pragma unroll
      for (int e = 0; e < 2; ++e) { const int nt = (wave & 1) * 2 + e;
          const f32x4 acc = mma_nt<256>(Qs + mt * 16 * 264, 264, Ks + nt * 16 * 264, 264, (f32x4){0.f, 0.f, 0.f, 0.f}, lane);
#pragma unroll
          for (int i = 0; i < 4; ++i) { const int t = mt * 16 + 4 * l4 + i, s = nt * 16 + l15;
              const float p = (s <= t) ? acc[i] * __expf(aS[t] + gS[s]) : 0.f; Ps[t * 72 + s] = (bf16)f2bf(p); } } }
    unsigned kreg[4][4];
#pragma unroll
    for (int i = 0; i < 4; ++i) { const int pair = tid + NTHREADS * i, d = pair & 255, sg = pair >> 8;
#pragma unroll
        for (int e = 0; e < 4; ++e) kreg[i][e] = (unsigned)Ks[(sg * 8 + 2 * e) * 264 + d] | ((unsigned)Ks[(sg * 8 + 2 * e + 1) * 264 + d] << 16); }
    __syncthreads();
#pragma unroll
    for (int i = 0; i < 4; ++i) { const int pair = tid + NTHREADS * i, d = pair & 255, sg = pair >> 8; v4u w;
        w.x = pk2(bflo(kreg[i][0]) * wkS[sg * 8 + 0], bfhi(kreg[i][0]) * wkS[sg * 8 + 1]); w.y = pk2(bflo(kreg[i][1]) * wkS[sg * 8 + 2], bfhi(kreg[i][1]) * wkS[sg * 8 + 3]);
        w.z = pk2(bflo(kreg[i][2]) * wkS[sg * 8 + 4], bfhi(kreg[i][2]) * wkS[sg * 8 + 5]); w.w = pk2(bflo(kreg[i][3]) * wkS[sg * 8 + 6], bfhi(kreg[i][3]) * wkS[sg * 8 + 7]);
        *(LAS v4u*)(Kw + d * 72 + sg * 8) = w; }
    { const int t = tid >> 3, sg = tid & 7; float ps = sum8bf(*(const LAS v4u*)(Ps + t * 72 + sg * 8));
      ps += __shfl_xor(ps, 1); ps += __shfl_xor(ps, 2); ps += __shfl_xor(ps, 4);
      if (sg == 0) DENI[(size_t)(row0 + t) * 8 + h] = ps; }
    __syncthreads();
#define M1_NUMI(hf) do { const int tt = wave & 3, vbase = (wave >> 2) * 8; \
        _Pragma("unroll") for (int i = 0; i < 8; ++i) { const int vtile = vbase + i; \
            const f32x4 acc = mma_nt<64>(Vt + vtile * 16 * 72, 72, Ps + tt * 16 * 72, 72, (f32x4){0.f, 0.f, 0.f, 0.f}, lane); \
            v2u w_; w_.x = pk2(acc[0], acc[1]); w_.y = pk2(acc[2], acc[3]); \
            *(v2u*)(NUMI + (size_t)(row0 + tt * 16 + l15) * DM + h * 512 + (hf) * 256 + vtile * 16 + 4 * l4) = w_; } } while (0)
#define M1_VT_EXPORT(hf) do { _Pragma("unroll") for (int i = 0; i < 4; ++i) { const int pair = tid + NTHREADS * i, v = pair >> 3, sg = pair & 7; \
            *(v4u*)(VTG + (size_t)((hf) * 256 + v) * 64 + sg * 8) = *(const LAS v4u*)(Vt + v * 72 + sg * 8); } } while (0)
    M1_NUMI(0);
#pragma unroll
    for (int i = 0; i < 4; ++i) { const int pair = tid + NTHREADS * i, d = pair >> 3, sg = pair & 7; *(v4u*)(KWT + (size_t)d * 64 + sg * 8) = *(const LAS v4u*)(Kw + d * 72 + sg * 8); }
    if (tid < 256) { float s = 0.f;
#pragma unroll
        for (int i = 0; i < 8; ++i) s += sum8bf(*(const LAS v4u*)(Kw + tid * 72 + i * 8));
        KWS[(size_t)unit * 256 + tid] = s; }
    M1_VT_EXPORT(0);
    __syncthreads();
    M1_VT_WRITE(vr1);
    __syncthreads();
    M1_NUMI(1);
    M1_VT_EXPORT(1);
    __syncthreads();
#undef M1_VT_WRITE
#undef M1_NUMI
#undef M1_VT_EXPORT
}

constexpr int S1_C = 0, S1_B = 17408, S1_CB = 0, S1_BT = 34816, S1_XT = 53248, S1_DT = 126976, S1_AC = 129024;
__device__ __forceinline__ void s1_unit(const Args& A, LAS unsigned char* lds, int unit, int tid, int lane, int wave) {
    const int bg = unit >> 5, c = unit & 31, b = bg >> 3, g = bg & 7, row0 = b * SEQ + c * 64;
    LAS bf16* Cs = (LAS bf16*)(lds + S1_C); LAS bf16* Bs = (LAS bf16*)(lds + S1_B); LAS float* CBs = (LAS float*)(lds + S1_CB); LAS bf16* Bt = (LAS bf16*)(lds + S1_BT); LAS bf16* Xt = (LAS bf16*)(lds + S1_XT);
    LAS float* dtS = (LAS float*)(lds + S1_DT); LAS float* acS = (LAS float*)(lds + S1_AC);
    const bf16* XBC = (const bf16*)(A.ws + WS_XBC); const f32x2* SG = (const f32x2*)(A.ws + WS_SG);
    bf16* YI = (bf16*)(A.ws + WS_YI); bf16* BMT = (bf16*)(A.ws + WS_BMT) + (size_t)unit * 8192; bf16* XWT = (bf16*)(A.ws + WS_XWT);
    const int l4 = lane >> 4, l15 = lane & 15;
#pragma unroll
    for (int i = 0; i < 2; ++i) { const int piece = tid + NTHREADS * i, r = piece >> 4, cc = piece & 15;
        const bf16* sp = XBC + (size_t)(row0 + r) * 6144 + 4096 + g * 128 + cc * 8;
        const v4u bm = *(const v4u*)sp, cm = *(const v4u*)(sp + 1024);
        *(LAS v4u*)(Cs + r * 136 + cc * 8) = cm; *(LAS v4u*)(Bs + r * 136 + cc * 8) = bm;
        const unsigned w[4] = {bm.x, bm.y, bm.z, bm.w};
#pragma unroll
        for (int e = 0; e < 4; ++e) { Bt[(cc * 8 + 2 * e) * 72 + r] = (bf16)(w[e] & 0xffffu); Bt[(cc * 8 + 2 * e + 1) * 72 + r] = (bf16)(w[e] >> 16); } }
#pragma unroll
    for (int i = 0; i < 8; ++i) { const int piece = tid + NTHREADS * i, r = piece >> 6, cc = piece & 63;
        const v4u xv = *(const v4u*)(XBC + (size_t)(row0 + r) * 6144 + g * 512 + cc * 8); const unsigned w[4] = {xv.x, xv.y, xv.z, xv.w};
#pragma unroll
        for (int e = 0; e < 4; ++e) { Xt[(cc * 8 + 2 * e) * 72 + r] = (bf16)(w[e] & 0xffffu); Xt[(cc * 8 + 2 * e + 1) * 72 + r] = (bf16)(w[e] >> 16); } }
    { const int hh = tid >> 6, t = tid & 63; const f32x2 sg = SG[(size_t)(row0 + t) * 64 + g * 8 + hh]; dtS[hh * 64 + t] = sg[0]; acS[hh * 64 + t] = sg[1]; }
    __syncthreads();
    f32x4 cb[2];
    { const int mt = wave >> 1;
#pragma unroll
      for (int e = 0; e < 2; ++e) { const int nt = (wave & 1) * 2 + e; cb[e] = mma_nt<128>(Cs + mt * 16 * 136, 136, Bs + nt * 16 * 136, 136, (f32x4){0.f, 0.f, 0.f, 0.f}, lane); } }
    __syncthreads();
    { const int mt = wave >> 1;
#pragma unroll
      for (int e = 0; e < 2; ++e) { const int nt = (wave & 1) * 2 + e;
#pragma unroll
          for (int i = 0; i < 4; ++i) CBs[(mt * 16 + 4 * l4 + i) * 68 + nt * 16 + l15] = cb[e][i]; } }
#pragma unroll
    for (int i = 0; i < 2; ++i) { const int pair = tid + NTHREADS * i, n = pair >> 3, sg = pair & 7; *(v4u*)(BMT + (size_t)n * 64 + sg * 8) = *(const LAS v4u*)(Bt + n * 72 + sg * 8); }
    __syncthreads();
    { const int hh = wave, head = g * 8 + hh; const float a_end = acS[hh * 64 + 63];
      bf16* xw = XWT + (size_t)((b * 64 + head) * 32 + c) * 4096;
#pragma unroll
      for (int i = 0; i < 8; ++i) { const int piece = lane + 64 * i, p = piece >> 3, sg = piece & 7; const v4u xv = *(const LAS v4u*)(Xt + (hh * 64 + p) * 72 + sg * 8);
          float wg[8];
#pragma unroll
          for (int e = 0; e < 8; ++e) wg[e] = dtS[hh * 64 + sg * 8 + e] * __expf(a_end - acS[hh * 64 + sg * 8 + e]);
          v4u o; o.x = pk2(bflo(xv.x) * wg[0], bfhi(xv.x) * wg[1]); o.y = pk2(bflo(xv.y) * wg[2], bfhi(xv.y) * wg[3]); o.z = pk2(bflo(xv.z) * wg[4], bfhi(xv.z) * wg[5]); o.w = pk2(bflo(xv.w) * wg[6], bfhi(xv.w) * wg[7]);
          *(v4u*)(xw + (size_t)p * 64 + sg * 8) = o; }
#pragma unroll
      for (int tt = 0; tt < 4; ++tt) { const int t = tt * 16 + l15; const float act = acS[hh * 64 + t];
          bf16x8 Y[2];
#pragma unroll
          for (int ks = 0; ks < 2; ++ks) { const int s0 = 32 * ks + 8 * l4; const f32x4 c0 = *(const LAS f32x4*)(CBs + t * 68 + s0), c1 = *(const LAS f32x4*)(CBs + t * 68 + s0 + 4); float gv[8];
#pragma unroll
              for (int e = 0; e < 8; ++e) { const int s = s0 + e; const float cbv = e < 4 ? c0[e & 3] : c1[e & 3]; gv[e] = (s <= t) ? cbv * __expf(act - acS[hh * 64 + s]) * dtS[hh * 64 + s] : 0.f; }
              v4u yv; yv.x = pk2(gv[0], gv[1]); yv.y = pk2(gv[2], gv[3]); yv.z = pk2(gv[4], gv[5]); yv.w = pk2(gv[6], gv[7]); Y[ks] = as_bf16x8(yv); }
#pragma unroll
          for (int pt = 0; pt < 4; ++pt) { f32x4 acc = (f32x4){0.f, 0.f, 0.f, 0.f};
#pragma unroll
              for (int ks = 0; ks < 2; ++ks) acc = mfma16(*(const LAS bf16x8*)(Xt + (hh * 64 + pt * 16 + l15) * 72 + 32 * ks + 8 * l4), Y[ks], acc);
              v2u w; w.x = pk2(acc[0], acc[1]); w.y = pk2(acc[2], acc[3]);
              *(v2u*)(YI + (size_t)(row0 + t) * DM + head * 64 + pt * 16 + 4 * l4) = w; } } }
    __syncthreads();
}

__device__ __forceinline__ void nscan_item(const Args& A, int bh, int tid) {
    if (tid < 256) { const float* KWS = (const float*)(A.ws + WS_KWS); const f32x2* MPD = (const f32x2*)(A.ws + WS_MPD); float* NALL = (float*)(A.ws + WS_NALL);
        float kw[32], dc[32];
#pragma unroll
        for (int c = 0; c < 32; ++c) { kw[c] = KWS[(size_t)(bh * 32 + c) * 256 + tid]; dc[c] = MPD[bh * 32 + c][1]; }
        float n = 0.f;
#pragma unroll
        for (int c = 0; c < 32; ++c) { NALL[(size_t)(bh * 32 + c) * 256 + tid] = n; n = dc[c] * n + kw[c]; }
        A.out[O_PN + bh * 256 + tid] = n; }
}

constexpr int M2_Q = 0, M2_KW = 33792, M2_VT = 70656;
__device__ __forceinline__ void m2_item(const Args& A, LAS unsigned char* lds, int item, int tid, int lane, int wave) {
    const int bh = item >> 2, j = item & 3, b = bh >> 3, h = bh & 7;
    LAS bf16* Qs = (LAS bf16*)(lds + M2_Q); LAS bf16* Kw = (LAS bf16*)(lds + M2_KW); LAS bf16* Vt = (LAS bf16*)(lds + M2_VT);
    const bf16* QK = (const bf16*)(A.ws + WS_QK); const bf16* KWT = (const bf16*)(A.ws + WS_KWT); const bf16* VTG = (const bf16*)(A.ws + WS_VT); const f32x2* MPD = (const f32x2*)(A.ws + WS_MPD);
    bf16* INTER = (bf16*)(A.ws + WS_INTER);
    const int l4 = lane >> 4, l15 = lane & 15;
    f32x4 acc[16];
#pragma unroll
    for (int i = 0; i < 16; ++i) acc[i] = (f32x4){0.f, 0.f, 0.f, 0.f};
    v4u rq[4], rk[4], rv[2]; float dnext;
#define M2_LOAD(cc_) do { const int r0_ = b * SEQ + (cc_) * 64; const size_t un_ = (size_t)(bh * 32 + (cc_)); \
        _Pragma("unroll") for (int i = 0; i < 4; ++i) { const int piece = tid + NTHREADS * i; rq[i] = *(const v4u*)(QK + (size_t)(r0_ + (piece >> 5)) * DM + h * 512 + (piece & 31) * 8); rk[i] = *(const v4u*)(KWT + un_ * 16384 + (size_t)piece * 8); } \
        _Pragma("unroll") for (int i = 0; i < 2; ++i) { const int piece = tid + NTHREADS * i; rv[i] = *(const v4u*)(VTG + un_ * 32768 + (size_t)(j * 128) * 64 + (size_t)piece * 8); } \
        dnext = MPD[un_][1]; } while (0)
    M2_LOAD(0);
    for (int c = 0; c < 32; ++c) {
        const int row0 = b * SEQ + c * 64;
#pragma unroll
        for (int i = 0; i < 4; ++i) { const int piece = tid + NTHREADS * i; *(LAS v4u*)(Qs + (piece >> 5) * 264 + (piece & 31) * 8) = rq[i]; *(LAS v4u*)(Kw + (piece >> 3) * 72 + (piece & 7) * 8) = rk[i]; }
#pragma unroll
        for (int i = 0; i < 2; ++i) { const int piece = tid + NTHREADS * i; *(LAS v4u*)(Vt + (piece >> 3) * 72 + (piece & 7) * 8) = rv[i]; }
        const float decay = dnext;
        if (c < 31) M2_LOAD(c + 1);
        __syncthreads();
        f32x4 ia[4];
#pragma unroll
        for (int tt = 0; tt < 4; ++tt) ia[tt] = (f32x4){0.f, 0.f, 0.f, 0.f};
#pragma unroll
        for (int ks = 0; ks < 8; ++ks) { const bf16x8 X = as_bf16x8(pack8(acc[2 * ks], acc[2 * ks + 1]));
#pragma unroll
            for (int tt = 0; tt < 4; ++tt) { const LAS bf16* qp = Qs + (tt * 16 + l15) * 264 + 32 * ks + 4 * l4; const v2u y0 = *(const LAS v2u*)qp, y1 = *(const LAS v2u*)(qp + 16);
                ia[tt] = mfma16(X, as_bf16x8((v4u){y0.x, y0.y, y1.x, y1.y}), ia[tt]); } }
#pragma unroll
        for (int tt = 0; tt < 4; ++tt) { v2u w; w.x = pk2(ia[tt][0], ia[tt][1]); w.y = pk2(ia[tt][2], ia[tt][3]);
            *(v2u*)(INTER + (size_t)(row0 + tt * 16 + l15) * DM + h * 512 + j * 128 + wave * 16 + 4 * l4) = w; }
        bf16x8 yv[2];
#pragma unroll
        for (int ks = 0; ks < 2; ++ks) yv[ks] = *(const LAS bf16x8*)(Vt + (wave * 16 + l15) * 72 + ks * 32 + l4 * 8);
#pragma unroll
        for (int dt = 0; dt < 16; ++dt) { acc[dt] = acc[dt] * decay;
#pragma unroll
            for (int ks = 0; ks < 2; ++ks) acc[dt] = mfma16(*(const LAS bf16x8*)(Kw + (dt * 16 + l15) * 72 + ks * 32 + l4 * 8), yv[ks], acc[dt]); }
        __syncthreads();
    }
#undef M2_LOAD
    float* pC = A.out + O_PC + (size_t)(bh * 256) * 512 + j * 128 + wave * 16 + l15;
#pragma unroll
    for (int dt = 0; dt < 16; ++dt)
#pragma unroll
        for (int i = 0; i < 4; ++i) pC[(size_t)(dt * 16 + 4 * l4 + i) * 512] = acc[dt][i];
}

constexpr int S2_C = 0, S2_BT = 17408, S2_XW = 35840;
__device__ __forceinline__ void s2_item(const Args& A, LAS unsigned char* lds, int item, int tid, int lane, int wave) {
    const int b = item >> 5, pair = item & 31, hsel = wave >> 2, head = pair * 2 + hsel, g = pair >> 2, pt = wave & 3;
    LAS bf16* Cs = (LAS bf16*)(lds + S2_C); LAS bf16* Bt = (LAS bf16*)(lds + S2_BT); LAS bf16* Xw = (LAS bf16*)(lds + S2_XW);
    const bf16* XBC = (const bf16*)(A.ws + WS_XBC); const bf16* BMT = (const bf16*)(A.ws + WS_BMT); const bf16* XWT = (const bf16*)(A.ws + WS_XWT); const f32x2* SG = (const f32x2*)(A.ws + WS_SG);
    bf16* YS = (bf16*)(A.ws + WS_YS);
    const int l4 = lane >> 4, l15 = lane & 15;
    f32x4 acc[8];
#pragma unroll
    for (int i = 0; i < 8; ++i) acc[i] = (f32x4){0.f, 0.f, 0.f, 0.f};
    v4u rc[2], rb[2], rx[2]; float enext;
#define S2_LOAD(cc_) do { const int r0_ = b * SEQ + (cc_) * 64; \
        _Pragma("unroll") for (int i = 0; i < 2; ++i) { const int piece = tid + NTHREADS * i; rc[i] = *(const v4u*)(XBC + (size_t)(r0_ + (piece >> 4)) * 6144 + 5120 + g * 128 + (piece & 15) * 8); \
            rb[i] = *(const v4u*)(BMT + (size_t)((b * 8 + g) * 32 + (cc_)) * 8192 + (size_t)piece * 8); \
            rx[i] = *(const v4u*)(XWT + (size_t)((b * 64 + pair * 2 + (piece >> 9)) * 32 + (cc_)) * 4096 + (size_t)(piece & 511) * 8); } \
        enext = __expf(SG[(size_t)(r0_ + 63) * 64 + head][1]); } while (0)
    S2_LOAD(0);
    for (int c = 0; c < 32; ++c) {
        const int row0 = b * SEQ + c * 64;
#pragma unroll
        for (int i = 0; i < 2; ++i) { const int piece = tid + NTHREADS * i; *(LAS v4u*)(Cs + (piece >> 4) * 136 + (piece & 15) * 8) = rc[i]; *(LAS v4u*)(Bt + (piece >> 3) * 72 + (piece & 7) * 8) = rb[i]; *(LAS v4u*)(Xw + (piece >> 3) * 72 + (piece & 7) * 8) = rx[i]; }
        const float ea = enext;
        if (c < 31) S2_LOAD(c + 1);
        __syncthreads();
        f32x4 ia[4];
#pragma unroll
        for (int tt = 0; tt < 4; ++tt) ia[tt] = (f32x4){0.f, 0.f, 0.f, 0.f};
#pragma unroll
        for (int ks = 0; ks < 4; ++ks) { const bf16x8 X = as_bf16x8(pack8(acc[2 * ks], acc[2 * ks + 1]));
#pragma unroll
            for (int tt = 0; tt < 4; ++tt) { const LAS bf16* cp = Cs + (tt * 16 + l15) * 136 + 32 * ks + 4 * l4; const v2u y0 = *(const LAS v2u*)cp, y1 = *(const LAS v2u*)(cp + 16);
                ia[tt] = mfma16(X, as_bf16x8((v4u){y0.x, y0.y, y1.x, y1.y}), ia[tt]); } }
#pragma unroll
        for (int tt = 0; tt < 4; ++tt) { v2u w; w.x = pk2(ia[tt][0], ia[tt][1]); w.y = pk2(ia[tt][2], ia[tt][3]);
            *(v2u*)(YS + (size_t)(row0 + tt * 16 + l15) * DM + head * 64 + pt * 16 + 4 * l4) = w; }
        bf16x8 yv[2];
#pragma unroll
        for (int ks = 0; ks < 2; ++ks) yv[ks] = *(const LAS bf16x8*)(Xw + (hsel * 64 + pt * 16 + l15) * 72 + ks * 32 + l4 * 8);
#pragma unroll
        for (int nt = 0; nt < 8; ++nt) { acc[nt] = acc[nt] * ea;
#pragma unroll
            for (int ks = 0; ks < 2; ++ks) acc[nt] = mfma16(*(const LAS bf16x8*)(Bt + (nt * 16 + l15) * 72 + ks * 32 + l4 * 8), yv[ks], acc[nt]); }
        __syncthreads();
    }
#undef S2_LOAD
    float* pH = A.out + O_PSSM + (size_t)((b * 64 + head) * 64 + pt * 16 + l15) * 128 + 4 * l4;
#pragma unroll
    for (int nt = 0; nt < 8; ++nt) *(f32x4*)(pH + nt * 16) = acc[nt];
}

__device__ __forceinline__ void m3_pass(const Args& A, int gw, int NGW, int lane) {
    const bf16* NUMI = (const bf16*)(A.ws + WS_NUMI); const bf16* INTER = (const bf16*)(A.ws + WS_INTER); const bf16* PROJ = (const bf16*)(A.ws + WS_PROJ); const bf16* QK = (const bf16*)(A.ws + WS_QK);
    const f32x4* MG = (const f32x4*)(A.ws + WS_MG); const f32x2* MPD = (const f32x2*)(A.ws + WS_MPD); const float* NALL = (const float*)(A.ws + WS_NALL); const float* DENI = (const float*)(A.ws + WS_DENI);
    bf16* MIX = (bf16*)(A.ws + WS_MIX); const float* mnorm = A.in[I_MNORM];
    for (int it = gw; it < MPR * 8; it += NGW) {
        const int row = it >> 3, h = it & 7, b = row >> 11, c = (row >> 6) & 31, unit = (b * 8 + h) * 32 + c, col = h * 512 + lane * 8;
        const v4u ni = *(const v4u*)(NUMI + (size_t)row * DM + col), iw = *(const v4u*)(INTER + (size_t)row * DM + col);
        const v4u ow = *(const v4u*)(PROJ + (size_t)row * NPROJ + 8192 + col), zw = *(const v4u*)(PROJ + (size_t)row * NPROJ + 12288 + col);
        const v2u qw = *(const v2u*)(QK + (size_t)row * DM + h * 512 + lane * 4); const f32x4 n4 = *(const f32x4*)(NALL + (size_t)unit * 256 + lane * 4);
        const f32x4 mg = MG[(size_t)row * 8 + h]; const float mp = MPD[unit][0]; const float deni = DENI[(size_t)row * 8 + h];
        const f32x4 mn0 = *(const f32x4*)(mnorm + col), mn1 = *(const f32x4*)(mnorm + col + 4);
        const float mm = fmaxf(mp, mg[2]), a = __expf(mp - mm), ex = __expf(-mm - mg[0]);
        const float qn = wave_sum((bflo(qw.x) * n4[0] + bfhi(qw.x) * n4[1]) + (bflo(qw.y) * n4[2] + bfhi(qw.y) * n4[3]));
        const float dn = fmaxf(fabsf(deni + a * qn), ex), rdn = 1.f / dn;
        const float nv[8] = {bflo(ni.x), bfhi(ni.x), bflo(ni.y), bfhi(ni.y), bflo(ni.z), bfhi(ni.z), bflo(ni.w), bfhi(ni.w)};
        const float iv[8] = {bflo(iw.x), bfhi(iw.x), bflo(iw.y), bfhi(iw.y), bflo(iw.z), bfhi(iw.z), bflo(iw.w), bfhi(iw.w)};
        const float ov[8] = {bflo(ow.x), bfhi(ow.x), bflo(ow.y), bfhi(ow.y), bflo(ow.z), bfhi(ow.z), bflo(ow.w), bfhi(ow.w)};
        const float zv[8] = {bflo(zw.x), bfhi(zw.x), bflo(zw.y), bfhi(zw.y), bflo(zw.z), bfhi(zw.z), bflo(zw.w), bfhi(zw.w)};
        const float mn[8] = {mn0[0], mn0[1], mn0[2], mn0[3], mn1[0], mn1[1], mn1[2], mn1[3]};
        float pre[8], ss = 0.f;
#pragma unroll
        for (int e = 0; e < 8; ++e) { pre[e] = (nv[e] + a * iv[e]) * rdn * sigm(ov[e]); ss += pre[e] * pre[e]; }
        const float rstd = rsqrtf(wave_sum(ss) * (1.f / 512.f) + EPS);
        float val[8];
#pragma unroll
        for (int e = 0; e < 8; ++e) val[e] = pre[e] * rstd * mn[e] * silu(zv[e]);
        v4u o; o.x = pk2(val[0], val[1]); o.y = pk2(val[2], val[3]); o.z = pk2(val[4], val[5]); o.w = pk2(val[6], val[7]);
        *(v4u*)(MIX + (size_t)row * 8192 + col) = o;
    }
}
__device__ __forceinline__ void s3_pass(const Args& A, int gw, int NGW, int lane) {
    const bf16* YI = (const bf16*)(A.ws + WS_YI); const bf16* YS = (const bf16*)(A.ws + WS_YS); const bf16* PROJ = (const bf16*)(A.ws + WS_PROJ); const bf16* XBC = (const bf16*)(A.ws + WS_XBC);
    const f32x2* SG = (const f32x2*)(A.ws + WS_SG); bf16* MIX = (bf16*)(A.ws + WS_MIX); const float* snorm = A.in[I_SNORM];
    for (int it = gw; it < MPR * 8; it += NGW) {
        const int row = it >> 3, g = it & 7, col = g * 512 + lane * 8, head = g * 8 + (lane >> 3);
        const v4u yi = *(const v4u*)(YI + (size_t)row * DM + col), ys = *(const v4u*)(YS + (size_t)row * DM + col);
        const v4u xw = *(const v4u*)(XBC + (size_t)row * 6144 + col), zw = *(const v4u*)(PROJ + (size_t)row * NPROJ + 16384 + col);
        const f32x2 sg = SG[(size_t)row * 64 + head]; const float eac = __expf(sg[1]), dsk = A.in[I_DSKIP][head];
        const f32x4 sn0 = *(const f32x4*)(snorm + col), sn1 = *(const f32x4*)(snorm + col + 4);
        const float a1[8] = {bflo(yi.x), bfhi(yi.x), bflo(yi.y), bfhi(yi.y), bflo(yi.z), bfhi(yi.z), bflo(yi.w), bfhi(yi.w)};
        const float a2[8] = {bflo(ys.x), bfhi(ys.x), bflo(ys.y), bfhi(ys.y), bflo(ys.z), bfhi(ys.z), bflo(ys.w), bfhi(ys.w)};
        const float xv[8] = {bflo(xw.x), bfhi(xw.x), bflo(xw.y), bfhi(xw.y), bflo(xw.z), bfhi(xw.z), bflo(xw.w), bfhi(xw.w)};
        const float zv[8] = {bflo(zw.x), bfhi(zw.x), bflo(zw.y), bfhi(zw.y), bflo(zw.z), bfhi(zw.z), bflo(zw.w), bfhi(zw.w)};
        const float sn[8] = {sn0[0], sn0[1], sn0[2], sn0[3], sn1[0], sn1[1], sn1[2], sn1[3]};
        float pre[8], ss = 0.f;
#pragma unroll
        for (int e = 0; e < 8; ++e) { pre[e] = (a1[e] + eac * a2[e] + dsk * xv[e]) * silu(zv[e]); ss += pre[e] * pre[e]; }
        const float rstd = rsqrtf(wave_sum(ss) * (1.f / 512.f) + EPS);
        v4u o; o.x = pk2(pre[0] * rstd * sn[0], pre[1] * rstd * sn[1]); o.y = pk2(pre[2] * rstd * sn[2], pre[3] * rstd * sn[3]); o.z = pk2(pre[4] * rstd * sn[4], pre[5] * rstd * sn[5]); o.w = pk2(pre[6] * rstd * sn[6], pre[7] * rstd * sn[7]);
        *(v4u*)(MIX + (size_t)row * 8192 + 4096 + col) = o;
    }
}


__device__ __forceinline__ void mlstm_sample_item(const Args& A, LAS unsigned char* lds, int item, int tid, int lane, int wave) {
    const int seq = item >> 3, h = item & 7;
    LAS float* qT = (LAS float*)lds; LAS float* kT = qT + 1024; LAS float* kwT = qT + 2048; LAS float* vS = qT + 3072; LAS float* n0S = qT + 5120; LAS float* gt = qT + 5376;
    LAS float* SSd = qT + 5408; LAS float* PSd = qT + 5440; LAS float* denS = qT + 5472; LAS float* wkS = qT + 5480; LAS float* ssS = qT + 5488; LAS float* accl = qT + 6144;
    const bf16* QK = (const bf16*)(A.ws + WS_QK); const bf16* PROJ = (const bf16*)(A.ws + WS_PROJ); const float* MG = (const float*)(A.ws + WS_MG);
    bf16* MIX = (bf16*)(A.ws + WS_MIX); const float* mnorm = A.in[I_MNORM];
    const int rowb = MPR + seq * 4;
    { const int idx = tid * 2, t = idx >> 8, d = idx & 255; const bf16* sp = QK + (size_t)(rowb + t) * DM + h * 512 + d;
      const unsigned qw = *(const unsigned*)sp, kw = *(const unsigned*)(sp + 256);
      qT[d * 4 + t] = bflo(qw); qT[(d + 1) * 4 + t] = bfhi(qw); kT[d * 4 + t] = bflo(kw); kT[(d + 1) * 4 + t] = bfhi(kw); }
    { const int idx = tid * 4, t = idx >> 9, v = idx & 511; const v2u vw = *(const v2u*)(PROJ + (size_t)(rowb + t) * NPROJ + 4096 + h * 512 + v);
      *(LAS f32x4*)(vS + t * 512 + v) = (f32x4){bflo(vw.x), bfhi(vw.x), bflo(vw.y), bfhi(vw.y)}; }
    if (tid < 256) n0S[tid] = A.in[I_MN][(size_t)(seq * 8 + h) * 256 + tid];
    if (tid < 16) { const int comp = tid >> 2, t = tid & 3; gt[comp * 4 + t] = MG[((size_t)(rowb + t) * 8 + h) * 4 + comp]; }
    __syncthreads();
    for (int pp = wave; pp < 20; pp += NWAVES) { float part = 0.f;
        if (pp < 16) { const int t = pp >> 2, s = pp & 3;
#pragma unroll
            for (int i = 0; i < 4; ++i) part += qT[(lane + 64 * i) * 4 + t] * kT[(lane + 64 * i) * 4 + s]; }
        else { const int t = pp - 16;
#pragma unroll
            for (int i = 0; i < 4; ++i) part += qT[(lane + 64 * i) * 4 + t] * n0S[lane + 64 * i]; }
        part = wave_sum(part); if (lane == 0) SSd[pp] = part; }
    __syncthreads();
    if (tid < 16) { const int t = tid >> 2, s = tid & 3; PSd[tid] = (s <= t) ? SSd[tid] * __expf(gt[t] + gt[4 + s]) : 0.f; }
    if (tid >= 64 && tid < 68) { const int s = tid - 64; wkS[s] = __expf(gt[3] + gt[4 + s]); }
    __syncthreads();
    if (tid < 4) denS[tid] = (PSd[tid * 4] + PSd[tid * 4 + 1]) + (PSd[tid * 4 + 2] + PSd[tid * 4 + 3]) + gt[8 + tid] * SSd[16 + tid];
    { const int i0 = tid * 2; kwT[i0] = kT[i0] * wkS[i0 & 3]; kwT[i0 + 1] = kT[i0 + 1] * wkS[(i0 + 1) & 3]; }
    __syncthreads();
    const float decay = gt[8 + 3];
    const int dr = tid >> 7, v4 = (tid & 127) * 4;
    f32x4 vv[4], acc[4];
#pragma unroll
    for (int s = 0; s < 4; ++s) { vv[s] = *(const LAS f32x4*)(vS + s * 512 + v4); acc[s] = (f32x4){0.f, 0.f, 0.f, 0.f}; }
    const float* C0 = A.in[I_MC] + (size_t)((seq * 8 + h) * 256) * 512 + v4; float* C1 = A.out + O_SC + (size_t)((seq * 8 + h) * 256) * 512 + v4;
#pragma unroll 8
    for (int i = 0; i < 64; ++i) { const int d = dr + 4 * i;
        const f32x4 c0 = __builtin_nontemporal_load((const f32x4*)(C0 + (size_t)d * 512));
        const f32x4 q4 = *(const LAS f32x4*)(qT + d * 4), kw4 = *(const LAS f32x4*)(kwT + d * 4);
#pragma unroll
        for (int t = 0; t < 4; ++t) acc[t] += q4[t] * c0;
        const f32x4 cn = decay * c0 + kw4[0] * vv[0] + kw4[1] * vv[1] + kw4[2] * vv[2] + kw4[3] * vv[3];
        __builtin_nontemporal_store(cn, (f32x4*)(C1 + (size_t)d * 512)); }
#pragma unroll
    for (int t = 0; t < 4; ++t) *(LAS f32x4*)(accl + (dr * 4 + t) * 512 + v4) = acc[t];
    __syncthreads();
    float val[4];
    { const int t = dr; f32x4 a = (f32x4){0.f, 0.f, 0.f, 0.f};
#pragma unroll
      for (int r = 0; r < 4; ++r) a += *(const LAS f32x4*)(accl + (r * 4 + t) * 512 + v4);
      f32x4 num = gt[8 + t] * a;
#pragma unroll
      for (int s = 0; s < 4; ++s) num += PSd[t * 4 + s] * vv[s];
      const float dn = fmaxf(fabsf(denS[t]), gt[12 + t]); const int row = rowb + t, col = h * 512 + v4;
      const v2u ow = *(const v2u*)(PROJ + (size_t)row * NPROJ + 8192 + col), zw = *(const v2u*)(PROJ + (size_t)row * NPROJ + 12288 + col);
      const f32x4 o4 = (f32x4){bflo(ow.x), bfhi(ow.x), bflo(ow.y), bfhi(ow.y)}, z4 = (f32x4){bflo(zw.x), bfhi(zw.x), bflo(zw.y), bfhi(zw.y)}; const f32x4 mn = *(const f32x4*)(mnorm + col);
      f32x4 pre; float ss = 0.f;
#pragma unroll
      for (int e = 0; e < 4; ++e) { pre[e] = (num[e] / dn) * sigm(o4[e]); ss += pre[e] * pre[e]; val[e] = pre[e] * mn[e] * silu(z4[e]); }
      ss = wave_sum(ss); if (lane == 0) ssS[wave] = ss; }
    __syncthreads();
    { const float rstd = rsqrtf((ssS[2 * dr] + ssS[2 * dr + 1]) * (1.f / 512.f) + EPS);
      v2u w; w.x = pk2(val[0] * rstd, val[1] * rstd); w.y = pk2(val[2] * rstd, val[3] * rstd); *(v2u*)(MIX + (size_t)(rowb + dr) * 8192 + h * 512 + v4) = w; }
    if (tid < 256) { const f32x4 kw = *(const LAS f32x4*)(kwT + tid * 4); A.out[O_SN + (size_t)(seq * 8 + h) * 256 + tid] = decay * n0S[tid] + ((kw[0] + kw[1]) + (kw[2] + kw[3])); }
    __syncthreads();
}

__device__ __forceinline__ void ssd_sample_item(const Args& A, LAS unsigned char* lds, int item, int tid, int lane, int wave) {
    const int seq = item >> 3, gi = item & 7, hd = gi * 8 + wave;
    LAS float* Cf = (LAS float*)lds; LAS float* Bf = Cf + 512; LAS float* xf = Cf + 1024; LAS float* dtS = Cf + 3072; LAS float* acS = Cf + 3104; LAS float* CBs = Cf + 3136;
    LAS float* xw = Cf + 3200; LAS float* yp = Cf + 5248; LAS float* ssS = Cf + 7296;
    const bf16* XBC = (const bf16*)(A.ws + WS_XBC); const bf16* PROJ = (const bf16*)(A.ws + WS_PROJ); const f32x2* SG = (const f32x2*)(A.ws + WS_SG);
    bf16* MIX = (bf16*)(A.ws + WS_MIX); const float* snorm = A.in[I_SNORM];
    const int rowb = MPR + seq * 4;
    { const int t = tid >> 7, n = tid & 127; const bf16* sp = XBC + (size_t)(rowb + t) * 6144 + 4096 + gi * 128 + n; Bf[t * 128 + n] = bf2f(sp[0]); Cf[t * 128 + n] = bf2f(sp[1024]); }
    { const int idx = tid * 4, t = idx >> 9, cidx = idx & 511; const v2u xv = *(const v2u*)(XBC + (size_t)(rowb + t) * 6144 + gi * 512 + cidx);
      *(LAS f32x4*)(xf + t * 512 + cidx) = (f32x4){bflo(xv.x), bfhi(xv.x), bflo(xv.y), bfhi(xv.y)}; }
    if (tid < 32) { const int hh = tid >> 2, t = tid & 3; const f32x2 sg = SG[(size_t)(rowb + t) * 64 + gi * 8 + hh]; dtS[hh * 4 + t] = sg[0]; acS[hh * 4 + t] = sg[1]; }
    __syncthreads();
#pragma unroll
    for (int e = 0; e < 2; ++e) { const int pp = wave * 2 + e, t = pp >> 2, s = pp & 3;
        float part = Cf[t * 128 + lane] * Bf[s * 128 + lane] + Cf[t * 128 + 64 + lane] * Bf[s * 128 + 64 + lane];
        part = wave_sum(part); if (lane == 0) CBs[pp] = part; }
#pragma unroll
    for (int i = 0; i < 4; ++i) { const int idx = tid + NTHREADS * i, hh = idx >> 8, p = (idx >> 2) & 63, s = idx & 3;
        xw[idx] = xf[s * 512 + hh * 64 + p] * dtS[hh * 4 + s] * __expf(acS[hh * 4 + 3] - acS[hh * 4 + s]); }
    __syncthreads();
    { const int n4 = (lane & 31) * 4, half = lane >> 5; f32x4 c4[4], b4[4];
#pragma unroll
      for (int t = 0; t < 4; ++t) { c4[t] = *(const LAS f32x4*)(Cf + t * 128 + n4); b4[t] = *(const LAS f32x4*)(Bf + t * 128 + n4); }
      const float ea = __expf(acS[wave * 4 + 3]);
      const float* H0 = A.in[I_SSSM] + (size_t)((seq * 64 + hd) * 64) * 128 + n4; float* H1 = A.out + O_SSSM + (size_t)((seq * 64 + hd) * 64) * 128 + n4;
#pragma unroll 4
      for (int i = 0; i < 32; ++i) { const int p = half + 2 * i;
          const f32x4 h4 = __builtin_nontemporal_load((const f32x4*)(H0 + (size_t)p * 128));
          const f32x4 xw4 = *(const LAS f32x4*)(xw + (wave * 64 + p) * 4);
          const f32x4 hn = ea * h4 + xw4[0] * b4[0] + xw4[1] * b4[1] + xw4[2] * b4[2] + xw4[3] * b4[3];
          __builtin_nontemporal_store(hn, (f32x4*)(H1 + (size_t)p * 128));
          float part[4];
#pragma unroll
          for (int t = 0; t < 4; ++t) { part[t] = (c4[t][0] * h4[0] + c4[t][1] * h4[1]) + (c4[t][2] * h4[2] + c4[t][3] * h4[3]);
              part[t] += __shfl_xor(part[t], 1); part[t] += __shfl_xor(part[t], 2); part[t] += __shfl_xor(part[t], 4); part[t] += __shfl_xor(part[t], 8); part[t] += __shfl_xor(part[t], 16); }
          if ((lane & 31) == 0) {
#pragma unroll
              for (int t = 0; t < 4; ++t) yp[(wave * 4 + t) * 64 + p] = part[t]; } } }
    __syncthreads();
    { const int p = lane; const float dskip = A.in[I_DSKIP][hd]; float pre[4];
#pragma unroll
      for (int t = 0; t < 4; ++t) { float y = __expf(acS[wave * 4 + t]) * yp[(wave * 4 + t) * 64 + p];
#pragma unroll
          for (int s = 0; s < 4; ++s) if (s <= t) y += CBs[t * 4 + s] * __expf(acS[wave * 4 + t] - acS[wave * 4 + s]) * dtS[wave * 4 + s] * xf[s * 512 + wave * 64 + p];
          y += dskip * xf[t * 512 + wave * 64 + p];
          const int row = rowb + t, col = hd * 64 + p; const float z = bf2f(PROJ[(size_t)row * NPROJ + 16384 + col]); pre[t] = y * silu(z);
          const float ss = wave_sum(pre[t] * pre[t]); if (lane == 0) ssS[wave * 4 + t] = ss; }
      __syncthreads();
#pragma unroll
      for (int t = 0; t < 4; ++t) { float tot = 0.f;
#pragma unroll
          for (int w = 0; w < 8; ++w) tot += ssS[w * 4 + t];
          const float rstd = rsqrtf(tot * (1.f / 512.f) + EPS); const int col = hd * 64 + p;
          MIX[(size_t)(rowb + t) * 8192 + 4096 + col] = (bf16)f2bf(pre[t] * rstd * snorm[col]); } }
    __syncthreads();
}


__global__ void __launch_bounds__(NTHREADS, 2) mk_fwd(Args args) {
    extern __shared__ __attribute__((aligned(16))) unsigned char lds_raw[];
    LAS unsigned char* lds = (LAS unsigned char*)lds_raw;
    volatile LAS unsigned* MISC = (volatile LAS unsigned*)(lds + LDSCTL_OFF);
    const int tid = threadIdx.x, lane = tid & 63, wave = __builtin_amdgcn_readfirstlane(tid >> 6);
    const int G = gridDim.x, bid = blockIdx.x;
    const int gw = bid * NWAVES + wave, NGW = G * NWAVES, gt = bid * NTHREADS + tid, NGT = G * NTHREADS;
    unsigned char* ws = args.ws;
    unsigned* ctl = (unsigned*)(ws + WS_CTL);
    if (tid < 64) MISC[tid] = 0u;
    __syncthreads();
    XcdBarrier bar; bar.bar = ctl + CW_BAR; bar.x = 0; bar.st = nullptr;
    if (MK_N_LAUNCHES == 1) bar = xcd_barrier_post(ctl + CW_BAR, MISC + 8);
#define GRID_BAR() do { if (MK_N_LAUNCHES == 1) xcd_barrier(bar); } while (0)
    const int lo = args.ph_lo, hi = args.ph_hi;
#define IN(k) (lo <= (k) && (k) < hi)
#define BOTH(k) (IN(k) && IN((k) + 1))

    if (IN(0)) {
#pragma nounroll
        for (int rep = 0; rep < (PROBE_DUP == 0 ? 2 : 1); ++rep) p0_prologue(args, lds, gw, NGW, lane, wave);
        if (BOTH(0)) GRID_BAR(); }
    if (IN(1)) {
        pg8::Gemm g{(const bf16*)(ws + WS_XN), (const bf16*)(ws + WS_W1T), DM, DM, DM}; pg8::Order S; S.init(MTOK / 256, NW1 / 256, G, bid, 0, 0, PROBE_DUP == 1 ? 2 : 1);
        pg8::EpiProj E{(bf16*)(ws + WS_PROJ), (float*)(ws + WS_GATES)};
        pg8::gemm_phase<pg8::EpiProj, pg8::Order>(lds, g, S, E);
        if (BOTH(1)) GRID_BAR();
    }
    if (IN(2)) {
        const bf16* PROJ = (const bf16*)(ws + WS_PROJ);
#pragma nounroll
        for (int rep = 0; rep < (PROBE_DUP == 2 ? 2 : 1); ++rep) {
        gate_scans(args, gw, NGW, lane);
        conv_part<4096, 8, true>(PROJ, nullptr, args.in[I_MCW], args.in[I_MCB], (bf16*)(ws + WS_UC), args.out + O_PMCONV, gt, NGT);
        conv_part<4096, 4, false>(PROJ, args.in[I_MCONV], args.in[I_MCW], args.in[I_MCB], (bf16*)(ws + WS_UC), args.out + O_SMCONV, gt, NGT);
        conv_part<6144, 8, true>(PROJ + 20480, nullptr, args.in[I_SCW], args.in[I_SCB], (bf16*)(ws + WS_XBC), args.out + O_PSCONV, gt, NGT);
        conv_part<6144, 4, false>(PROJ + 20480, args.in[I_SCONV], args.in[I_SCW], args.in[I_SCB], (bf16*)(ws + WS_XBC), args.out + O_SSCONV, gt, NGT); }
        if (BOTH(2)) GRID_BAR();
    }
    if (IN(3)) {
        if (bid == 0 && wave == 0) mlstm_m_carry(args, lane);
        { pg8::Gemm g{(const bf16*)(ws + WS_UC), (const bf16*)(ws + WS_WQK), DM, 512, 512}; pg8::Order S; S.init(MTOK / 256, 16, G, bid, 1, 512, PROBE_DUP == 3 ? 2 : 1);
          pg8::EpiBf16 E{(bf16*)(ws + WS_QK), DM};
          pg8::gemm_phase<pg8::EpiBf16, pg8::Order>(lds, g, S, E); }
        { pg8::Gemm g{(const bf16*)(ws + WS_PB), (const bf16*)(ws + WS_WPT), 256, 256, 256}; pg8::Order S; S.init(MTOK / 256, 16, G, bid, 0, 0, PROBE_DUP == 3 ? 2 : 1);
          pg8::EpiBf16 E{(bf16*)(ws + WS_PPB), DM};
          pg8::gemm_phase<pg8::EpiBf16, pg8::Order>(lds, g, S, E); }
        if (BOTH(3)) GRID_BAR();
    }
    if (IN(4)) {
#pragma nounroll
        for (int rep = 0; rep < (PROBE_DUP == 40 ? 2 : 1); ++rep) for (int it = bid; it < 1024; it += G) m1_unit(args, lds, it, tid, lane, wave);
#pragma nounroll
        for (int rep = 0; rep < (PROBE_DUP == 41 ? 2 : 1); ++rep) for (int it = bid; it < 1024; it += G) s1_unit(args, lds, it, tid, lane, wave);
        if (BOTH(4)) GRID_BAR();
    }
    if (IN(5)) {
        if (bid >= G - 32) nscan_item(args, bid - (G - 32), tid);
#pragma nounroll
        for (int rep = 0; rep < (PROBE_DUP == 50 ? 2 : 1); ++rep)
        for (int it = bid; it < 256; it += G) { if (it < 128) m2_item(args, lds, it, tid, lane, wave); else s2_item(args, lds, it - 128, tid, lane, wave); }
#pragma nounroll
        for (int rep = 0; rep < (PROBE_DUP == 52 ? 2 : 1); ++rep) for (int it = bid; it < 1024; it += G) mlstm_sample_item(args, lds, it, tid, lane, wave);
#pragma nounroll
        for (int rep = 0; rep < (PROBE_DUP == 53 ? 2 : 1); ++rep) for (int it = bid; it < 1024; it += G) ssd_sample_item(args, lds, it, tid, lane, wave);
        if (BOTH(5)) GRID_BAR();
    }
    if (IN(6)) {
#pragma nounroll
        for (int rep = 0; rep < (PROBE_DUP == 6 ? 2 : 1); ++rep) { m3_pass(args, gw, NGW, lane); s3_pass(args, gw, NGW, lane); }
        if (BOTH(6)) GRID_BAR();
    }
    if (IN(7)) {
        pg8::Gemm g{(const bf16*)(ws + WS_MIX), (const bf16*)(ws + WS_W2T), 8192, 8192, 8192}; pg8::Order S; S.init(MTOK / 256, 16, G, bid, 0, 0, PROBE_DUP == 7 ? 2 : 1);
        pg8::EpiX1 E{args.in[I_XP], args.in[I_XS], args.in[I_PLENORM], (float*)(ws + WS_X1), (bf16*)(ws + WS_X1G), (float*)(ws + WS_RS1), PROBE_DUP == 7 ? 0.5f : 1.f};
        pg8::gemm_phase<pg8::EpiX1, pg8::Order>(lds, g, S, E);
        if (BOTH(7)) GRID_BAR();
    }
    if (IN(8)) {
        pg8::Gemm g{(const bf16*)(ws + WS_X1G), (const bf16*)(ws + WS_WGT), DM, DM, DM}; pg8::Order S; S.init(MTOK / 256, 16, G, bid, 0, 0, PROBE_DUP == 8 ? 2 : 1);
        pg8::EpiGate E{(const float*)(ws + WS_X1), (const bf16*)(ws + WS_PPB), (const float*)(ws + WS_RS1), args.out + O_Y, (float*)(ws + WS_RS2), PROBE_DUP == 8 ? 0.5f : 1.f};
        pg8::gemm_phase<pg8::EpiGate, pg8::Order>(lds, g, S, E);
        if (BOTH(8)) GRID_BAR();
    }
    if (IN(9)) {
        const float* RS2 = (const float*)(ws + WS_RS2); const float* fn = args.in[I_FNORM]; float* Y = args.out + O_Y;
        for (int i = gt; i < MTOK * 1024; i += NGT) { const int row = i >> 10, c4 = (i & 1023) * 4;
            const float rstd = rsqrtf(RS2[row] * (1.f / DM) + EPS);
            const f32x4 g4 = *(const f32x4*)(fn + c4); f32x4 v = *(f32x4*)(Y + (size_t)row * DM + c4);
            v = v * rstd * g4; *(f32x4*)(Y + (size_t)row * DM + c4) = v; }
    }
#undef IN
#undef BOTH
#undef GRID_BAR
}

extern "C" void kernel_launch(void* const* d_in, const int* in_sizes, int n_in, void* d_out, int out_size, void* d_ws, size_t ws_size, hipStream_t stream) {
    static int grid = 0;
    if (grid == 0) {
        if (n_in != N_IN || (size_t)out_size != O_END || ws_size < WS_END) { fprintf(stderr, "kernel_launch: unexpected sizes n_in %d out %d ws %zu\n", n_in, out_size, ws_size); grid = -1; return; }
        int dev = 0, cus = 0, per_cu = 0;
        if (hipGetDevice(&dev) != hipSuccess || hipDeviceGetAttribute(&cus, hipDeviceAttributeMultiprocessorCount, dev) != hipSuccess) { grid = -1; return; }
        if (hipFuncSetAttribute((const void*)mk_fwd, hipFuncAttributeMaxDynamicSharedMemorySize, LDS_BYTES) != hipSuccess) { fprintf(stderr, "kernel_launch: hipFuncSetAttribute failed\n"); grid = -1; return; }
        if (hipOccupancyMaxActiveBlocksPerMultiprocessor(&per_cu, (const void*)mk_fwd, NTHREADS, LDS_BYTES) != hipSuccess || per_cu < 1) { fprintf(stderr, "kernel_launch: occupancy query says %d\n", per_cu); }
        (void)hipGetLastError();
        grid = cus;
    }
    if (grid < 0) return;
    if (hipMemsetAsync((char*)d_ws + WS_CTL, 0, CTL_ZERO_BYTES, stream) != hipSuccess) return;
    Args a{};
    for (int i = 0; i < N_IN; ++i) a.in[i] = (const float*)d_in[i];
    a.out = (float*)d_out; a.ws = (unsigned char*)d_ws;
    constexpr int NPH = 10;
    if (MK_N_LAUNCHES == 1) { a.ph_lo = 0; a.ph_hi = NPH; hipLaunchKernelGGL(mk_fwd, dim3(grid), dim3(NTHREADS), LDS_BYTES, stream, a); }
    else for (int p = 0; p < NPH; ++p) { a.ph_lo = p; a.ph_hi = p + 1; hipLaunchKernelGGL(mk_fwd, dim3(grid), dim3(NTHREADS), LDS_BYTES, stream, a); }
}
```

```cpp
#include <hip/hip_runtime.h>
#include <cstdio>

#ifndef PROBE_DUP
#define PROBE_DUP -1
#endif
#ifndef PG8_SP2
#define PG8_SP2 true
#endif
#ifndef MK_N_LAUNCHES
#define MK_N_LAUNCHES 1
#endif

#define GAS __attribute__((address_space(1)))
#define LAS __attribute__((address_space(3)))
typedef unsigned short bf16;
typedef unsigned v4u __attribute__((ext_vector_type(4)));
typedef unsigned v2u __attribute__((ext_vector_type(2)));
typedef float f32x4 __attribute__((ext_vector_type(4)));
typedef float f32x2 __attribute__((ext_vector_type(2)));
typedef short bf16x8 __attribute__((ext_vector_type(8)));

constexpr int NWAVES = 8, NTHREADS = 512;
constexpr int MTOK = 8704, MPR = 8192, DM = 4096, SEQ = 2048;
constexpr int NPROJ = 26624, NW1 = 26880, INCOLS = 26704;
constexpr int LDX = 4160, LDM = 8256, LDP = 320, LDQ = 576;
constexpr float EPS = 1e-6f;
enum { I_XP = 0, I_XS, I_PP, I_PS, I_MC, I_MN, I_MM, I_MCONV, I_SSSM, I_SCONV, I_NORMIN, I_WIN, I_BIG, I_BFG, I_MCW, I_MCB, I_WQ, I_WK, I_MNORM,
       I_SCW, I_SCB, I_DTB, I_ALOG, I_DSKIP, I_SNORM, I_WOUT, I_PLEPROJ, I_PLEGATE, I_PLENORM, I_FNORM, N_IN };
constexpr size_t O_Y = 0, O_PC = 35651584, O_PN = 39845888, O_PM = 39854080, O_PMCONV = 39854112, O_PSSM = 39903264, O_PSCONV = 42000416,
                 O_SC = 42074144, O_SN = 176291872, O_SM = 176554016, O_SMCONV = 176555040, O_SSSM = 178127904, O_SSCONV = 245236768, O_END = 247596064;
constexpr size_t MiB = 1u << 20;
constexpr size_t WS_CTL = 0, CTL_ZERO_BYTES = 4 * MiB;
constexpr size_t WS_NRM = 1 * MiB, WS_RS1 = 2 * MiB, WS_RS2 = 2 * MiB + 65536;
constexpr size_t WS_W1T = 4 * MiB, WS_W2T = 218 * MiB, WS_WGT = 283 * MiB, WS_WPT = 316 * MiB, WS_WQK = 319 * MiB, WS_XN = 324 * MiB, WS_PB = 394 * MiB,
                 WS_PROJ = 400 * MiB, WS_GATES = 842 * MiB, WS_UC = 851 * MiB, WS_QK = 921 * MiB, WS_XBC = 989 * MiB, WS_MG = 1091 * MiB, WS_SG = 1093 * MiB,
                 WS_MIX = 1098 * MiB, WS_X1 = 1236 * MiB, WS_X1G = 1372 * MiB, WS_PPB = 1442 * MiB,
                 WS_KWT = 1510 * MiB, WS_XWT = 1542 * MiB, WS_BMT = 1606 * MiB, WS_KWS = 1622 * MiB, WS_NALL = 1623 * MiB, WS_DENI = 1624 * MiB, WS_CS = 1625 * MiB, WS_MPD = 1626 * MiB, WS_END = 1627 * MiB;
constexpr size_t WS_NUMI = WS_UC, WS_INTER = WS_XN, WS_YI = WS_W1T, WS_YS = WS_W1T + 64 * MiB, WS_VT = WS_W1T + 128 * MiB;
constexpr int CW_TMO = 0, CW_BAR = 4096;
constexpr int LDSCTL_OFF = 131072, LDS_BYTES = 147456;

__device__ __forceinline__ unsigned f2bf(float f) { unsigned u = __builtin_bit_cast(unsigned, f); return (u + 0x7fffu + ((u >> 16) & 1u)) >> 16; }
typedef __bf16 bf16x2_t __attribute__((ext_vector_type(2)));
__device__ __forceinline__ unsigned pk2(float lo, float hi) { const f32x2 v = {lo, hi}; return __builtin_bit_cast(unsigned, __builtin_convertvector(v, bf16x2_t)); }
__device__ __forceinline__ float bflo(unsigned w) { return __builtin_bit_cast(float, w << 16); }
__device__ __forceinline__ float bfhi(unsigned w) { return __builtin_bit_cast(float, w & 0xffff0000u); }
__device__ __forceinline__ float bf2f(bf16 b) { return __builtin_bit_cast(float, (unsigned)b << 16); }
__device__ __forceinline__ float sigm(float x) { return 1.f / (1.f + __expf(-x)); }
__device__ __forceinline__ float silu(float x) { return x / (1.f + __expf(-x)); }
__device__ __forceinline__ float softplus(float x) { return fmaxf(x, 0.f) + log1pf(__expf(-fabsf(x))); }
__device__ __forceinline__ float softcap(float x) { return 15.f * tanhf(x * (1.f / 15.f)); }
__device__ __forceinline__ float wave_sum(float v) {
#pragma unroll
    for (int o = 1; o < 64; o <<= 1) v += __shfl_xor(v, o);
    return v;
}
#define LDS_WAIT() asm volatile("s_waitcnt lgkmcnt(0)" ::: "memory")

namespace pg8 {
constexpr int BM = 256, BK = 64, HALF = 128, HTB = HALF * BK * 2, STAGE_BYTES = 8 * HTB, NXCD = 8, WGM = 8;
__host__ __device__ __forceinline__ int lds_byte(int r, int c) { const int st = (r >> 4) * 2 + (c >> 5), rr = r & 15, cc = c & 31, ob = rr * 64 + cc * 2; return st * 1024 + (ob ^ (((ob >> 9) & 1) << 5)); }
__host__ __device__ __forceinline__ void stage_rc(int b, int& R, int& C) { const int st = b / 1024, sb = b % 1024, swz = sb ^ (((sb >> 9) & 1) << 5); R = (st >> 1) * 16 + swz / 64; C = (st & 1) * 32 + (swz % 64) / 2; }
__host__ __device__ __forceinline__ int perm32(int rho) { const int n = rho >> 4, i = rho & 15; return 8 * (i >> 2) + 4 * n + (i & 3); }
struct Unit { int pm, pn; };
struct Gemm { const bf16* A; const bf16* Bt; int lda, ldb, K; };
struct Order {
    int nM, nN, nwg, G, c, kshift, kmul, rep;
    __device__ void init(int nM_, int nN_, int G_, int c_, int kshift_ = 0, int kmul_ = 0, int rep_ = 1) { nM = nM_; nN = nN_; nwg = nM * nN; G = G_; c = c_; kshift = kshift_; kmul = kmul_; rep = rep_; }
    __device__ bool next(int i, Unit& u) const {
        const int L = i * G + c; if (L >= nwg * rep) return false;
        int wgid = (rep == 1) ? L : (L % nwg); { const int q = nwg / NXCD, r = nwg % NXCD, xcd = wgid % NXCD, off = wgid / NXCD; wgid = (xcd < r ? xcd * (q + 1) : r * (q + 1) + (xcd - r) * q) + off; }
        const int nig = WGM * nN, gid = wgid / nig, fm = gid * WGM, gsz = (nM - fm) < WGM ? (nM - fm) : WGM;
        u.pm = fm + ((wgid % nig) % gsz); u.pn = (wgid % nig) / gsz; return true;
    }
    __device__ __forceinline__ int a_koff(const Unit& u) const { return (u.pn >> kshift) * kmul; }
    __device__ __forceinline__ void a_ready(const Unit&) const {}
    __device__ __forceinline__ void done(const Unit&) const {}
};

template <class Epi, class Sched, bool ALIGN_EPI = true, bool SP2 = PG8_SP2>
__device__ __forceinline__ void gemm_phase(LAS unsigned char* lds, const Gemm g, const Sched& S, const Epi& E) {
    const int tid = threadIdx.x, wid = __builtin_amdgcn_readfirstlane(tid >> 6), lane = tid & 63, wr = wid >> 2, wc = wid & 3, fr = lane & 15, fq = lane >> 4;
    const int K = g.K, nt = K / BK;
    unsigned voffA[2], voffB[2];
#pragma unroll
    for (int i = 0; i < 2; ++i) { int R, C; stage_rc(tid * 16 + i * 8192, R, C); const int Rb = Epi::PERM ? ((R & ~31) + perm32(R & 31)) : R;
        voffA[i] = (unsigned)(R * g.lda + C) * 2u; voffB[i] = (unsigned)(Rb * g.ldb + C) * 2u; }
    const size_t kstep = (size_t)(BK * 2);
    const size_t hstepA = (size_t)HALF * g.lda * 2, hstepB = (size_t)HALF * g.ldb * 2;
    const size_t tstepA = 2 * hstepA, tstepB = 2 * hstepB;
    const unsigned ldsw = (unsigned)wid * 1024u;
    const int aoff = lds_byte(wr * 64 + fr, fq * 8), boff = lds_byte(wc * 32 + fr, fq * 8);
#define PG8_SA(b, h) (((b) * 2 + (h)) * HTB)
#define PG8_SB(b, h) ((4 + (b) * 2 + (h)) * HTB)
#define PG8_STAGE(bufoff, gbase, voff) do { _Pragma("unroll") for (int _i = 0; _i < 2; ++_i) \
        __builtin_amdgcn_global_load_lds((const unsigned*)((const char*)(gbase) + (voff)[_i]), (LAS unsigned*)(lds + (bufoff) + ldsw + _i * 8192), 16, 0, 0); } while (0)
#define PG8_LDA(dst, b, h) do { _Pragma("unroll") for (int m = 0; m < 4; ++m) _Pragma("unroll") for (int k = 0; k < 2; ++k) dst[m][k] = *(const LAS bf16x8*)(lds + PG8_SA(b, h) + aoff + m * 2048 + k * 1024); } while (0)
#define PG8_LDB(dst, b, h) do { _Pragma("unroll") for (int n = 0; n < 2; ++n) _Pragma("unroll") for (int k = 0; k < 2; ++k) dst[n][k] = *(const LAS bf16x8*)(lds + PG8_SB(b, h) + boff + n * 2048 + k * 1024); } while (0)
#define PG8_MMA(ai, bj, At, Bt) do { __builtin_amdgcn_s_setprio(1); _Pragma("unroll") for (int m = 0; m < 4; ++m) _Pragma("unroll") for (int n = 0; n < 2; ++n) _Pragma("unroll") for (int k = 0; k < 2; ++k) \
        acc[ai][bj][m][n] = __builtin_amdgcn_mfma_f32_16x16x32_bf16(Bt[n][k], At[m][k], acc[ai][bj][m][n], 0, 0, 0); __builtin_amdgcn_s_setprio(0); } while (0)
#define PG8_WAIT_V(n) asm volatile("s_waitcnt vmcnt(" #n ")" ::: "memory")
#define PG8_WAIT_L(n) asm volatile("s_waitcnt lgkmcnt(" #n ")" ::: "memory")
#define PG8_BAR __builtin_amdgcn_s_barrier()
#define PG8_SCHED __builtin_amdgcn_sched_barrier(0)
    Unit cur, nxt; int ui = 0;
    if (!S.next(0, cur)) return;
    f32x4 acc[2][2][4][2];
#pragma unroll
    for (int a = 0; a < 2; ++a)
#pragma unroll
        for (int b = 0; b < 2; ++b)
#pragma unroll
            for (int m = 0; m < 4; ++m)
#pragma unroll
                for (int n = 0; n < 2; ++n) acc[a][b][m][n] = (f32x4){0.f, 0.f, 0.f, 0.f};
    bf16x8 At[4][2], B0[2][2], B1[2][2];
    const char* cA = (const char*)g.A + (size_t)cur.pm * tstepA + (size_t)S.a_koff(cur) * 2; const char* cB = (const char*)g.Bt + (size_t)cur.pn * tstepB;
    S.a_ready(cur);
    if constexpr (SP2) {
    PG8_STAGE(PG8_SB(0, 0), cB, voffB); PG8_STAGE(PG8_SB(0, 1), cB + hstepB, voffB); PG8_STAGE(PG8_SA(0, 0), cA, voffA); PG8_STAGE(PG8_SA(0, 1), cA + hstepA, voffA);
    if (wr == 1) PG8_BAR;
    PG8_WAIT_V(2); PG8_BAR;
    PG8_STAGE(PG8_SB(1, 0), cB + kstep, voffB); PG8_STAGE(PG8_SA(1, 0), cA + kstep, voffA); PG8_STAGE(PG8_SB(1, 1), cB + hstepB + kstep, voffB);
    PG8_WAIT_V(6); PG8_BAR;
    } else {
    PG8_STAGE(PG8_SB(0, 0), cB, voffB); PG8_STAGE(PG8_SA(0, 0), cA, voffA); PG8_STAGE(PG8_SB(0, 1), cB + hstepB, voffB); PG8_STAGE(PG8_SA(0, 1), cA + hstepA, voffA);
    if (wr == 1) PG8_BAR;
    PG8_WAIT_V(4); PG8_BAR;
    PG8_STAGE(PG8_SB(1, 0), cB + kstep, voffB); PG8_STAGE(PG8_SA(1, 0), cA + kstep, voffA); PG8_STAGE(PG8_SB(1, 1), cB + hstepB + kstep, voffB);
    PG8_WAIT_V(6); PG8_BAR;
    }
    for (;;) {
        const bool has_next = S.next(ui + 1, nxt);
        const char* nA = has_next ? (const char*)g.A + (size_t)nxt.pm * tstepA + (size_t)S.a_koff(nxt) * 2 : cA; const char* nB = has_next ? (const char*)g.Bt + (size_t)nxt.pn * tstepB : cB;
        for (int t = 0; t < nt; t += 2) {
            const bool last = (t == nt - 2);
            const char* a1 = cA + (size_t)(t + 1) * kstep;
            const char* a2 = last ? nA : cA + (size_t)(t + 2) * kstep; const char* b2 = last ? nB : cB + (size_t)(t + 2) * kstep;
            const char* a3 = a2 + kstep; const char* b3 = b2 + kstep;
            if (last && has_next) S.a_ready(nxt);
            if constexpr (SP2) {
            PG8_LDB(B0, 0, 0); PG8_LDB(B1, 0, 1); PG8_SCHED; PG8_LDA(At, 0, 0); PG8_STAGE(PG8_SA(1, 1), a1 + hstepA, voffA);
            PG8_WAIT_V(8); PG8_WAIT_L(0); PG8_BAR; PG8_MMA(0, 0, At, B0); PG8_MMA(0, 1, At, B1); PG8_BAR; PG8_SCHED;
            PG8_LDA(At, 0, 1); PG8_STAGE(PG8_SB(0, 0), b2, voffB); PG8_STAGE(PG8_SB(0, 1), b2 + hstepB, voffB); PG8_STAGE(PG8_SA(0, 0), a2, voffA);
            PG8_WAIT_V(8); PG8_WAIT_L(0); PG8_BAR; PG8_MMA(1, 0, At, B0); PG8_MMA(1, 1, At, B1); PG8_BAR; PG8_SCHED;
            PG8_LDB(B0, 1, 0); PG8_LDB(B1, 1, 1); PG8_SCHED; PG8_LDA(At, 1, 0); PG8_STAGE(PG8_SA(0, 1), a2 + hstepA, voffA);
            PG8_WAIT_V(8); PG8_WAIT_L(0); PG8_BAR; PG8_MMA(0, 0, At, B0); PG8_MMA(0, 1, At, B1); PG8_BAR; PG8_SCHED;
            PG8_LDA(At, 1, 1); PG8_STAGE(PG8_SB(1, 0), b3, voffB); PG8_STAGE(PG8_SB(1, 1), b3 + hstepB, voffB); PG8_STAGE(PG8_SA(1, 0), a3, voffA);
            PG8_WAIT_V(8); PG8_WAIT_L(0); PG8_BAR; PG8_MMA(1, 0, At, B0); PG8_MMA(1, 1, At, B1); PG8_BAR; PG8_SCHED;
            } else {
            PG8_LDB(B0, 0, 0); PG8_SCHED; PG8_LDA(At, 0, 0); PG8_STAGE(PG8_SA(1, 1), a1 + hstepA, voffA);
            PG8_WAIT_L(8); PG8_BAR; PG8_WAIT_L(0); PG8_MMA(0, 0, At, B0); PG8_BAR; PG8_SCHED;
            PG8_LDB(B1, 0, 1); PG8_STAGE(PG8_SB(0, 0), b2, voffB);
            PG8_BAR; PG8_WAIT_L(0); PG8_MMA(0, 1, At, B1); PG8_BAR;
            PG8_LDA(At, 0, 1); PG8_STAGE(PG8_SA(0, 0), a2, voffA);
            PG8_BAR; PG8_WAIT_L(0); PG8_MMA(1, 0, At, B0); PG8_BAR; PG8_SCHED;
            PG8_STAGE(PG8_SB(0, 1), b2 + hstepB, voffB);
            PG8_WAIT_V(6); PG8_BAR; PG8_MMA(1, 1, At, B1); PG8_BAR;
            PG8_LDB(B0, 1, 0); PG8_SCHED; PG8_LDA(At, 1, 0); PG8_STAGE(PG8_SA(0, 1), a2 + hstepA, voffA);
            PG8_WAIT_L(8); PG8_BAR; PG8_WAIT_L(0); PG8_MMA(0, 0, At, B0); PG8_BAR; PG8_SCHED;
            PG8_LDB(B1, 1, 1); PG8_STAGE(PG8_SB(1, 0), b3, voffB);
            PG8_BAR; PG8_WAIT_L(0); PG8_MMA(0, 1, At, B1); PG8_BAR;
            PG8_LDA(At, 1, 1); PG8_STAGE(PG8_SA(1, 0), a3, voffA);
            PG8_BAR; PG8_WAIT_L(0); PG8_MMA(1, 0, At, B0); PG8_BAR; PG8_SCHED;
            PG8_STAGE(PG8_SB(1, 1), b3 + hstepB, voffB);
            PG8_WAIT_V(6); PG8_BAR; PG8_MMA(1, 1, At, B1); PG8_BAR;
            }
        }
        if constexpr (ALIGN_EPI) { if (wr == 0) PG8_BAR; }
        E(acc, cur, wr, wc, fr, fq); S.done(cur);
        if (!has_next) break;
#pragma unroll
        for (int a = 0; a < 2; ++a)
#pragma unroll
            for (int b = 0; b < 2; ++b)
#pragma unroll
                for (int m = 0; m < 4; ++m)
#pragma unroll
                    for (int n = 0; n < 2; ++n) acc[a][b][m][n] = (f32x4){0.f, 0.f, 0.f, 0.f};
        cur = nxt; cA = nA; cB = nB; ++ui;
        if constexpr (ALIGN_EPI) { if (wr == 1) PG8_BAR; }
    }
    PG8_WAIT_V(0);
    if constexpr (!ALIGN_EPI) { if (wr == 0) PG8_BAR; }
    PG8_BAR;
#undef PG8_SA
#undef PG8_SB
#undef PG8_STAGE
#undef PG8_LDA
#undef PG8_LDB
#undef PG8_MMA
#undef PG8_WAIT_V
#undef PG8_WAIT_L
#undef PG8_BAR
#undef PG8_SCHED
}

struct EpiBf16 {
    static constexpr bool PERM = true;
    bf16* O; int ldc;
    __device__ __forceinline__ void operator()(const f32x4 (&acc)[2][2][4][2], const Unit& u, int wr, int wc, int fr, int fq) const {
        const int row0 = u.pm * BM + wr * 64 + fr, col0 = u.pn * BM + wc * 32 + 8 * fq;
#pragma unroll
        for (int ai = 0; ai < 2; ++ai)
#pragma unroll
            for (int m = 0; m < 4; ++m) { bf16* rowp = O + (size_t)(row0 + ai * HALF + m * 16) * ldc + col0;
#pragma unroll
                for (int bj = 0; bj < 2; ++bj) { const f32x4 v0 = acc[ai][bj][m][0], v1 = acc[ai][bj][m][1];
                    v4u w; w.x = pk2(v0[0], v0[1]); w.y = pk2(v0[2], v0[3]); w.z = pk2(v1[0], v1[1]); w.w = pk2(v1[2], v1[3]);
                    *(v4u*)(rowp + bj * HALF) = w; } }
    }
};
struct EpiProj {
    static constexpr bool PERM = true;
    bf16* O; float* Gt;
    __device__ __forceinline__ void operator()(const f32x4 (&acc)[2][2][4][2], const Unit& u, int wr, int wc, int fr, int fq) const {
        const int row0 = u.pm * BM + wr * 64 + fr;
        if (u.pn < 104) {
            const int col0 = u.pn * BM + wc * 32 + 8 * fq;
#pragma unroll
            for (int ai = 0; ai < 2; ++ai)
#pragma unroll
                for (int m = 0; m < 4; ++m) { bf16* rowp = O + (size_t)(row0 + ai * HALF + m * 16) * NPROJ + col0;
#pragma unroll
                    for (int bj = 0; bj < 2; ++bj) { const f32x4 v0 = acc[ai][bj][m][0], v1 = acc[ai][bj][m][1];
                        v4u w; w.x = pk2(v0[0], v0[1]); w.y = pk2(v0[2], v0[3]); w.z = pk2(v1[0], v1[1]); w.w = pk2(v1[2], v1[3]);
                        *(v4u*)(rowp + bj * HALF) = w; } }
        } else {
            const int col0 = wc * 32 + 8 * fq;
#pragma unroll
            for (int ai = 0; ai < 2; ++ai)
#pragma unroll
                for (int m = 0; m < 4; ++m) { float* rowp = Gt + (size_t)(row0 + ai * HALF + m * 16) * 256 + col0;
#pragma unroll
                    for (int bj = 0; bj < 2; ++bj)
#pragma unroll
                        for (int n = 0; n < 2; ++n) *(f32x4*)(rowp + bj * HALF + 4 * n) = acc[ai][bj][m][n]; }
        }
    }
};
struct EpiX1 {
    static constexpr bool PERM = false;
    const float* xp; const float* xs; const float* gn; float* X1; bf16* X1G; float* RS; float ssw;
    __device__ __forceinline__ void operator()(const f32x4 (&acc)[2][2][4][2], const Unit& u, int wr, int wc, int fr, int fq) const {
        const int row0 = u.pm * BM + wr * 64 + fr, col0 = u.pn * BM + wc * 32 + 4 * fq;
#pragma unroll
        for (int ai = 0; ai < 2; ++ai)
#pragma unroll
            for (int m = 0; m < 4; ++m) { const int row = row0 + ai * HALF + m * 16;
                const float* xrow = (row < MPR ? xp + (size_t)row * DM : xs + (size_t)(row - MPR) * DM) + col0; const size_t off = (size_t)row * DM + col0; float ss = 0.f;
#pragma unroll
                for (int bj = 0; bj < 2; ++bj)
#pragma unroll
                    for (int n = 0; n < 2; ++n) { const int co = bj * HALF + n * 16; const f32x4 v = *(const f32x4*)(xrow + co) + acc[ai][bj][m][n];
                        *(f32x4*)(X1 + off + co) = v; ss += (v[0] * v[0] + v[1] * v[1]) + (v[2] * v[2] + v[3] * v[3]);
                        const f32x4 gv = *(const f32x4*)(gn + col0 + co); v2u w; w.x = pk2(v[0] * gv[0], v[1] * gv[1]); w.y = pk2(v[2] * gv[2], v[3] * gv[3]);
                        *(v2u*)(X1G + (size_t)row * LDX + col0 + co) = w; }
                ss += __shfl_xor(ss, 16); ss += __shfl_xor(ss, 32);
                if (fq == 0) atomicAdd(RS + row, ss * ssw); }
    }
};
struct EpiGate {
    static constexpr bool PERM = false;
    const float* X1; const bf16* PP; const float* RS1; float* out; float* RS2; float ssw;
    __device__ __forceinline__ void operator()(const f32x4 (&acc)[2][2][4][2], const Unit& u, int wr, int wc, int fr, int fq) const {
        const int row0 = u.pm * BM + wr * 64 + fr, col0 = u.pn * BM + wc * 32 + 4 * fq;
#pragma unroll
        for (int ai = 0; ai < 2; ++ai)
#pragma unroll
            for (int m = 0; m < 4; ++m) { const int row = row0 + ai * HALF + m * 16; const size_t off = (size_t)row * DM + col0; float ss = 0.f;
                const float rstd = rsqrtf(RS1[row] * (1.f / DM) + EPS);
#pragma unroll
                for (int bj = 0; bj < 2; ++bj)
#pragma unroll
                    for (int n = 0; n < 2; ++n) { const int co = bj * HALF + n * 16; const f32x4 a = acc[ai][bj][m][n] * rstd; const v2u pw = *(const v2u*)(PP + off + co);
                        const f32x4 x1 = *(const f32x4*)(X1 + off + co); f32x4 v;
                        v[0] = x1[0] + sigm(a[0]) * bflo(pw.x); v[1] = x1[1] + sigm(a[1]) * bfhi(pw.x); v[2] = x1[2] + sigm(a[2]) * bflo(pw.y); v[3] = x1[3] + sigm(a[3]) * bfhi(pw.y);
                        *(f32x4*)(out + off + co) = v; ss += (v[0] * v[0] + v[1] * v[1]) + (v[2] * v[2] + v[3] * v[3]); }
                ss += __shfl_xor(ss, 16); ss += __shfl_xor(ss, 32);
                if (fq == 0) atomicAdd(RS2 + row, ss * ssw); }
    }
};
}

#define XB_TMO      128
#define XB_XCNT(j)  (256  + 64 * (j))
#define XB_XSUB(j)  (1280 + 64 * (j))
#define XB_XGEN(j)  (2304 + 64 * (j))
#define XB_TOP      3328
#define XB_TOPGEN   3392
#define XCD_BAR_WORDS 3456
#define XB_SPIN_CAP (1u << 18)
__device__ __forceinline__ unsigned xb_ld(unsigned* p)              { return __hip_atomic_load(p, __ATOMIC_RELAXED, __HIP_MEMORY_SCOPE_AGENT); }
__device__ __forceinline__ unsigned xb_add(unsigned* p, unsigned v) { return __hip_atomic_fetch_add(p, v, __ATOMIC_RELAXED, __HIP_MEMORY_SCOPE_AGENT); }
__device__ __forceinline__ unsigned xb_xcc_id() { return (unsigned)__builtin_amdgcn_s_getreg((3 << 11) | 20) & 0xFu; }
#define XB_SPIN(cond, bar) do { unsigned _sp = 0; while (cond) { __builtin_amdgcn_s_sleep(1); \
    if ((++_sp & 255u) == 0u) { if (xb_ld(&(bar)[XB_TMO])) break; if (_sp > XB_SPIN_CAP) { atomicAdd(&(bar)[XB_TMO], 1u); break; } } } } while (0)
struct XcdBarrier { unsigned* bar; unsigned x; volatile LAS unsigned* st; };
__device__ __forceinline__ XcdBarrier xcd_barrier_post(unsigned* bar, volatile LAS unsigned* st) {
    XcdBarrier b; b.bar = bar; b.x = xb_xcc_id(); b.st = st;
    if (threadIdx.x == 0) (void)xb_add(&bar[XB_XCNT(b.x)], 1u);
    return b;
}
__device__ __forceinline__ void xcd_barrier_complete(unsigned* bar, unsigned x, unsigned& nloc, unsigned& nx) {
    const unsigned G = gridDim.x * gridDim.y * gridDim.z;
    unsigned sum, cnt, mine, sp = 0u;
    for (;;) {
        sum = 0u; cnt = 0u; mine = 0u;
#pragma unroll
        for (unsigned j = 0; j < 16; ++j) { const unsigned c = xb_ld(&bar[XB_XCNT(j)]); sum += c; cnt += (c > 0u) ? 1u : 0u; mine = (j == x) ? c : mine; }
        if (sum == G) break;
        __builtin_amdgcn_s_sleep(1);
        if ((++sp & 255u) == 0u) { if (xb_ld(&bar[XB_TMO])) break; if (sp > XB_SPIN_CAP) { atomicAdd(&bar[XB_TMO], 1u); break; } }
    }
    nloc = mine > 0u ? mine : 1u; nx = cnt > 0u ? cnt : 1u;
}
__device__ __forceinline__ void xcd_barrier(const XcdBarrier& b) {
    asm volatile("s_waitcnt vmcnt(0)" ::: "memory");
    __syncthreads();
    if (threadIdx.x == 0) {
        unsigned* bar = b.bar;
        __builtin_amdgcn_s_waitcnt(0);
        unsigned nloc = b.st[0], nx = b.st[1];
        if (nloc == 0u) { xcd_barrier_complete(bar, b.x, nloc, nx); b.st[0] = nloc; b.st[1] = nx; }
        const unsigned old = xb_add(&bar[XB_XSUB(b.x)], 1u);
        const unsigned gen = old / nloc;
        if (old + 1u == (gen + 1u) * nloc) {
            __builtin_amdgcn_fence(__ATOMIC_RELEASE, "agent");
            asm volatile("s_waitcnt vmcnt(0)" ::: "memory");
            const unsigned og = xb_add(&bar[XB_TOP], 1u);
            const unsigned tg = og / nx;
            if (og + 1u == (tg + 1u) * nx) xb_add(&bar[XB_TOPGEN], 1u);
            else XB_SPIN(xb_ld(&bar[XB_TOPGEN]) == tg, bar);
            __builtin_amdgcn_fence(__ATOMIC_ACQUIRE, "agent");
            xb_add(&bar[XB_XGEN(b.x)], 1u);
            asm volatile("s_waitcnt vmcnt(0)" ::: "memory");
        } else {
            XB_SPIN(xb_ld(&bar[XB_XGEN(b.x)]) == gen, bar);
            __builtin_amdgcn_fence(__ATOMIC_ACQUIRE, "agent");
            asm volatile("s_waitcnt vmcnt(0)" ::: "memory");
        }
    }
    __syncthreads();
}

struct Args { const float* in[N_IN]; float* out; unsigned char* ws; int ph_lo, ph_hi; };

template <int K>
__device__ __forceinline__ f32x4 mma_nt(const LAS bf16* X, int ldx, const LAS bf16* Y, int ldy, f32x4 acc, int lane) {
    const int r = lane & 15, kq = (lane >> 4) * 8;
#pragma unroll
    for (int k0 = 0; k0 < K; k0 += 32) {
        const bf16x8 a = *(const LAS bf16x8*)(X + r * ldx + k0 + kq);
        const bf16x8 b = *(const LAS bf16x8*)(Y + r * ldy + k0 + kq);
        acc = __builtin_amdgcn_mfma_f32_16x16x32_bf16(a, b, acc, 0, 0, 0);
    }
    return acc;
}

__device__ __forceinline__ int w1_colmap(int n) { return n < 16384 ? n : (n < 26624 ? n + 16 : (n < 26640 ? n - 26624 + 16384 : (n < INCOLS ? n : -1))); }
template <bool MAP>
__device__ __forceinline__ void transpose_item(const float* W, int ldw, bf16* WT, int ldt, int k0, int n0, LAS float* scr, int lane, float scale) {
    const int nn = n0 + (lane & 31); const int oc = MAP ? w1_colmap(nn) : nn;
    const int loff = (lane >> 5) * ldw + (oc >= 0 ? oc : 0);
    float tv[32];
#pragma unroll
    for (int i = 0; i < 32; ++i) { const float* rowp = W + (size_t)(k0 + 2 * i) * ldw; tv[i] = rowp[loff]; }
#pragma unroll
    for (int i = 0; i < 32; ++i) { const int kk = 2 * i + (lane >> 5); scr[kk * 33 + (lane & 31)] = (oc >= 0) ? tv[i] * scale : 0.f; }
    LDS_WAIT(); asm volatile("" ::: "memory");
    const int c = lane & 7;
#pragma unroll
    for (int j = 0; j < 4; ++j) { const int n = (lane >> 3) + 8 * j; const LAS float* s = scr + (8 * c) * 33 + n;
        v4u o; o.x = pk2(s[0 * 33], s[1 * 33]); o.y = pk2(s[2 * 33], s[3 * 33]); o.z = pk2(s[4 * 33], s[5 * 33]); o.w = pk2(s[6 * 33], s[7 * 33]);
        *(v4u*)(WT + (size_t)(n0 + n) * ldt + k0 + 8 * c) = o; }
    LDS_WAIT(); asm volatile("" ::: "memory");
}
__device__ __forceinline__ void p0_prologue(const Args& A, LAS unsigned char* lds, int gw, int NGW, int lane, int wave) {
    LAS float* scr = (LAS float*)(lds + wave * 16384);
    unsigned char* ws = A.ws;
    constexpr int I1 = 64 * 840, I2 = 128 * 128, I3 = 64 * 128, I4 = 4 * 128, I5 = 1024;
    for (int it = gw; it < I1 + I2 + I3 + I4 + I5; it += NGW) {
        int r = it;
        if (r < I1) { transpose_item<true>(A.in[I_WIN], INCOLS, (bf16*)(ws + WS_W1T), LDX, (r / 840) * 64, (r % 840) * 32, scr, lane, 1.f); continue; } r -= I1;
        if (r < I2) { transpose_item<false>(A.in[I_WOUT], DM, (bf16*)(ws + WS_W2T), LDM, (r / 128) * 64, (r % 128) * 32, scr, lane, 1.f); continue; } r -= I2;
        if (r < I3) { transpose_item<false>(A.in[I_PLEGATE], DM, (bf16*)(ws + WS_WGT), LDX, (r / 128) * 64, (r % 128) * 32, scr, lane, 1.f); continue; } r -= I3;
        if (r < I4) { transpose_item<false>(A.in[I_PLEPROJ], DM, (bf16*)(ws + WS_WPT), LDP, (r / 128) * 64, (r % 128) * 32, scr, lane, 1.f); continue; } r -= I4;
        { const int hw = r >> 6, h = hw >> 1, which = hw & 1, q = r & 63;
          const float* W = (which ? A.in[I_WK] : A.in[I_WQ]) + (size_t)h * 512 * 256;
          transpose_item<false>(W, 256, (bf16*)(ws + WS_WQK) + (size_t)(h * 512 + which * 256) * LDQ, LDQ, (q >> 3) * 64, (q & 7) * 32, scr, lane, which ? 0.0625f : 1.f); }
    }
    const float* gn = A.in[I_NORMIN];
    for (int m = gw; m < MTOK; m += NGW) {
        const float* xrow = m < MPR ? A.in[I_XP] + (size_t)m * DM : A.in[I_XS] + (size_t)(m - MPR) * DM;
        f32x4 v[16]; float s = 0.f;
#pragma unroll
        for (int j = 0; j < 16; ++j) { v[j] = ((const f32x4*)xrow)[lane + 64 * j]; s += (v[j][0] * v[j][0] + v[j][1] * v[j][1]) + (v[j][2] * v[j][2] + v[j][3] * v[j][3]); }
        const float rstd = rsqrtf(wave_sum(s) * (1.f / DM) + EPS);
        bf16* orow = (bf16*)(ws + WS_XN) + (size_t)m * LDX;
#pragma unroll
        for (int j = 0; j < 16; ++j) { const f32x4 g4 = ((const f32x4*)gn)[lane + 64 * j]; v2u w; w.x = pk2(v[j][0] * rstd * g4[0], v[j][1] * rstd * g4[1]); w.y = pk2(v[j][2] * rstd * g4[2], v[j][3] * rstd * g4[3]);
            ((v2u*)orow)[lane + 64 * j] = w; }
    }
    { const int gt = gw * 64 + lane, NGT = NGW * 64;
      for (int i = gt; i < MTOK * 32; i += NGT) { const int row = i >> 5, c8 = (i & 31) * 8;
          const float* src = (row < MPR ? A.in[I_PP] + (size_t)row * 256 : A.in[I_PS] + (size_t)(row - MPR) * 256) + c8;
          const f32x4 a = *(const f32x4*)src, b = *(const f32x4*)(src + 4);
          v4u w; w.x = pk2(a[0], a[1]); w.y = pk2(a[2], a[3]); w.z = pk2(b[0], b[1]); w.w = pk2(b[2], b[3]);
          *(v4u*)((bf16*)(ws + WS_PB) + (size_t)row * LDP + c8) = w; } }
}

template <int NCH, int NT, bool PROMPT>
__device__ __forceinline__ void conv_part(const bf16* src  , const float* state_in, const float* w, const float* bias, bf16* dst, int dst_ld, float* out_state, int gt, int NGT) {
    constexpr int CG = NCH / 8, NBLK = PROMPT ? SEQ / NT : 1, NSEQ = PROMPT ? 4 : 128;
    for (int it = gt; it < NSEQ * NBLK * CG; it += NGT) {
        const int cg = it % CG, q = it / CG, seq = q / NBLK, blk = q % NBLK, c0 = cg * 8;
        const int row0 = PROMPT ? seq * SEQ + blk * NT : MPR + seq * 4;
        v4u rows[NT]; float win[3][8];
#pragma unroll
        for (int i = 0; i < NT; ++i) rows[i] = *(const v4u*)(src + (size_t)(row0 + i) * NPROJ + c0);
        if (PROMPT) {
#pragma unroll
            for (int j = 0; j < 3; ++j) { v4u v = (v4u){0u, 0u, 0u, 0u}; if (blk != 0) v = *(const v4u*)(src + (size_t)(row0 - 3 + j) * NPROJ + c0);
                win[j][0] = bflo(v.x); win[j][1] = bfhi(v.x); win[j][2] = bflo(v.y); win[j][3] = bfhi(v.y); win[j][4] = bflo(v.z); win[j][5] = bfhi(v.z); win[j][6] = bflo(v.w); win[j][7] = bfhi(v.w); }
        } else {
#pragma unroll
            for (int j = 0; j < 3; ++j) { const float* sp = state_in + ((size_t)seq * 3 + j) * NCH + c0; const f32x4 a = *(const f32x4*)sp, b = *(const f32x4*)(sp + 4);
#pragma unroll
                for (int e = 0; e < 4; ++e) { win[j][e] = a[e]; win[j][4 + e] = b[e]; } }
        }
        float wv[4][8], bv[8];
#pragma unroll
        for (int j = 0; j < 4; ++j) { const f32x4 a = *(const f32x4*)(w + j * NCH + c0), b = *(const f32x4*)(w + j * NCH + c0 + 4);
#pragma unroll
            for (int e = 0; e < 4; ++e) { wv[j][e] = a[e]; wv[j][4 + e] = b[e]; } }
        { const f32x4 a = *(const f32x4*)(bias + c0), b = *(const f32x4*)(bias + c0 + 4);
#pragma unroll
          for (int e = 0; e < 4; ++e) { bv[e] = a[e]; bv[4 + e] = b[e]; } }
#pragma unroll
        for (int i = 0; i < NT; ++i) {
            const v4u v = rows[i];
            const float cur[8] = {bflo(v.x), bfhi(v.x), bflo(v.y), bfhi(v.y), bflo(v.z), bfhi(v.z), bflo(v.w), bfhi(v.w)};
            float y[8];
#pragma unroll
            for (int e = 0; e < 8; ++e) { y[e] = silu(bv[e] + wv[0][e] * win[0][e] + wv[1][e] * win[1][e] + wv[2][e] * win[2][e] + wv[3][e] * cur[e]); win[0][e] = win[1][e]; win[1][e] = win[2][e]; win[2][e] = cur[e]; }
            v4u o; o.x = pk2(y[0], y[1]); o.y = pk2(y[2], y[3]); o.z = pk2(y[4], y[5]); o.w = pk2(y[6], y[7]);
            *(v4u*)(dst + (size_t)(row0 + i) * dst_ld + c0) = o;
        }
        if (!PROMPT || blk == NBLK - 1) { float* op = out_state + (size_t)seq * 3 * NCH + c0;
#pragma unroll
            for (int j = 0; j < 3; ++j) { *(f32x4*)(op + j * NCH) = (f32x4){win[j][0], win[j][1], win[j][2], win[j][3]}; *(f32x4*)(op + j * NCH + 4) = (f32x4){win[j][4], win[j][5], win[j][6], win[j][7]}; } }
    }
}
template <int W> __device__ __forceinline__ float scan_add(float v, int lane) {
#pragma unroll
    for (int o = 1; o < W; o <<= 1) { const float t = __shfl_up(v, o, W); if ((lane & (W - 1)) >= o) v += t; }
    return v;
}
template <int W> __device__ __forceinline__ float scan_max(float v, int lane) {
#pragma unroll
    for (int o = 1; o < W; o <<= 1) { const float t = __shfl_up(v, o, W); if ((lane & (W - 1)) >= o) v = fmaxf(v, t); }
    return v;
}
__device__ __forceinline__ void gate_scans(const Args& A, int gw, int NGW, int lane) {
    const float* GT = (const float*)(A.ws + WS_GATES);
    f32x4* MG = (f32x4*)(A.ws + WS_MG); f32x2* SG = (f32x2*)(A.ws + WS_SG); f32x2* CS = (f32x2*)(A.ws + WS_CS);
    for (int it = gw; it < 512; it += NGW) {
        if (it < 128) {
            const int seq = it >> 5, c = it & 31, row = seq * SEQ + c * 64 + lane;
            const f32x4 g0 = *(const f32x4*)(GT + (size_t)row * 256), g1 = *(const f32x4*)(GT + (size_t)row * 256 + 4), g2 = *(const f32x4*)(GT + (size_t)row * 256 + 8), g3 = *(const f32x4*)(GT + (size_t)row * 256 + 12);
            const float gi[8] = {g0[0], g0[1], g0[2], g0[3], g1[0], g1[1], g1[2], g1[3]}, gf[8] = {g2[0], g2[1], g2[2], g2[3], g3[0], g3[1], g3[2], g3[3]};
#pragma unroll
            for (int h = 0; h < 8; ++h) {
                const float ig = softcap(gi[h] + A.in[I_BIG][h]), lf = -softplus(-softcap(gf[h] + A.in[I_BFG][h]));
                const float bc = scan_add<64>(lf, lane), g = ig - bc, gmax = scan_max<64>(g, lane);
                MG[(size_t)row * 8 + h] = (f32x4){bc, g, gmax, 0.f};
                if (lane == 63) CS[(seq * 8 + h) * 32 + c] = (f32x2){bc, gmax};
            }
        } else if (it < 256) {
            const int seq = it - 128, h = (lane >> 2) & 7, t = lane & 3, row = MPR + seq * 4 + t;
            const float m = A.in[I_MM][seq * 8 + h];
            const float ig = softcap(GT[(size_t)row * 256 + h] + A.in[I_BIG][h]), lf = -softplus(-softcap(GT[(size_t)row * 256 + 8 + h] + A.in[I_BFG][h]));
            const float bc = scan_add<4>(lf, lane), g = ig - bc, gmax = scan_max<4>(g, lane);
            const float mm = fmaxf(m, gmax), alpha = -mm, a = __expf(m - mm), ex = __expf(alpha - bc);
            if (lane < 32) { MG[(size_t)row * 8 + h] = (f32x4){alpha, g, a, ex}; if (t == 3) A.out[O_SM + seq * 8 + h] = bc + mm; }
        } else if (it < 384) {
            const int q = it - 256, seq = q >> 5, c = q & 31, hd = lane, rowb = seq * SEQ + c * 64;
            const float dtb = A.in[I_DTB][hd], Aneg = -__expf(A.in[I_ALOG][hd]); float ac = 0.f;
            float gv[64];
#pragma unroll
            for (int t = 0; t < 64; ++t) { const float* rp = GT + (size_t)(rowb + t) * 256 + 16; gv[t] = rp[hd]; }
#pragma unroll
            for (int t = 0; t < 64; ++t) { const float dt = softplus(gv[t] + dtb); ac += dt * Aneg; SG[(size_t)(rowb + t) * 64 + hd] = (f32x2){dt, ac}; }
        } else {
            const int seq = it - 384, hd = lane; const float dtb = A.in[I_DTB][hd], Aneg = -__expf(A.in[I_ALOG][hd]); float ac = 0.f;
#pragma unroll
            for (int t = 0; t < 4; ++t) { const int row = MPR + seq * 4 + t; const float dt = softplus(GT[(size_t)row * 256 + 16 + hd] + dtb); ac += dt * Aneg; SG[(size_t)row * 64 + hd] = (f32x2){dt, ac}; }
        }
    }
}
__device__ __forceinline__ void mlstm_m_carry(const Args& A, int lane) {
    if (lane < 32) { const f32x2* CS = (const f32x2*)(A.ws + WS_CS); f32x2* MPD = (f32x2*)(A.ws + WS_MPD); float m = -INFINITY;
        for (int c = 0; c < 32; ++c) { const f32x2 cs = CS[lane * 32 + c]; const float mm = fmaxf(m, cs[1]); MPD[lane * 32 + c] = (f32x2){m, __expf(m - mm)}; m = cs[0] + mm; }
        A.out[O_PM + lane] = m; }
}

__device__ __forceinline__ bf16x8 as_bf16x8(v4u v) { return __builtin_bit_cast(bf16x8, v); }
__device__ __forceinline__ f32x4 mfma16(bf16x8 a, bf16x8 b, f32x4 c) { return __builtin_amdgcn_mfma_f32_16x16x32_bf16(a, b, c, 0, 0, 0); }
__device__ __forceinline__ v4u pack8(f32x4 a, f32x4 b) { v4u r; r.x = pk2(a[0], a[1]); r.y = pk2(a[2], a[3]); r.z = pk2(b[0], b[1]); r.w = pk2(b[2], b[3]); return r; }
__device__ __forceinline__ float sum8bf(v4u v) { return ((bflo(v.x) + bfhi(v.x)) + (bflo(v.y) + bfhi(v.y))) + ((bflo(v.z) + bfhi(v.z)) + (bflo(v.w) + bfhi(v.w))); }

constexpr int M1_Q = 0, M1_K = 33792, M1_VT = 70656, M1_P = 107520, M1_G = 116736;
__device__ __forceinline__ void m1_unit(const Args& A, LAS unsigned char* lds, int unit, int tid, int lane, int wave) {
    const int bh = unit >> 5, c = unit & 31, b = bh >> 3, h = bh & 7, row0 = b * SEQ + c * 64;
    LAS bf16* Qs = (LAS bf16*)(lds + M1_Q); LAS bf16* Ks = (LAS bf16*)(lds + M1_K); LAS bf16* Kw = Ks; LAS bf16* Vt = (LAS bf16*)(lds + M1_VT); LAS bf16* Ps = (LAS bf16*)(lds + M1_P);
    LAS float* aS = (LAS float*)(lds + M1_G); LAS float* gS = aS + 64; LAS float* wkS = aS + 128;
    const bf16* QK = (const bf16*)(A.ws + WS_QK); const bf16* PROJ = (const bf16*)(A.ws + WS_PROJ); const f32x4* MG = (const f32x4*)(A.ws + WS_MG); const f32x2* MPD = (const f32x2*)(A.ws + WS_MPD);
    bf16* NUMI = (bf16*)(A.ws + WS_NUMI); bf16* KWT = (bf16*)(A.ws + WS_KWT) + (size_t)unit * 16384; bf16* VTG = (bf16*)(A.ws + WS_VT) + (size_t)unit * 32768;
    float* KWS = (float*)(A.ws + WS_KWS); float* DENI = (float*)(A.ws + WS_DENI);
    const int l4 = lane >> 4, l15 = lane & 15;
    v4u vr0[4], vr1[4];
#pragma unroll
    for (int i = 0; i < 4; ++i) { const int piece = tid + NTHREADS * i, r = piece >> 5, cc = piece & 31;
        const bf16* sp = QK + (size_t)(row0 + r) * DM + h * 512 + cc * 8;
        const v4u q = *(const v4u*)sp, k = *(const v4u*)(sp + 256);
        { const int rv = piece & 63, cv = piece >> 6; const bf16* vp = PROJ + (size_t)(row0 + rv) * NPROJ + 4096 + h * 512 + cv * 8;
          vr0[i] = *(const v4u*)vp; vr1[i] = *(const v4u*)(vp + 256); }
        *(LAS v4u*)(Qs + r * 264 + cc * 8) = q; *(LAS v4u*)(Ks + r * 264 + cc * 8) = k; }
    if (tid < 64) { const f32x4 mg = MG[(size_t)(row0 + tid) * 8 + h]; const float mp = MPD[unit][0]; aS[tid] = -fmaxf(mp, mg[2]); gS[tid] = mg[1]; }
#define M1_VT_WRITE(vr) do { _Pragma("unroll") for (int i = 0; i < 4; ++i) { const int piece = tid + NTHREADS * i, r = piece & 63, cc = piece >> 6; const unsigned w_[4] = {vr[i].x, vr[i].y, vr[i].z, vr[i].w}; \
        _Pragma("unroll") for (int e = 0; e < 4; ++e) { Vt[(cc * 8 + 2 * e) * 72 + r] = (bf16)(w_[e] & 0xffffu); Vt[(cc * 8 + 2 * e + 1) * 72 + r] = (bf16)(w_[e] >> 16); } } } while (0)
    M1_VT_WRITE(vr0);
    __syncthreads();
    if (tid < 64) wkS[tid] = __expf(aS[63] + gS[tid]);
    { const int mt = wave >> 1;
#pragma unroll
      for (int e = 0; e < 2; ++e) { const int nt = (wave & 1) * 2 + e;
          const f32x4 acc = mma_nt<256>(Qs + mt * 16 * 264, 264, Ks + nt * 16 * 264, 264, (f32x4){0.f, 0.f, 0.f, 0.f}, lane);
#pragma unroll
          for (int i = 0; i < 4; ++i) { const int t = mt * 16 + 4 * l4 + i, s = nt * 16 + l15;
              const float p = (s <= t) ? acc[i] * __expf(aS[t] + gS[s]) : 0.f; Ps[t * 72 + s] = (bf16)f2bf(p); } } }
    unsigned kreg[4][4];
#pragma unroll
    for (int i = 0; i < 4; ++i) { const int pair = tid + NTHREADS * i, d = pair & 255, sg = pair >> 8;
#pragma unroll
        for (int e = 0; e < 4; ++e) kreg[i][e] = (unsigned)Ks[(sg * 8 + 2 * e) * 264 + d] | ((unsigned)Ks[(sg * 8 + 2 * e + 1) * 264 + d] << 16); }
    __syncthreads();
#pragma unroll
    for (int i = 0; i < 4; ++i) { const int pair = tid + NTHREADS * i, d = pair & 255, sg = pair >> 8; v4u w;
        w.x = pk2(bflo(kreg[i][0]) * wkS[sg * 8 + 0], bfhi(kreg[i][0]) * wkS[sg * 8 + 1]); w.y = pk2(bflo(kreg[i][1]) * wkS[sg * 8 + 2], bfhi(kreg[i][1]) * wkS[sg * 8 + 3]);
        w.z = pk2(bflo(kreg[i][2]) * wkS[sg * 8 + 4], bfhi(kreg[i][2]) * wkS[sg * 8 + 5]); w.w = pk2(bflo(kreg[i][3]) * wkS[sg * 8 + 6], bfhi(kreg[i][3]) * wkS[sg * 8 + 7]);
        *(LAS v4u*)(Kw + d * 72 + sg * 8) = w; }
    { const int t = tid >> 3, sg = tid & 7; float ps = sum8bf(*(const LAS v4u*)(Ps + t * 72 + sg * 8));
      ps += __shfl_xor(ps, 1); ps += __shfl_xor(ps, 2); ps += __shfl_xor(ps, 4);
      if (sg == 0) DENI[(size_t)(row0 + t) * 8 + h] = ps; }
    __syncthreads();
#define M1_NUMI(hf) do { const int tt = wave & 3, vbase = (wave >> 2) * 8; \
        _Pragma("unroll") for (int i = 0; i < 8; ++i) { const int vtile = vbase + i; \
            const f32x4 acc = mma_nt<64>(Vt + vtile * 16 * 72, 72, Ps + tt * 16 * 72, 72, (f32x4){0.f, 0.f, 0.f, 0.f}, lane); \
            v2u w_; w_.x = pk2(acc[0], acc[1]); w_.y = pk2(acc[2], acc[3]); \
            *(v2u*)(NUMI + (size_t)(row0 + tt * 16 + l15) * DM + h * 512 + (hf) * 256 + vtile * 16 + 4 * l4) = w_; } } while (0)
#define M1_VT_EXPORT(hf) do { _Pragma("unroll") for (int i = 0; i < 4; ++i) { const int pair = tid + NTHREADS * i, v = pair >> 3, sg = pair & 7; \
            *(v4u*)(VTG + (size_t)((hf) * 256 + v) * 64 + sg * 8) = *(const LAS v4u*)(Vt + v * 72 + sg * 8); } } while (0)
    M1_NUMI(0);
#pragma unroll
    for (int i = 0; i < 4; ++i) { const int pair = tid + NTHREADS * i, d = pair >> 3, sg = pair & 7; *(v4u*)(KWT + (size_t)d * 64 + sg * 8) = *(const LAS v4u*)(Kw + d * 72 + sg * 8); }
    if (tid < 256) { float s = 0.f;
#pragma unroll
        for (int i = 0; i < 8; ++i) s += sum8bf(*(const LAS v4u*)(Kw + tid * 72 + i * 8));
        KWS[(size_t)unit * 256 + tid] = s; }
    M1_VT_EXPORT(0);
    __syncthreads();
    M1_VT_WRITE(vr1);
    __syncthreads();
    M1_NUMI(1);
    M1_VT_EXPORT(1);
    __syncthreads();
#undef M1_VT_WRITE
#undef M1_NUMI
#undef M1_VT_EXPORT
}

constexpr int S1_C = 0, S1_B = 17408, S1_CB = 0, S1_BT = 34816, S1_XT = 53248, S1_DT = 126976, S1_AC = 129024;
__device__ __forceinline__ void s1_unit(const Args& A, LAS unsigned char* lds, int unit, int tid, int lane, int wave) {
    const int bg = unit >> 5, c = unit & 31, b = bg >> 3, g = bg & 7, row0 = b * SEQ + c * 64;
    LAS bf16* Cs = (LAS bf16*)(lds + S1_C); LAS bf16* Bs = (LAS bf16*)(lds + S1_B); LAS float* CBs = (LAS float*)(lds + S1_CB); LAS bf16* Bt = (LAS bf16*)(lds + S1_BT); LAS bf16* Xt = (LAS bf16*)(lds + S1_XT);
    LAS float* dtS = (LAS float*)(lds + S1_DT); LAS float* acS = (LAS float*)(lds + S1_AC);
    const bf16* XBC = (const bf16*)(A.ws + WS_XBC); const f32x2* SG = (const f32x2*)(A.ws + WS_SG);
    bf16* YI = (bf16*)(A.ws + WS_YI); bf16* BMT = (bf16*)(A.ws + WS_BMT) + (size_t)unit * 8192; bf16* XWT = (bf16*)(A.ws + WS_XWT);
    const int l4 = lane >> 4, l15 = lane & 15;
#pragma unroll
    for (int i = 0; i < 2; ++i) { const int piece = tid + NTHREADS * i, r = piece & 63, cc = piece >> 6;
        const bf16* sp = XBC + (size_t)(row0 + r) * 6144 + 4096 + g * 128 + cc * 8;
        const v4u bm = *(const v4u*)sp, cm = *(const v4u*)(sp + 1024);
        *(LAS v4u*)(Cs + r * 136 + cc * 8) = cm; *(LAS v4u*)(Bs + r * 136 + cc * 8) = bm;
        const unsigned w[4] = {bm.x, bm.y, bm.z, bm.w};
#pragma unroll
        for (int e = 0; e < 4; ++e) { Bt[(cc * 8 + 2 * e) * 72 + r] = (bf16)(w[e] & 0xffffu); Bt[(cc * 8 + 2 * e + 1) * 72 + r] = (bf16)(w[e] >> 16); } }
#pragma unroll
    for (int i = 0; i < 8; ++i) { const int piece = tid + NTHREADS * i, r = piece & 63, cc = piece >> 6;
        const v4u xv = *(const v4u*)(XBC + (size_t)(row0 + r) * 6144 + g * 512 + cc * 8); const unsigned w[4] = {xv.x, xv.y, xv.z, xv.w};
#pragma unroll
        for (int e = 0; e < 4; ++e) { Xt[(cc * 8 + 2 * e) * 72 + r] = (bf16)(w[e] & 0xffffu); Xt[(cc * 8 + 2 * e + 1) * 72 + r] = (bf16)(w[e] >> 16); } }
    { const int hh = tid >> 6, t = tid & 63; const f32x2 sg = SG[(size_t)(row0 + t) * 64 + g * 8 + hh]; dtS[hh * 64 + t] = sg[0]; acS[hh * 64 + t] = sg[1]; }
    __syncthreads();
    f32x4 cb[2];
    { const int mt = wave >> 1;
#pragma unroll
      for (int e = 0; e < 2; ++e) { const int nt = (wave & 1) * 2 + e; cb[e] = mma_nt<128>(Cs + mt * 16 * 136, 136, Bs + nt * 16 * 136, 136, (f32x4){0.f, 0.f, 0.f, 0.f}, lane); } }
    __syncthreads();
    { const int mt = wave >> 1;
#pragma unroll
      for (int e = 0; e < 2; ++e) { const int nt = (wave & 1) * 2 + e;
#pragma unroll
          for (int i = 0; i < 4; ++i) CBs[(mt * 16 + 4 * l4 + i) * 68 + nt * 16 + l15] = cb[e][i]; } }
#pragma unroll
    for (int i = 0; i < 2; ++i) { const int pair = tid + NTHREADS * i, n = pair >> 3, sg = pair & 7; *(v4u*)(BMT + (size_t)n * 64 + sg * 8) = *(const LAS v4u*)(Bt + n * 72 + sg * 8); }
    __syncthreads();
    { const int hh = wave, head = g * 8 + hh; const float a_end = acS[hh * 64 + 63];
      bf16* xw = XWT + (size_t)((b * 64 + head) * 32 + c) * 4096;
#pragma unroll
      for (int i = 0; i < 8; ++i) { const int piece = lane + 64 * i, p = piece >> 3, sg = piece & 7; const v4u xv = *(const LAS v4u*)(Xt + (hh * 64 + p) * 72 + sg * 8);
          float wg[8];
#pragma unroll
          for (int e = 0; e < 8; ++e) wg[e] = dtS[hh * 64 + sg * 8 + e] * __expf(a_end - acS[hh * 64 + sg * 8 + e]);
          v4u o; o.x = pk2(bflo(xv.x) * wg[0], bfhi(xv.x) * wg[1]); o.y = pk2(bflo(xv.y) * wg[2], bfhi(xv.y) * wg[3]); o.z = pk2(bflo(xv.z) * wg[4], bfhi(xv.z) * wg[5]); o.w = pk2(bflo(xv.w) * wg[6], bfhi(xv.w) * wg[7]);
          *(v4u*)(xw + (size_t)p * 64 + sg * 8) = o; }
#pragma unroll
      for (int tt = 0; tt < 4; ++tt) { const int t = tt * 16 + l15; const float act = acS[hh * 64 + t];
          bf16x8 Y[2];
#pragma unroll
          for (int ks = 0; ks < 2; ++ks) { const int s0 = 32 * ks + 8 * l4; const f32x4 c0 = *(const LAS f32x4*)(CBs + t * 68 + s0), c1 = *(const LAS f32x4*)(CBs + t * 68 + s0 + 4); float gv[8];
#pragma unroll
              for (int e = 0; e < 8; ++e) { const int s = s0 + e; const float cbv = e < 4 ? c0[e & 3] : c1[e & 3]; gv[e] = (s <= t) ? cbv * __expf(act - acS[hh * 64 + s]) * dtS[hh * 64 + s] : 0.f; }
              v4u yv; yv.x = pk2(gv[0], gv[1]); yv.y = pk2(gv[2], gv[3]); yv.z = pk2(gv[4], gv[5]); yv.w = pk2(gv[6], gv[7]); Y[ks] = as_bf16x8(yv); }
#pragma unroll
          for (int pt = 0; pt < 4; ++pt) { f32x4 acc = (f32x4){0.f, 0.f, 0.f, 0.f};
#pragma unroll
              for (int ks = 0; ks < 2; ++ks) acc = mfma16(*(const LAS bf16x8*)(Xt + (hh * 64 + pt * 16 + l15) * 72 + 32 * ks + 8 * l4), Y[ks], acc);
              v2u w; w.x = pk2(acc[0], acc[1]); w.y = pk2(acc[2], acc[3]);
              *(v2u*)(YI + (size_t)(row0 + t) * DM + head * 64 + pt * 16 + 4 * l4) = w; } } }
    __syncthreads();
}

__device__ __forceinline__ void nscan_item(const Args& A, int bh, int tid) {
    if (tid < 256) { const float* KWS = (const float*)(A.ws + WS_KWS); const f32x2* MPD = (const f32x2*)(A.ws + WS_MPD); float* NALL = (float*)(A.ws + WS_NALL);
        float kw[32], dc[32];
#pragma unroll
        for (int c = 0; c < 32; ++c) { kw[c] = KWS[(size_t)(bh * 32 + c) * 256 + tid]; dc[c] = MPD[bh * 32 + c][1]; }
        float n = 0.f;
#pragma unroll
        for (int c = 0; c < 32; ++c) { NALL[(size_t)(bh * 32 + c) * 256 + tid] = n; n = dc[c] * n + kw[c]; }
        A.out[O_PN + bh * 256 + tid] = n; }
}

constexpr int M2_Q = 0, M2_KW = 33792, M2_VT = 70656;
__device__ __forceinline__ void m2_item(const Args& A, LAS unsigned char* lds, int item, int tid, int lane, int wave) {
    const int bh = item >> 2, j = item & 3, b = bh >> 3, h = bh & 7;
    LAS bf16* Qs = (LAS bf16*)(lds + M2_Q); LAS bf16* Kw = (LAS bf16*)(lds + M2_KW); LAS bf16* Vt = (LAS bf16*)(lds + M2_VT);
    const bf16* QK = (const bf16*)(A.ws + WS_QK); const bf16* KWT = (const bf16*)(A.ws + WS_KWT); const bf16* VTG = (const bf16*)(A.ws + WS_VT); const f32x2* MPD = (const f32x2*)(A.ws + WS_MPD);
    bf16* INTER = (bf16*)(A.ws + WS_INTER);
    const int l4 = lane >> 4, l15 = lane & 15;
    f32x4 acc[16];
#pragma unroll
    for (int i = 0; i < 16; ++i) acc[i] = (f32x4){0.f, 0.f, 0.f, 0.f};
    v4u rq[4], rk[4], rv[2]; float dnext;
#define M2_LOAD(cc_) do { const int r0_ = b * SEQ + (cc_) * 64; const size_t un_ = (size_t)(bh * 32 + (cc_)); \
        _Pragma("unroll") for (int i = 0; i < 4; ++i) { const int piece = tid + NTHREADS * i; rq[i] = *(const v4u*)(QK + (size_t)(r0_ + (piece >> 5)) * DM + h * 512 + (piece & 31) * 8); rk[i] = *(const v4u*)(KWT + un_ * 16384 + (size_t)piece * 8); } \
        _Pragma("unroll") for (int i = 0; i < 2; ++i) { const int piece = tid + NTHREADS * i; rv[i] = *(const v4u*)(VTG + un_ * 32768 + (size_t)(j * 128) * 64 + (size_t)piece * 8); } \
        dnext = MPD[un_][1]; } while (0)
    M2_LOAD(0);
    for (int c = 0; c < 32; ++c) {
        const int row0 = b * SEQ + c * 64;
#pragma unroll
        for (int i = 0; i < 4; ++i) { const int piece = tid + NTHREADS * i; *(LAS v4u*)(Qs + (piece >> 5) * 264 + (piece & 31) * 8) = rq[i]; *(LAS v4u*)(Kw + (piece >> 3) * 72 + (piece & 7) * 8) = rk[i]; }
#pragma unroll
        for (int i = 0; i < 2; ++i) { const int piece = tid + NTHREADS * i; *(LAS v4u*)(Vt + (piece >> 3) * 72 + (piece & 7) * 8) = rv[i]; }
        const float decay = dnext;
        if (c < 31) M2_LOAD(c + 1);
        __syncthreads();
        f32x4 ia[4];
#pragma unroll
        for (int tt = 0; tt < 4; ++tt) ia[tt] = (f32x4){0.f, 0.f, 0.f, 0.f};
#pragma unroll
        for (int ks = 0; ks < 8; ++ks) { const bf16x8 X = as_bf16x8(pack8(acc[2 * ks], acc[2 * ks + 1]));
#pragma unroll
            for (int tt = 0; tt < 4; ++tt) { const LAS bf16* qp = Qs + (tt * 16 + l15) * 264 + 32 * ks + 4 * l4; const v2u y0 = *(const LAS v2u*)qp, y1 = *(const LAS v2u*)(qp + 16);
                ia[tt] = mfma16(X, as_bf16x8((v4u){y0.x, y0.y, y1.x, y1.y}), ia[tt]); } }
#pragma unroll
        for (int tt = 0; tt < 4; ++tt) { v2u w; w.x = pk2(ia[tt][0], ia[tt][1]); w.y = pk2(ia[tt][2], ia[tt][3]);
            *(v2u*)(INTER + (size_t)(row0 + tt * 16 + l15) * DM + h * 512 + j * 128 + wave * 16 + 4 * l4) = w; }
        bf16x8 yv[2];
#pragma unroll
        for (int ks = 0; ks < 2; ++ks) yv[ks] = *(const LAS bf16x8*)(Vt + (wave * 16 + l15) * 72 + ks * 32 + l4 * 8);
#pragma unroll
        for (int dt = 0; dt < 16; ++dt) { acc[dt] = acc[dt] * decay;
#pragma unroll
            for (int ks = 0; ks < 2; ++ks) acc[dt] = mfma16(*(const LAS bf16x8*)(Kw + (dt * 16 + l15) * 72 + ks * 32 + l4 * 8), yv[ks], acc[dt]); }
        __syncthreads();
    }
#undef M2_LOAD
    float* pC = A.out + O_PC + (size_t)(bh * 256) * 512 + j * 128 + wave * 16 + l15;
#pragma unroll
    for (int dt = 0; dt < 16; ++dt)
#pragma unroll
        for (int i = 0; i < 4; ++i) pC[(size_t)(dt * 16 + 4 * l4 + i) * 512] = acc[dt][i];
}

constexpr int S2_C = 0, S2_BT = 17408, S2_XW = 35840;
__device__ __forceinline__ void s2_item(const Args& A, LAS unsigned char* lds, int item, int tid, int lane, int wave) {
    const int b = item >> 5, pair = item & 31, hsel = wave >> 2, head = pair * 2 + hsel, g = pair >> 2, pt = wave & 3;
    LAS bf16* Cs = (LAS bf16*)(lds + S2_C); LAS bf16* Bt = (LAS bf16*)(lds + S2_BT); LAS bf16* Xw = (LAS bf16*)(lds + S2_XW);
    const bf16* XBC = (const bf16*)(A.ws + WS_XBC); const bf16* BMT = (const bf16*)(A.ws + WS_BMT); const bf16* XWT = (const bf16*)(A.ws + WS_XWT); const f32x2* SG = (const f32x2*)(A.ws + WS_SG);
    bf16* YS = (bf16*)(A.ws + WS_YS);
    const int l4 = lane >> 4, l15 = lane & 15;
    f32x4 acc[8];
#pragma unroll
    for (int i = 0; i < 8; ++i) acc[i] = (f32x4){0.f, 0.f, 0.f, 0.f};
    v4u rc[2], rb[2], rx[2]; float enext;
#define S2_LOAD(cc_) do { const int r0_ = b * SEQ + (cc_) * 64; \
        _Pragma("unroll") for (int i = 0; i < 2; ++i) { const int piece = tid + NTHREADS * i; rc[i] = *(const v4u*)(XBC + (size_t)(r0_ + (piece >> 4)) * 6144 + 5120 + g * 128 + (piece & 15) * 8); \
            rb[i] = *(const v4u*)(BMT + (size_t)((b * 8 + g) * 32 + (cc_)) * 8192 + (size_t)piece * 8); \
            rx[i] = *(const v4u*)(XWT + (size_t)((b * 64 + pair * 2 + (piece >> 9)) * 32 + (cc_)) * 4096 + (size_t)(piece & 511) * 8); } \
        enext = __expf(SG[(size_t)(r0_ + 63) * 64 + head][1]); } while (0)
    S2_LOAD(0);
    for (int c = 0; c < 32; ++c) {
        const int row0 = b * SEQ + c * 64;
#pragma unroll
        for (int i = 0; i < 2; ++i) { const int piece = tid + NTHREADS * i; *(LAS v4u*)(Cs + (piece >> 4) * 136 + (piece & 15) * 8) = rc[i]; *(LAS v4u*)(Bt + (piece >> 3) * 72 + (piece & 7) * 8) = rb[i]; *(LAS v4u*)(Xw + (piece >> 3) * 72 + (piece & 7) * 8) = rx[i]; }
        const float ea = enext;
        if (c < 31) S2_LOAD(c + 1);
        __syncthreads();
        f32x4 ia[4];
#pragma unroll
        for (int tt = 0; tt < 4; ++tt) ia[tt] = (f32x4){0.f, 0.f, 0.f, 0.f};
#pragma unroll
        for (int ks = 0; ks < 4; ++ks) { const bf16x8 X = as_bf16x8(pack8(acc[2 * ks], acc[2 * ks + 1]));
#pragma unroll
            for (int tt = 0; tt < 4; ++tt) { const LAS bf16* cp = Cs + (tt * 16 + l15) * 136 + 32 * ks + 4 * l4; const v2u y0 = *(const LAS v2u*)cp, y1 = *(const LAS v2u*)(cp + 16);
                ia[tt] = mfma16(X, as_bf16x8((v4u){y0.x, y0.y, y1.x, y1.y}), ia[tt]); } }
#pragma unroll
        for (int tt = 0; tt < 4; ++tt) { v2u w; w.x = pk2(ia[tt][0], ia[tt][1]); w.y = pk2(ia[tt][2], ia[tt][3]);
            *(v2u*)(YS + (size_t)(row0 + tt * 16 + l15) * DM + head * 64 + pt * 16 + 4 * l4) = w; }
        bf16x8 yv[2];
#pragma unroll
        for (int ks = 0; ks < 2; ++ks) yv[ks] = *(const LAS bf16x8*)(Xw + (hsel * 64 + pt * 16 + l15) * 72 + ks * 32 + l4 * 8);
#pragma unroll
        for (int nt = 0; nt < 8; ++nt) { acc[nt] = acc[nt] * ea;
#pragma unroll
            for (int ks = 0; ks < 2; ++ks) acc[nt] = mfma16(*(const LAS bf16x8*)(Bt + (nt * 16 + l15) * 72 + ks * 32 + l4 * 8), yv[ks], acc[nt]); }
        __syncthreads();
    }
#undef S2_LOAD
    float* pH = A.out + O_PSSM + (size_t)((b * 64 + head) * 64 + pt * 16 + l15) * 128 + 4 * l4;
#pragma unroll
    for (int nt = 0; nt < 8; ++nt) *(f32x4*)(pH + nt * 16) = acc[nt];
}

__device__ __forceinline__ void m3_pass(const Args& A, int gw, int NGW, int lane) {
    const bf16* NUMI = (const bf16*)(A.ws + WS_NUMI); const bf16* INTER = (const bf16*)(A.ws + WS_INTER); const bf16* PROJ = (const bf16*)(A.ws + WS_PROJ); const bf16* QK = (const bf16*)(A.ws + WS_QK);
    const f32x4* MG = (const f32x4*)(A.ws + WS_MG); const f32x2* MPD = (const f32x2*)(A.ws + WS_MPD); const float* NALL = (const float*)(A.ws + WS_NALL); const float* DENI = (const float*)(A.ws + WS_DENI);
    bf16* MIX = (bf16*)(A.ws + WS_MIX); const float* mnorm = A.in[I_MNORM];
    for (int it = gw; it < MPR * 8; it += NGW) {
        const int row = it >> 3, h = it & 7, b = row >> 11, c = (row >> 6) & 31, unit = (b * 8 + h) * 32 + c, col = h * 512 + lane * 8;
        const v4u ni = *(const v4u*)(NUMI + (size_t)row * DM + col), iw = *(const v4u*)(INTER + (size_t)row * DM + col);
        const v4u ow = *(const v4u*)(PROJ + (size_t)row * NPROJ + 8192 + col), zw = *(const v4u*)(PROJ + (size_t)row * NPROJ + 12288 + col);
        const v2u qw = *(const v2u*)(QK + (size_t)row * DM + h * 512 + lane * 4); const f32x4 n4 = *(const f32x4*)(NALL + (size_t)unit * 256 + lane * 4);
        const f32x4 mg = MG[(size_t)row * 8 + h]; const float mp = MPD[unit][0]; const float deni = DENI[(size_t)row * 8 + h];
        const f32x4 mn0 = *(const f32x4*)(mnorm + col), mn1 = *(const f32x4*)(mnorm + col + 4);
        const float mm = fmaxf(mp, mg[2]), a = __expf(mp - mm), ex = __expf(-mm - mg[0]);
        const float qn = wave_sum((bflo(qw.x) * n4[0] + bfhi(qw.x) * n4[1]) + (bflo(qw.y) * n4[2] + bfhi(qw.y) * n4[3]));
        const float dn = fmaxf(fabsf(deni + a * qn), ex), rdn = 1.f / dn;
        const float nv[8] = {bflo(ni.x), bfhi(ni.x), bflo(ni.y), bfhi(ni.y), bflo(ni.z), bfhi(ni.z), bflo(ni.w), bfhi(ni.w)};
        const float iv[8] = {bflo(iw.x), bfhi(iw.x), bflo(iw.y), bfhi(iw.y), bflo(iw.z), bfhi(iw.z), bflo(iw.w), bfhi(iw.w)};
        const float ov[8] = {bflo(ow.x), bfhi(ow.x), bflo(ow.y), bfhi(ow.y), bflo(ow.z), bfhi(ow.z), bflo(ow.w), bfhi(ow.w)};
        const float zv[8] = {bflo(zw.x), bfhi(zw.x), bflo(zw.y), bfhi(zw.y), bflo(zw.z), bfhi(zw.z), bflo(zw.w), bfhi(zw.w)};
        const float mn[8] = {mn0[0], mn0[1], mn0[2], mn0[3], mn1[0], mn1[1], mn1[2], mn1[3]};
        float pre[8], ss = 0.f;
#pragma unroll
        for (int e = 0; e < 8; ++e) { pre[e] = (nv[e] + a * iv[e]) * rdn * sigm(ov[e]); ss += pre[e] * pre[e]; }
        const float rstd = rsqrtf(wave_sum(ss) * (1.f / 512.f) + EPS);
        float val[8];
#pragma unroll
        for (int e = 0; e < 8; ++e) val[e] = pre[e] * rstd * mn[e] * silu(zv[e]);
        v4u o; o.x = pk2(val[0], val[1]); o.y = pk2(val[2], val[3]); o.z = pk2(val[4], val[5]); o.w = pk2(val[6], val[7]);
        *(v4u*)(MIX + (size_t)row * LDM + col) = o;
    }
}
__device__ __forceinline__ void s3_pass(const Args& A, int gw, int NGW, int lane) {
    const bf16* YI = (const bf16*)(A.ws + WS_YI); const bf16* YS = (const bf16*)(A.ws + WS_YS); const bf16* PROJ = (const bf16*)(A.ws + WS_PROJ); const bf16* XBC = (const bf16*)(A.ws + WS_XBC);
    const f32x2* SG = (const f32x2*)(A.ws + WS_SG); bf16* MIX = (bf16*)(A.ws + WS_MIX); const float* snorm = A.in[I_SNORM];
    for (int it = gw; it < MPR * 8; it += NGW) {
        const int row = it >> 3, g = it & 7, col = g * 512 + lane * 8, head = g * 8 + (lane >> 3);
        const v4u yi = *(const v4u*)(YI + (size_t)row * DM + col), ys = *(const v4u*)(YS + (size_t)row * DM + col);
        const v4u xw = *(const v4u*)(XBC + (size_t)row * 6144 + col), zw = *(const v4u*)(PROJ + (size_t)row * NPROJ + 16384 + col);
        const f32x2 sg = SG[(size_t)row * 64 + head]; const float eac = __expf(sg[1]), dsk = A.in[I_DSKIP][head];
        const f32x4 sn0 = *(const f32x4*)(snorm + col), sn1 = *(const f32x4*)(snorm + col + 4);
        const float a1[8] = {bflo(yi.x), bfhi(yi.x), bflo(yi.y), bfhi(yi.y), bflo(yi.z), bfhi(yi.z), bflo(yi.w), bfhi(yi.w)};
        const float a2[8] = {bflo(ys.x), bfhi(ys.x), bflo(ys.y), bfhi(ys.y), bflo(ys.z), bfhi(ys.z), bflo(ys.w), bfhi(ys.w)};
        const float xv[8] = {bflo(xw.x), bfhi(xw.x), bflo(xw.y), bfhi(xw.y), bflo(xw.z), bfhi(xw.z), bflo(xw.w), bfhi(xw.w)};
        const float zv[8] = {bflo(zw.x), bfhi(zw.x), bflo(zw.y), bfhi(zw.y), bflo(zw.z), bfhi(zw.z), bflo(zw.w), bfhi(zw.w)};
        const float sn[8] = {sn0[0], sn0[1], sn0[2], sn0[3], sn1[0], sn1[1], sn1[2], sn1[3]};
        float pre[8], ss = 0.f;
#pragma unroll
        for (int e = 0; e < 8; ++e) { pre[e] = (a1[e] + eac * a2[e] + dsk * xv[e]) * silu(zv[e]); ss += pre[e] * pre[e]; }
        const float rstd = rsqrtf(wave_sum(ss) * (1.f / 512.f) + EPS);
        v4u o; o.x = pk2(pre[0] * rstd * sn[0], pre[1] * rstd * sn[1]); o.y = pk2(pre[2] * rstd * sn[2], pre[3] * rstd * sn[3]); o.z = pk2(pre[4] * rstd * sn[4], pre[5] * rstd * sn[5]); o.w = pk2(pre[6] * rstd * sn[6], pre[7] * rstd * sn[7]);
        *(v4u*)(MIX + (size_t)row * LDM + 4096 + col) = o;
    }
}


__device__ __forceinline__ void mlstm_sample_item(const Args& A, LAS unsigned char* lds, int item, int tid, int lane, int wave) {
    const int seq = item >> 3, h = item & 7;
    LAS float* qT = (LAS float*)lds; LAS float* kT = qT + 1024; LAS float* kwT = qT + 2048; LAS float* vS = qT + 3072; LAS float* n0S = qT + 5120; LAS float* gt = qT + 5376;
    LAS float* SSd = qT + 5408; LAS float* PSd = qT + 5440; LAS float* denS = qT + 5472; LAS float* wkS = qT + 5480; LAS float* ssS = qT + 5488; LAS float* accl = qT + 6144;
    const bf16* QK = (const bf16*)(A.ws + WS_QK); const bf16* PROJ = (const bf16*)(A.ws + WS_PROJ); const float* MG = (const float*)(A.ws + WS_MG);
    bf16* MIX = (bf16*)(A.ws + WS_MIX); const float* mnorm = A.in[I_MNORM];
    const int rowb = MPR + seq * 4;
    { const int idx = tid * 2, t = idx >> 8, d = idx & 255; const bf16* sp = QK + (size_t)(rowb + t) * DM + h * 512 + d;
      const unsigned qw = *(const unsigned*)sp, kw = *(const unsigned*)(sp + 256);
      qT[d * 4 + t] = bflo(qw); qT[(d + 1) * 4 + t] = bfhi(qw); kT[d * 4 + t] = bflo(kw); kT[(d + 1) * 4 + t] = bfhi(kw); }
    { const int idx = tid * 4, t = idx >> 9, v = idx & 511; const v2u vw = *(const v2u*)(PROJ + (size_t)(rowb + t) * NPROJ + 4096 + h * 512 + v);
      *(LAS f32x4*)(vS + t * 512 + v) = (f32x4){bflo(vw.x), bfhi(vw.x), bflo(vw.y), bfhi(vw.y)}; }
    if (tid < 256) n0S[tid] = A.in[I_MN][(size_t)(seq * 8 + h) * 256 + tid];
    if (tid < 16) { const int comp = tid >> 2, t = tid & 3; gt[comp * 4 + t] = MG[((size_t)(rowb + t) * 8 + h) * 4 + comp]; }
    __syncthreads();
    for (int pp = wave; pp < 20; pp += NWAVES) { float part = 0.f;
        if (pp < 16) { const int t = pp >> 2, s = pp & 3;
#pragma unroll
            for (int i = 0; i < 4; ++i) part += qT[(lane + 64 * i) * 4 + t] * kT[(lane + 64 * i) * 4 + s]; }
        else { const int t = pp - 16;
#pragma unroll
            for (int i = 0; i < 4; ++i) part += qT[(lane + 64 * i) * 4 + t] * n0S[lane + 64 * i]; }
        part = wave_sum(part); if (lane == 0) SSd[pp] = part; }
    __syncthreads();
    if (tid < 16) { const int t = tid >> 2, s = tid & 3; PSd[tid] = (s <= t) ? SSd[tid] * __expf(gt[t] + gt[4 + s]) : 0.f; }
    if (tid >= 64 && tid < 68) { const int s = tid - 64; wkS[s] = __expf(gt[3] + gt[4 + s]); }
    __syncthreads();
    if (tid < 4) denS[tid] = (PSd[tid * 4] + PSd[tid * 4 + 1]) + (PSd[tid * 4 + 2] + PSd[tid * 4 + 3]) + gt[8 + tid] * SSd[16 + tid];
    { const int i0 = tid * 2; kwT[i0] = kT[i0] * wkS[i0 & 3]; kwT[i0 + 1] = kT[i0 + 1] * wkS[(i0 + 1) & 3]; }
    __syncthreads();
    const float decay = gt[8 + 3];
    const int dr = wave >> 1, v4 = (tid & 127) * 4;
    f32x4 vv[4], acc[4];
#pragma unroll
    for (int s = 0; s < 4; ++s) { vv[s] = *(const LAS f32x4*)(vS + s * 512 + v4); acc[s] = (f32x4){0.f, 0.f, 0.f, 0.f}; }
    const float* C0 = A.in[I_MC] + (size_t)((seq * 8 + h) * 256 + dr) * 512; float* C1 = A.out + O_SC + (size_t)((seq * 8 + h) * 256 + dr) * 512;
    f32x4 cbuf[2][8];
#pragma unroll
    for (int r = 0; r < 8; ++r) { const float* rp = C0 + (size_t)(4 * r) * 512; cbuf[0][r] = __builtin_nontemporal_load((const f32x4*)(rp + v4)); }
#pragma unroll
    for (int bt = 0; bt < 8; ++bt) {
        if (bt < 7) {
#pragma unroll
            for (int r = 0; r < 8; ++r) { const float* rp = C0 + (size_t)(4 * ((bt + 1) * 8 + r)) * 512; cbuf[(bt + 1) & 1][r] = __builtin_nontemporal_load((const f32x4*)(rp + v4)); } }
#pragma unroll
        for (int r = 0; r < 8; ++r) { const int d = dr + 4 * (bt * 8 + r); const f32x4 c0 = cbuf[bt & 1][r];
            const f32x4 q4 = *(const LAS f32x4*)(qT + d * 4), kw4 = *(const LAS f32x4*)(kwT + d * 4);
#pragma unroll
            for (int t = 0; t < 4; ++t) acc[t] += q4[t] * c0;
            const f32x4 cn = decay * c0 + kw4[0] * vv[0] + kw4[1] * vv[1] + kw4[2] * vv[2] + kw4[3] * vv[3];
            { float* wp = C1 + (size_t)(4 * (bt * 8 + r)) * 512; __builtin_nontemporal_store(cn, (f32x4*)(wp + v4)); } } }
#pragma unroll
    for (int t = 0; t < 4; ++t) *(LAS f32x4*)(accl + (dr * 4 + t) * 512 + v4) = acc[t];
    __syncthreads();
    float val[4];
    { const int t = dr; f32x4 a = (f32x4){0.f, 0.f, 0.f, 0.f};
#pragma unroll
      for (int r = 0; r < 4; ++r) a += *(const LAS f32x4*)(accl + (r * 4 + t) * 512 + v4);
      f32x4 num = gt[8 + t] * a;
#pragma unroll
      for (int s = 0; s < 4; ++s) num += PSd[t * 4 + s] * vv[s];
      const float dn = fmaxf(fabsf(denS[t]), gt[12 + t]); const int row = rowb + t, col = h * 512 + v4;
      const v2u ow = *(const v2u*)(PROJ + (size_t)row * NPROJ + 8192 + col), zw = *(const v2u*)(PROJ + (size_t)row * NPROJ + 12288 + col);
      const f32x4 o4 = (f32x4){bflo(ow.x), bfhi(ow.x), bflo(ow.y), bfhi(ow.y)}, z4 = (f32x4){bflo(zw.x), bfhi(zw.x), bflo(zw.y), bfhi(zw.y)}; const f32x4 mn = *(const f32x4*)(mnorm + col);
      f32x4 pre; float ss = 0.f;
#pragma unroll
      for (int e = 0; e < 4; ++e) { pre[e] = (num[e] / dn) * sigm(o4[e]); ss += pre[e] * pre[e]; val[e] = pre[e] * mn[e] * silu(z4[e]); }
      ss = wave_sum(ss); if (lane == 0) ssS[wave] = ss; }
    __syncthreads();
    { const float rstd = rsqrtf((ssS[2 * dr] + ssS[2 * dr + 1]) * (1.f / 512.f) + EPS);
      v2u w; w.x = pk2(val[0] * rstd, val[1] * rstd); w.y = pk2(val[2] * rstd, val[3] * rstd); *(v2u*)(MIX + (size_t)(rowb + dr) * LDM + h * 512 + v4) = w; }
    if (tid < 256) { const f32x4 kw = *(const LAS f32x4*)(kwT + tid * 4); A.out[O_SN + (size_t)(seq * 8 + h) * 256 + tid] = decay * n0S[tid] + ((kw[0] + kw[1]) + (kw[2] + kw[3])); }
    __syncthreads();
}

__device__ __forceinline__ void ssd_sample_item(const Args& A, LAS unsigned char* lds, int item, int tid, int lane, int wave) {
    const int seq = item >> 3, gi = item & 7, hd = gi * 8 + wave;
    LAS float* Cf = (LAS float*)lds; LAS float* Bf = Cf + 512; LAS float* xf = Cf + 1024; LAS float* dtS = Cf + 3072; LAS float* acS = Cf + 3104; LAS float* CBs = Cf + 3136;
    LAS float* xw = Cf + 3200; LAS float* yp = Cf + 5248; LAS float* ssS = Cf + 7296;
    const bf16* XBC = (const bf16*)(A.ws + WS_XBC); const bf16* PROJ = (const bf16*)(A.ws + WS_PROJ); const f32x2* SG = (const f32x2*)(A.ws + WS_SG);
    bf16* MIX = (bf16*)(A.ws + WS_MIX); const float* snorm = A.in[I_SNORM];
    const int rowb = MPR + seq * 4;
    { const int t = tid >> 7, n = tid & 127; const bf16* sp = XBC + (size_t)(rowb + t) * 6144 + 4096 + gi * 128 + n; Bf[t * 128 + n] = bf2f(sp[0]); Cf[t * 128 + n] = bf2f(sp[1024]); }
    { const int idx = tid * 4, t = idx >> 9, cidx = idx & 511; const v2u xv = *(const v2u*)(XBC + (size_t)(rowb + t) * 6144 + gi * 512 + cidx);
      *(LAS f32x4*)(xf + t * 512 + cidx) = (f32x4){bflo(xv.x), bfhi(xv.x), bflo(xv.y), bfhi(xv.y)}; }
    if (tid < 32) { const int hh = tid >> 2, t = tid & 3; const f32x2 sg = SG[(size_t)(rowb + t) * 64 + gi * 8 + hh]; dtS[hh * 4 + t] = sg[0]; acS[hh * 4 + t] = sg[1]; }
    __syncthreads();
#pragma unroll
    for (int e = 0; e < 2; ++e) { const int pp = wave * 2 + e, t = pp >> 2, s = pp & 3;
        float part = Cf[t * 128 + lane] * Bf[s * 128 + lane] + Cf[t * 128 + 64 + lane] * Bf[s * 128 + 64 + lane];
        part = wave_sum(part); if (lane == 0) CBs[pp] = part; }
#pragma unroll
    for (int i = 0; i < 4; ++i) { const int idx = tid + NTHREADS * i, hh = idx >> 8, p = (idx >> 2) & 63, s = idx & 3;
        xw[idx] = xf[s * 512 + hh * 64 + p] * dtS[hh * 4 + s] * __expf(acS[hh * 4 + 3] - acS[hh * 4 + s]); }
    __syncthreads();
    { const int n4 = (lane & 31) * 4, half = lane >> 5; f32x4 c4[4], b4[4];
#pragma unroll
      for (int t = 0; t < 4; ++t) { c4[t] = *(const LAS f32x4*)(Cf + t * 128 + n4); b4[t] = *(const LAS f32x4*)(Bf + t * 128 + n4); }
      const float ea = __expf(acS[wave * 4 + 3]);
      const float* H0 = A.in[I_SSSM] + (size_t)((seq * 64 + hd) * 64) * 128; float* H1 = A.out + O_SSSM + (size_t)((seq * 64 + hd) * 64) * 128; const int hoff = half * 128 + n4;
      f32x4 hbuf[2][8];
#pragma unroll
      for (int r = 0; r < 8; ++r) { const float* rp = H0 + (size_t)(2 * r) * 128; hbuf[0][r] = __builtin_nontemporal_load((const f32x4*)(rp + hoff)); }
#pragma unroll
      for (int bt = 0; bt < 4; ++bt) {
          if (bt < 3) {
#pragma unroll
              for (int r = 0; r < 8; ++r) { const float* rp = H0 + (size_t)(2 * ((bt + 1) * 8 + r)) * 128; hbuf[(bt + 1) & 1][r] = __builtin_nontemporal_load((const f32x4*)(rp + hoff)); } }
#pragma unroll
          for (int r = 0; r < 8; ++r) { const int p = half + 2 * (bt * 8 + r); const f32x4 h4 = hbuf[bt & 1][r];
              const f32x4 xw4 = *(const LAS f32x4*)(xw + (wave * 64 + p) * 4);
              const f32x4 hn = ea * h4 + xw4[0] * b4[0] + xw4[1] * b4[1] + xw4[2] * b4[2] + xw4[3] * b4[3];
              { float* wp = H1 + (size_t)(2 * (bt * 8 + r)) * 128; __builtin_nontemporal_store(hn, (f32x4*)(wp + hoff)); }
              float part[4];
#pragma unroll
              for (int t = 0; t < 4; ++t) { part[t] = (c4[t][0] * h4[0] + c4[t][1] * h4[1]) + (c4[t][2] * h4[2] + c4[t][3] * h4[3]);
                  part[t] += __shfl_xor(part[t], 1); part[t] += __shfl_xor(part[t], 2); part[t] += __shfl_xor(part[t], 4); part[t] += __shfl_xor(part[t], 8); part[t] += __shfl_xor(part[t], 16); }
              if ((lane & 31) == 0) {
#pragma unroll
                  for (int t = 0; t < 4; ++t) yp[(wave * 4 + t) * 64 + p] = part[t]; } } } }
    __syncthreads();
    { const int p = lane; const float dskip = A.in[I_DSKIP][hd]; float pre[4];
#pragma unroll
      for (int t = 0; t < 4; ++t) { float y = __expf(acS[wave * 4 + t]) * yp[(wave * 4 + t) * 64 + p];
#pragma unroll
          for (int s = 0; s < 4; ++s) if (s <= t) y += CBs[t * 4 + s] * __expf(acS[wave * 4 + t] - acS[wave * 4 + s]) * dtS[wave * 4 + s] * xf[s * 512 + wave * 64 + p];
          y += dskip * xf[t * 512 + wave * 64 + p];
          const int row = rowb + t, col = hd * 64 + p; const float z = bf2f(PROJ[(size_t)row * NPROJ + 16384 + col]); pre[t] = y * silu(z);
          const float ss = wave_sum(pre[t] * pre[t]); if (lane == 0) ssS[wave * 4 + t] = ss; }
      __syncthreads();
#pragma unroll
      for (int t = 0; t < 4; ++t) { float tot = 0.f;
#pragma unroll
          for (int w = 0; w < 8; ++w) tot += ssS[w * 4 + t];
          const float rstd = rsqrtf(tot * (1.f / 512.f) + EPS); const int col = hd * 64 + p;
          MIX[(size_t)(rowb + t) * LDM + 4096 + col] = (bf16)f2bf(pre[t] * rstd * snorm[col]); } }
    __syncthreads();
}


__global__ void __launch_bounds__(NTHREADS, 2) mk_fwd(Args args) {
    extern __shared__ __attribute__((aligned(16))) unsigned char lds_raw[];
    LAS unsigned char* lds = (LAS unsigned char*)lds_raw;
    volatile LAS unsigned* MISC = (volatile LAS unsigned*)(lds + LDSCTL_OFF);
    const int tid = threadIdx.x, lane = tid & 63, wave = __builtin_amdgcn_readfirstlane(tid >> 6);
    const int G = gridDim.x, bid = blockIdx.x;
    const int gw = bid * NWAVES + wave, NGW = G * NWAVES, gt = bid * NTHREADS + tid, NGT = G * NTHREADS;
    unsigned char* ws = args.ws;
    unsigned* ctl = (unsigned*)(ws + WS_CTL);
    if (tid < 64) MISC[tid] = 0u;
    __syncthreads();
    XcdBarrier bar; bar.bar = ctl + CW_BAR; bar.x = 0; bar.st = nullptr;
    if (MK_N_LAUNCHES == 1) bar = xcd_barrier_post(ctl + CW_BAR, MISC + 8);
#define GRID_BAR() do { if (MK_N_LAUNCHES == 1) xcd_barrier(bar); } while (0)
    const int lo = args.ph_lo, hi = args.ph_hi;
#define IN(k) (lo <= (k) && (k) < hi)
#define BOTH(k) (IN(k) && IN((k) + 1))

    if (IN(0)) {
#pragma nounroll
        for (int rep = 0; rep < (PROBE_DUP == 0 ? 2 : 1); ++rep) p0_prologue(args, lds, gw, NGW, lane, wave);
        if (BOTH(0)) GRID_BAR(); }
    if (IN(1)) {
        pg8::Gemm g{(const bf16*)(ws + WS_XN), (const bf16*)(ws + WS_W1T), LDX, LDX, DM}; pg8::Order S; S.init(MTOK / 256, NW1 / 256, G, bid, 0, 0, PROBE_DUP == 1 ? 2 : 1);
        pg8::EpiProj E{(bf16*)(ws + WS_PROJ), (float*)(ws + WS_GATES)};
        pg8::gemm_phase<pg8::EpiProj, pg8::Order>(lds, g, S, E);
        if (BOTH(1)) GRID_BAR();
    }
    if (IN(2)) {
        const bf16* PROJ = (const bf16*)(ws + WS_PROJ);
#pragma nounroll
        for (int rep = 0; rep < (PROBE_DUP == 2 ? 2 : 1); ++rep) {
        gate_scans(args, gw, NGW, lane);
        conv_part<4096, 8, true>(PROJ, nullptr, args.in[I_MCW], args.in[I_MCB], (bf16*)(ws + WS_UC), LDX, args.out + O_PMCONV, gt, NGT);
        conv_part<4096, 4, false>(PROJ, args.in[I_MCONV], args.in[I_MCW], args.in[I_MCB], (bf16*)(ws + WS_UC), LDX, args.out + O_SMCONV, gt, NGT);
        conv_part<6144, 8, true>(PROJ + 20480, nullptr, args.in[I_SCW], args.in[I_SCB], (bf16*)(ws + WS_XBC), 6144, args.out + O_PSCONV, gt, NGT);
        conv_part<6144, 4, false>(PROJ + 20480, args.in[I_SCONV], args.in[I_SCW], args.in[I_SCB], (bf16*)(ws + WS_XBC), 6144, args.out + O_SSCONV, gt, NGT); }
        if (BOTH(2)) GRID_BAR();
    }
    if (IN(3)) {
        if (bid == 0 && wave == 0) mlstm_m_carry(args, lane);
        { pg8::Gemm g{(const bf16*)(ws + WS_UC), (const bf16*)(ws + WS_WQK), LDX, LDQ, 512}; pg8::Order S; S.init(MTOK / 256, 16, G, bid, 1, 512, PROBE_DUP == 3 ? 2 : 1);
          pg8::EpiBf16 E{(bf16*)(ws + WS_QK), DM};
          pg8::gemm_phase<pg8::EpiBf16, pg8::Order>(lds, g, S, E); }
        { pg8::Gemm g{(const bf16*)(ws + WS_PB), (const bf16*)(ws + WS_WPT), LDP, LDP, 256}; pg8::Order S; S.init(MTOK / 256, 16, G, bid, 0, 0, PROBE_DUP == 3 ? 2 : 1);
          pg8::EpiBf16 E{(bf16*)(ws + WS_PPB), DM};
          pg8::gemm_phase<pg8::EpiBf16, pg8::Order>(lds, g, S, E); }
        if (BOTH(3)) GRID_BAR();
    }
    if (IN(4)) {
#pragma nounroll
        for (int rep = 0; rep < (PROBE_DUP == 40 ? 2 : 1); ++rep) for (int it = bid; it < 1024; it += G) m1_unit(args, lds, it, tid, lane, wave);
#pragma nounroll
        for (int rep = 0; rep < (PROBE_DUP == 41 ? 2 : 1); ++rep) for (int it = bid; it < 1024; it += G) s1_unit(args, lds, it, tid, lane, wave);
        if (BOTH(4)) GRID_BAR();
    }
    if (IN(5)) {
        if (bid >= G - 32) nscan_item(args, bid - (G - 32), tid);
#pragma nounroll
        for (int rep = 0; rep < (PROBE_DUP == 50 ? 2 : 1); ++rep)
        for (int it = bid; it < 256; it += G) { if (it < 128) m2_item(args, lds, it, tid, lane, wave); else s2_item(args, lds, it - 128, tid, lane, wave); }
#pragma nounroll
        for (int rep = 0; rep < (PROBE_DUP == 52 ? 2 : 1); ++rep) for (int it = bid; it < 1024; it += G) mlstm_sample_item(args, lds, it, tid, lane, wave);
#pragma nounroll
        for (int rep = 0; rep < (PROBE_DUP == 53 ? 2 : 1); ++rep) for (int it = bid; it < 1024; it += G) ssd_sample_item(args, lds, it, tid, lane, wave);
        if (BOTH(5)) GRID_BAR();
    }
    if (IN(6)) {
#pragma nounroll
        for (int rep = 0; rep < (PROBE_DUP == 6 ? 2 : 1); ++rep) { m3_pass(args, gw, NGW, lane); s3_pass(args, gw, NGW, lane); }
        if (BOTH(6)) GRID_BAR();
    }
    if (IN(7)) {
        pg8::Gemm g{(const bf16*)(ws + WS_MIX), (const bf16*)(ws + WS_W2T), LDM, LDM, 8192}; pg8::Order S; S.init(MTOK / 256, 16, G, bid, 0, 0, PROBE_DUP == 7 ? 2 : 1);
        pg8::EpiX1 E{args.in[I_XP], args.in[I_XS], args.in[I_PLENORM], (float*)(ws + WS_X1), (bf16*)(ws + WS_X1G), (float*)(ws + WS_RS1), PROBE_DUP == 7 ? 0.5f : 1.f};
        pg8::gemm_phase<pg8::EpiX1, pg8::Order>(lds, g, S, E);
        if (BOTH(7)) GRID_BAR();
    }
    if (IN(8)) {
        pg8::Gemm g{(const bf16*)(ws + WS_X1G), (const bf16*)(ws + WS_WGT), LDX, LDX, DM}; pg8::Order S; S.init(MTOK / 256, 16, G, bid, 0, 0, PROBE_DUP == 8 ? 2 : 1);
        pg8::EpiGate E{(const float*)(ws + WS_X1), (const bf16*)(ws + WS_PPB), (const float*)(ws + WS_RS1), args.out + O_Y, (float*)(ws + WS_RS2), PROBE_DUP == 8 ? 0.5f : 1.f};
        pg8::gemm_phase<pg8::EpiGate, pg8::Order>(lds, g, S, E);
        if (BOTH(8)) GRID_BAR();
    }
    if (IN(9)) {
        const float* RS2 = (const float*)(ws + WS_RS2); const float* fn = args.in[I_FNORM]; float* Y = args.out + O_Y;
        for (int i = gt; i < MTOK * 1024; i += NGT) { const int row = i >> 10, c4 = (i & 1023) * 4;
            const float rstd = rsqrtf(RS2[row] * (1.f / DM) + EPS);
            const f32x4 g4 = *(const f32x4*)(fn + c4); f32x4 v = *(f32x4*)(Y + (size_t)row * DM + c4);
            v = v * rstd * g4; *(f32x4*)(Y + (size_t)row * DM + c4) = v; }
    }
#undef IN
#undef BOTH
#undef GRID_BAR
}

extern "C" void kernel_launch(void* const* d_in, const int* in_sizes, int n_in, void* d_out, int out_size, void* d_ws, size_t ws_size, hipStream_t stream) {
    static int grid = 0;
    if (grid == 0) {
        if (n_in != N_IN || (size_t)out_size != O_END || ws_size < WS_END) { fprintf(stderr, "kernel_launch: unexpected sizes n_in %d out %d ws %zu\n", n_in, out_size, ws_size); grid = -1; return; }
        int dev = 0, cus = 0, per_cu = 0;
        if (hipGetDevice(&dev) != hipSuccess || hipDeviceGetAttribute(&cus, hipDeviceAttributeMultiprocessorCount, dev) != hipSuccess) { grid = -1; return; }
        if (hipFuncSetAttribute((const void*)mk_fwd, hipFuncAttributeMaxDynamicSharedMemorySize, LDS_BYTES) != hipSuccess) { fprintf(stderr, "kernel_launch: hipFuncSetAttribute failed\n"); grid = -1; return; }
        if (hipOccupancyMaxActiveBlocksPerMultiprocessor(&per_cu, (const void*)mk_fwd, NTHREADS, LDS_BYTES) != hipSuccess || per_cu < 1) { fprintf(stderr, "kernel_launch: occupancy query says %d\n", per_cu); }
        (void)hipGetLastError();
        grid = cus;
    }
    if (grid < 0) return;
    if (hipMemsetAsync((char*)d_ws + WS_CTL, 0, CTL_ZERO_BYTES, stream) != hipSuccess) return;
    Args a{};
    for (int i = 0; i < N_IN; ++i) a.in[i] = (const float*)d_in[i];
    a.out = (float*)d_out; a.ws = (unsigned char*)d_ws;
    constexpr int NPH = 10;
    if (MK_N_LAUNCHES == 1) { a.ph_lo = 0; a.ph_hi = NPH; hipLaunchKernelGGL(mk_fwd, dim3(grid), dim3(NTHREADS), LDS_BYTES, stream, a); }
    else for (int p = 0; p < NPH; ++p) { a.ph_lo = p; a.ph_hi = p + 1; hipLaunchKernelGGL(mk_fwd, dim3(grid), dim3(NTHREADS), LDS_BYTES, stream, a); }
}
```

```cpp
#include <hip/hip_runtime.h>
#include <cstdio>

#ifndef PROBE_DUP
#define PROBE_DUP -1
#endif
#ifndef PG8_SP2
#define PG8_SP2 true
#endif
#ifndef MK_N_LAUNCHES
#define MK_N_LAUNCHES 1
#endif

#define GAS __attribute__((address_space(1)))
#define LAS __attribute__((address_space(3)))
typedef unsigned short bf16;
typedef unsigned v4u __attribute__((ext_vector_type(4)));
typedef unsigned v2u __attribute__((ext_vector_type(2)));
typedef float f32x4 __attribute__((ext_vector_type(4)));
typedef float f32x2 __attribute__((ext_vector_type(2)));
typedef short bf16x8 __attribute__((ext_vector_type(8)));

constexpr int NWAVES = 8, NTHREADS = 512;
constexpr int MTOK = 8704, MPR = 8192, DM = 4096, SEQ = 2048;
constexpr int NPROJ = 26624, NW1 = 26880, INCOLS = 26704;
constexpr int LDX = 4160, LDM = 8256, LDP = 320, LDQ = 576;
constexpr float EPS = 1e-6f;
enum { I_XP = 0, I_XS, I_PP, I_PS, I_MC, I_MN, I_MM, I_MCONV, I_SSSM, I_SCONV, I_NORMIN, I_WIN, I_BIG, I_BFG, I_MCW, I_MCB, I_WQ, I_WK, I_MNORM,
       I_SCW, I_SCB, I_DTB, I_ALOG, I_DSKIP, I_SNORM, I_WOUT, I_PLEPROJ, I_PLEGATE, I_PLENORM, I_FNORM, N_IN };
constexpr size_t O_Y = 0, O_PC = 35651584, O_PN = 39845888, O_PM = 39854080, O_PMCONV = 39854112, O_PSSM = 39903264, O_PSCONV = 42000416,
                 O_SC = 42074144, O_SN = 176291872, O_SM = 176554016, O_SMCONV = 176555040, O_SSSM = 178127904, O_SSCONV = 245236768, O_END = 247596064;
constexpr size_t MiB = 1u << 20;
constexpr size_t WS_CTL = 0, CTL_ZERO_BYTES = 4 * MiB;
constexpr size_t WS_NRM = 1 * MiB, WS_RS1 = 2 * MiB, WS_RS2 = 2 * MiB + 65536;
constexpr size_t WS_W1T = 4 * MiB, WS_W2T = 218 * MiB, WS_WGT = 283 * MiB, WS_WPT = 316 * MiB, WS_WQK = 319 * MiB, WS_XN = 324 * MiB, WS_PB = 394 * MiB,
                 WS_PROJ = 400 * MiB, WS_GATES = 842 * MiB, WS_UC = 851 * MiB, WS_QK = 921 * MiB, WS_XBC = 989 * MiB, WS_MG = 1091 * MiB, WS_SG = 1093 * MiB,
                 WS_MIX = 1098 * MiB, WS_X1 = 1236 * MiB, WS_X1G = 1372 * MiB, WS_PPB = 1442 * MiB,
                 WS_KWT = 1510 * MiB, WS_XWT = 1542 * MiB, WS_BMT = 1606 * MiB, WS_KWS = 1622 * MiB, WS_NALL = 1623 * MiB, WS_DENI = 1624 * MiB, WS_CS = 1625 * MiB, WS_MPD = 1626 * MiB, WS_END = 1627 * MiB;
constexpr size_t WS_NUMI = WS_UC, WS_INTER = WS_XN, WS_YI = WS_W1T, WS_YS = WS_W1T + 64 * MiB, WS_VT = WS_W1T + 128 * MiB;
constexpr size_t WS_SLAB2 = WS_W1T, WS_SLAB3 = WS_W1T + 64 * MiB;
constexpr int CW_TMO = 0, CW_BAR = 4096;
constexpr int LDSCTL_OFF = 131072, LDS_BYTES = 147456;

__device__ __forceinline__ unsigned f2bf(float f) { unsigned u = __builtin_bit_cast(unsigned, f); return (u + 0x7fffu + ((u >> 16) & 1u)) >> 16; }
typedef __bf16 bf16x2_t __attribute__((ext_vector_type(2)));
__device__ __forceinline__ unsigned pk2(float lo, float hi) { const f32x2 v = {lo, hi}; return __builtin_bit_cast(unsigned, __builtin_convertvector(v, bf16x2_t)); }
__device__ __forceinline__ float bflo(unsigned w) { return __builtin_bit_cast(float, w << 16); }
__device__ __forceinline__ float bfhi(unsigned w) { return __builtin_bit_cast(float, w & 0xffff0000u); }
__device__ __forceinline__ float bf2f(bf16 b) { return __builtin_bit_cast(float, (unsigned)b << 16); }
__device__ __forceinline__ float sigm(float x) { return 1.f / (1.f + __expf(-x)); }
__device__ __forceinline__ float silu(float x) { return x / (1.f + __expf(-x)); }
__device__ __forceinline__ float softplus(float x) { return fmaxf(x, 0.f) + log1pf(__expf(-fabsf(x))); }
__device__ __forceinline__ float softcap(float x) { return 15.f * tanhf(x * (1.f / 15.f)); }
__device__ __forceinline__ float wave_sum(float v) {
#pragma unroll
    for (int o = 1; o < 64; o <<= 1) v += __shfl_xor(v, o);
    return v;
}
#define LDS_WAIT() asm volatile("s_waitcnt lgkmcnt(0)" ::: "memory")

namespace pg8 {
constexpr int BM = 256, BK = 64, HALF = 128, HTB = HALF * BK * 2, STAGE_BYTES = 8 * HTB, NXCD = 8, WGM = 8;
__host__ __device__ __forceinline__ int lds_byte(int r, int c) { const int st = (r >> 4) * 2 + (c >> 5), rr = r & 15, cc = c & 31, ob = rr * 64 + cc * 2; return st * 1024 + (ob ^ (((ob >> 9) & 1) << 5)); }
__host__ __device__ __forceinline__ void stage_rc(int b, int& R, int& C) { const int st = b / 1024, sb = b % 1024, swz = sb ^ (((sb >> 9) & 1) << 5); R = (st >> 1) * 16 + swz / 64; C = (st & 1) * 32 + (swz % 64) / 2; }
__host__ __device__ __forceinline__ int perm32(int rho) { const int n = rho >> 4, i = rho & 15; return 8 * (i >> 2) + 4 * n + (i & 3); }
struct Unit { int pm, pn, ks; };
struct Gemm { const bf16* A; const bf16* Bt; int lda, ldb, K; };
struct Order {
    int nM, nN, nwg, G, c, kshift, kmul, rep;
    __device__ void init(int nM_, int nN_, int G_, int c_, int kshift_ = 0, int kmul_ = 0, int rep_ = 1) { nM = nM_; nN = nN_; nwg = nM * nN; G = G_; c = c_; kshift = kshift_; kmul = kmul_; rep = rep_; }
    __device__ bool next(int i, Unit& u) const {
        const int L = i * G + c; if (L >= nwg * rep) return false;
        int wgid = (rep == 1) ? L : (L % nwg); { const int q = nwg / NXCD, r = nwg % NXCD, xcd = wgid % NXCD, off = wgid / NXCD; wgid = (xcd < r ? xcd * (q + 1) : r * (q + 1) + (xcd - r) * q) + off; }
        const int nig = WGM * nN, gid = wgid / nig, fm = gid * WGM, gsz = (nM - fm) < WGM ? (nM - fm) : WGM;
        u.pm = fm + ((wgid % nig) % gsz); u.pn = (wgid % nig) / gsz; u.ks = 0; return true;
    }
    __device__ __forceinline__ int a_koff(const Unit& u) const { return (u.pn >> kshift) * kmul; }
    __device__ __forceinline__ int b_koff(const Unit&) const { return 0; }
    __device__ __forceinline__ void a_ready(const Unit&) const {}
    __device__ __forceinline__ void done(const Unit&) const {}
};

struct SplitOrder {
    int G, c, pm0, kchunk;
    __device__ bool next(int i, Unit& u) const { const int L = i * G + c; if (L >= 256) return false; u.pm = pm0 + (L >> 7); u.pn = (L >> 3) & 15; u.ks = L & 7; return true; }
    __device__ __forceinline__ int a_koff(const Unit& u) const { return u.ks * kchunk; }
    __device__ __forceinline__ int b_koff(const Unit& u) const { return u.ks * kchunk; }
    __device__ __forceinline__ void a_ready(const Unit&) const {}
    __device__ __forceinline__ void done(const Unit&) const {}
};
template <class Epi, class Sched, bool ALIGN_EPI = true, bool SP2 = PG8_SP2>
__device__ __forceinline__ void gemm_phase(LAS unsigned char* lds, const Gemm g, const Sched& S, const Epi& E) {
    const int tid = threadIdx.x, wid = __builtin_amdgcn_readfirstlane(tid >> 6), lane = tid & 63, wr = wid >> 2, wc = wid & 3, fr = lane & 15, fq = lane >> 4;
    const int K = g.K, nt = K / BK;
    unsigned voffA[2], voffB[2];
#pragma unroll
    for (int i = 0; i < 2; ++i) { int R, C; stage_rc(tid * 16 + i * 8192, R, C); const int Rb = Epi::PERM ? ((R & ~31) + perm32(R & 31)) : R;
        voffA[i] = (unsigned)(R * g.lda + C) * 2u; voffB[i] = (unsigned)(Rb * g.ldb + C) * 2u; }
    const size_t kstep = (size_t)(BK * 2);
    const size_t hstepA = (size_t)HALF * g.lda * 2, hstepB = (size_t)HALF * g.ldb * 2;
    const size_t tstepA = 2 * hstepA, tstepB = 2 * hstepB;
    const unsigned ldsw = (unsigned)wid * 1024u;
    const int aoff = lds_byte(wr * 64 + fr, fq * 8), boff = lds_byte(wc * 32 + fr, fq * 8);
#define PG8_SA(b, h) (((b) * 2 + (h)) * HTB)
#define PG8_SB(b, h) ((4 + (b) * 2 + (h)) * HTB)
#define PG8_STAGE(bufoff, gbase, voff) do { _Pragma("unroll") for (int _i = 0; _i < 2; ++_i) \
        __builtin_amdgcn_global_load_lds((const unsigned*)((const char*)(gbase) + (voff)[_i]), (LAS unsigned*)(lds + (bufoff) + ldsw + _i * 8192), 16, 0, 0); } while (0)
#define PG8_LDA(dst, b, h) do { _Pragma("unroll") for (int m = 0; m < 4; ++m) _Pragma("unroll") for (int k = 0; k < 2; ++k) dst[m][k] = *(const LAS bf16x8*)(lds + PG8_SA(b, h) + aoff + m * 2048 + k * 1024); } while (0)
#define PG8_LDB(dst, b, h) do { _Pragma("unroll") for (int n = 0; n < 2; ++n) _Pragma("unroll") for (int k = 0; k < 2; ++k) dst[n][k] = *(const LAS bf16x8*)(lds + PG8_SB(b, h) + boff + n * 2048 + k * 1024); } while (0)
#define PG8_MMA(ai, bj, At, Bt) do { __builtin_amdgcn_s_setprio(1); _Pragma("unroll") for (int m = 0; m < 4; ++m) _Pragma("unroll") for (int n = 0; n < 2; ++n) _Pragma("unroll") for (int k = 0; k < 2; ++k) \
        acc[ai][bj][m][n] = __builtin_amdgcn_mfma_f32_16x16x32_bf16(Bt[n][k], At[m][k], acc[ai][bj][m][n], 0, 0, 0); __builtin_amdgcn_s_setprio(0); } while (0)
#define PG8_WAIT_V(n) asm volatile("s_waitcnt vmcnt(" #n ")" ::: "memory")
#define PG8_WAIT_L(n) asm volatile("s_waitcnt lgkmcnt(" #n ")" ::: "memory")
#define PG8_BAR __builtin_amdgcn_s_barrier()
#define PG8_SCHED __builtin_amdgcn_sched_barrier(0)
    Unit cur, nxt; int ui = 0;
    if (!S.next(0, cur)) return;
    f32x4 acc[2][2][4][2];
#pragma unroll
    for (int a = 0; a < 2; ++a)
#pragma unroll
        for (int b = 0; b < 2; ++b)
#pragma unroll
            for (int m = 0; m < 4; ++m)
#pragma unroll
                for (int n = 0; n < 2; ++n) acc[a][b][m][n] = (f32x4){0.f, 0.f, 0.f, 0.f};
    bf16x8 At[4][2], B0[2][2], B1[2][2];
    const char* cA = (const char*)g.A + (size_t)cur.pm * tstepA + (size_t)S.a_koff(cur) * 2; const char* cB = (const char*)g.Bt + (size_t)cur.pn * tstepB + (size_t)S.b_koff(cur) * 2;
    S.a_ready(cur);
    if constexpr (SP2) {
    PG8_STAGE(PG8_SB(0, 0), cB, voffB); PG8_STAGE(PG8_SB(0, 1), cB + hstepB, voffB); PG8_STAGE(PG8_SA(0, 0), cA, voffA); PG8_STAGE(PG8_SA(0, 1), cA + hstepA, voffA);
    if (wr == 1) PG8_BAR;
    PG8_WAIT_V(2); PG8_BAR;
    PG8_STAGE(PG8_SB(1, 0), cB + kstep, voffB); PG8_STAGE(PG8_SA(1, 0), cA + kstep, voffA); PG8_STAGE(PG8_SB(1, 1), cB + hstepB + kstep, voffB);
    PG8_WAIT_V(6); PG8_BAR;
    } else {
    PG8_STAGE(PG8_SB(0, 0), cB, voffB); PG8_STAGE(PG8_SA(0, 0), cA, voffA); PG8_STAGE(PG8_SB(0, 1), cB + hstepB, voffB); PG8_STAGE(PG8_SA(0, 1), cA + hstepA, voffA);
    if (wr == 1) PG8_BAR;
    PG8_WAIT_V(4); PG8_BAR;
    PG8_STAGE(PG8_SB(1, 0), cB + kstep, voffB); PG8_STAGE(PG8_SA(1, 0), cA + kstep, voffA); PG8_STAGE(PG8_SB(1, 1), cB + hstepB + kstep, voffB);
    PG8_WAIT_V(6); PG8_BAR;
    }
    for (;;) {
        const bool has_next = S.next(ui + 1, nxt);
        const char* nA = has_next ? (const char*)g.A + (size_t)nxt.pm * tstepA + (size_t)S.a_koff(nxt) * 2 : cA; const char* nB = has_next ? (const char*)g.Bt + (size_t)nxt.pn * tstepB + (size_t)S.b_koff(nxt) * 2 : cB;
        for (int t = 0; t < nt; t += 2) {
            const bool last = (t == nt - 2);
            const char* a1 = cA + (size_t)(t + 1) * kstep;
            const char* a2 = last ? nA : cA + (size_t)(t + 2) * kstep; const char* b2 = last ? nB : cB + (size_t)(t + 2) * kstep;
            const char* a3 = a2 + kstep; const char* b3 = b2 + kstep;
            if (last && has_next) S.a_ready(nxt);
            if constexpr (SP2) {
            PG8_LDB(B0, 0, 0); PG8_LDB(B1, 0, 1); PG8_SCHED; PG8_LDA(At, 0, 0); PG8_STAGE(PG8_SA(1, 1), a1 + hstepA, voffA);
            PG8_WAIT_V(8); PG8_WAIT_L(0); PG8_BAR; PG8_MMA(0, 0, At, B0); PG8_MMA(0, 1, At, B1); PG8_BAR; PG8_SCHED;
            PG8_LDA(At, 0, 1); PG8_STAGE(PG8_SB(0, 0), b2, voffB); PG8_STAGE(PG8_SB(0, 1), b2 + hstepB, voffB); PG8_STAGE(PG8_SA(0, 0), a2, voffA);
            PG8_WAIT_V(8); PG8_WAIT_L(0); PG8_BAR; PG8_MMA(1, 0, At, B0); PG8_MMA(1, 1, At, B1); PG8_BAR; PG8_SCHED;
            PG8_LDB(B0, 1, 0); PG8_LDB(B1, 1, 1); PG8_SCHED; PG8_LDA(At, 1, 0); PG8_STAGE(PG8_SA(0, 1), a2 + hstepA, voffA);
            PG8_WAIT_V(8); PG8_WAIT_L(0); PG8_BAR; PG8_MMA(0, 0, At, B0); PG8_MMA(0, 1, At, B1); PG8_BAR; PG8_SCHED;
            PG8_LDA(At, 1, 1); PG8_STAGE(PG8_SB(1, 0), b3, voffB); PG8_STAGE(PG8_SB(1, 1), b3 + hstepB, voffB); PG8_STAGE(PG8_SA(1, 0), a3, voffA);
            PG8_WAIT_V(8); PG8_WAIT_L(0); PG8_BAR; PG8_MMA(1, 0, At, B0); PG8_MMA(1, 1, At, B1); PG8_BAR; PG8_SCHED;
            } else {
            PG8_LDB(B0, 0, 0); PG8_SCHED; PG8_LDA(At, 0, 0); PG8_STAGE(PG8_SA(1, 1), a1 + hstepA, voffA);
            PG8_WAIT_L(8); PG8_BAR; PG8_WAIT_L(0); PG8_MMA(0, 0, At, B0); PG8_BAR; PG8_SCHED;
            PG8_LDB(B1, 0, 1); PG8_STAGE(PG8_SB(0, 0), b2, voffB);
            PG8_BAR; PG8_WAIT_L(0); PG8_MMA(0, 1, At, B1); PG8_BAR;
            PG8_LDA(At, 0, 1); PG8_STAGE(PG8_SA(0, 0), a2, voffA);
            PG8_BAR; PG8_WAIT_L(0); PG8_MMA(1, 0, At, B0); PG8_BAR; PG8_SCHED;
            PG8_STAGE(PG8_SB(0, 1), b2 + hstepB, voffB);
            PG8_WAIT_V(6); PG8_BAR; PG8_MMA(1, 1, At, B1); PG8_BAR;
            PG8_LDB(B0, 1, 0); PG8_SCHED; PG8_LDA(At, 1, 0); PG8_STAGE(PG8_SA(0, 1), a2 + hstepA, voffA);
            PG8_WAIT_L(8); PG8_BAR; PG8_WAIT_L(0); PG8_MMA(0, 0, At, B0); PG8_BAR; PG8_SCHED;
            PG8_LDB(B1, 1, 1); PG8_STAGE(PG8_SB(1, 0), b3, voffB);
            PG8_BAR; PG8_WAIT_L(0); PG8_MMA(0, 1, At, B1); PG8_BAR;
            PG8_LDA(At, 1, 1); PG8_STAGE(PG8_SA(1, 0), a3, voffA);
            PG8_BAR; PG8_WAIT_L(0); PG8_MMA(1, 0, At, B0); PG8_BAR; PG8_SCHED;
            PG8_STAGE(PG8_SB(1, 1), b3 + hstepB, voffB);
            PG8_WAIT_V(6); PG8_BAR; PG8_MMA(1, 1, At, B1); PG8_BAR;
            }
        }
        if constexpr (ALIGN_EPI) { if (wr == 0) PG8_BAR; }
        E(acc, cur, wr, wc, fr, fq); S.done(cur);
        if (!has_next) break;
#pragma unroll
        for (int a = 0; a < 2; ++a)
#pragma unroll
            for (int b = 0; b < 2; ++b)
#pragma unroll
                for (int m = 0; m < 4; ++m)
#pragma unroll
                    for (int n = 0; n < 2; ++n) acc[a][b][m][n] = (f32x4){0.f, 0.f, 0.f, 0.f};
        cur = nxt; cA = nA; cB = nB; ++ui;
        if constexpr (ALIGN_EPI) { if (wr == 1) PG8_BAR; }
    }
    PG8_WAIT_V(0);
    if constexpr (!ALIGN_EPI) { if (wr == 0) PG8_BAR; }
    PG8_BAR;
#undef PG8_SA
#undef PG8_SB
#undef PG8_STAGE
#undef PG8_LDA
#undef PG8_LDB
#undef PG8_MMA
#undef PG8_WAIT_V
#undef PG8_WAIT_L
#undef PG8_BAR
#undef PG8_SCHED
}

struct EpiBf16 {
    static constexpr bool PERM = true;
    bf16* O; int ldc;
    __device__ __forceinline__ void operator()(const f32x4 (&acc)[2][2][4][2], const Unit& u, int wr, int wc, int fr, int fq) const {
        const int row0 = u.pm * BM + wr * 64 + fr, col0 = u.pn * BM + wc * 32 + 8 * fq;
#pragma unroll
        for (int ai = 0; ai < 2; ++ai)
#pragma unroll
            for (int m = 0; m < 4; ++m) { bf16* rowp = O + (size_t)(row0 + ai * HALF + m * 16) * ldc + col0;
#pragma unroll
                for (int bj = 0; bj < 2; ++bj) { const f32x4 v0 = acc[ai][bj][m][0], v1 = acc[ai][bj][m][1];
                    v4u w; w.x = pk2(v0[0], v0[1]); w.y = pk2(v0[2], v0[3]); w.z = pk2(v1[0], v1[1]); w.w = pk2(v1[2], v1[3]);
                    *(v4u*)(rowp + bj * HALF) = w; } }
    }
};
struct EpiProj {
    static constexpr bool PERM = true;
    bf16* O; float* Gt;
    __device__ __forceinline__ void operator()(const f32x4 (&acc)[2][2][4][2], const Unit& u, int wr, int wc, int fr, int fq) const {
        const int row0 = u.pm * BM + wr * 64 + fr;
        if (u.pn < 104) {
            const int col0 = u.pn * BM + wc * 32 + 8 * fq;
#pragma unroll
            for (int ai = 0; ai < 2; ++ai)
#pragma unroll
                for (int m = 0; m < 4; ++m) { bf16* rowp = O + (size_t)(row0 + ai * HALF + m * 16) * NPROJ + col0;
#pragma unroll
                    for (int bj = 0; bj < 2; ++bj) { const f32x4 v0 = acc[ai][bj][m][0], v1 = acc[ai][bj][m][1];
                        v4u w; w.x = pk2(v0[0], v0[1]); w.y = pk2(v0[2], v0[3]); w.z = pk2(v1[0], v1[1]); w.w = pk2(v1[2], v1[3]);
                        *(v4u*)(rowp + bj * HALF) = w; } }
        } else {
            const int col0 = wc * 32 + 8 * fq;
#pragma unroll
            for (int ai = 0; ai < 2; ++ai)
#pragma unroll
                for (int m = 0; m < 4; ++m) { float* rowp = Gt + (size_t)(row0 + ai * HALF + m * 16) * 256 + col0;
#pragma unroll
                    for (int bj = 0; bj < 2; ++bj)
#pragma unroll
                        for (int n = 0; n < 2; ++n) *(f32x4*)(rowp + bj * HALF + 4 * n) = acc[ai][bj][m][n]; }
        }
    }
};
struct EpiSlab {
    static constexpr bool PERM = false;
    float* slab;
    __device__ __forceinline__ void operator()(const f32x4 (&acc)[2][2][4][2], const Unit& u, int wr, int wc, int fr, int fq) const {
        const int row0 = u.pm * BM - MPR + wr * 64 + fr, col0 = u.pn * BM + wc * 32 + 4 * fq;
#pragma unroll
        for (int ai = 0; ai < 2; ++ai)
#pragma unroll
            for (int m = 0; m < 4; ++m) { float* rowp = slab + ((size_t)u.ks * 512 + row0 + ai * HALF + m * 16) * DM + col0;
#pragma unroll
                for (int bj = 0; bj < 2; ++bj)
#pragma unroll
                    for (int n = 0; n < 2; ++n) *(f32x4*)(rowp + bj * HALF + n * 16) = acc[ai][bj][m][n]; }
    }
};
struct EpiX1 {
    static constexpr bool PERM = false;
    const float* xp; const float* xs; const float* gn; float* X1; bf16* X1G; float* RS; float ssw;
    __device__ __forceinline__ void operator()(const f32x4 (&acc)[2][2][4][2], const Unit& u, int wr, int wc, int fr, int fq) const {
        const int row0 = u.pm * BM + wr * 64 + fr, col0 = u.pn * BM + wc * 32 + 4 * fq;
#pragma unroll
        for (int ai = 0; ai < 2; ++ai)
#pragma unroll
            for (int m = 0; m < 4; ++m) { const int row = row0 + ai * HALF + m * 16;
                const float* xrow = (row < MPR ? xp + (size_t)row * DM : xs + (size_t)(row - MPR) * DM) + col0; const size_t off = (size_t)row * DM + col0; float ss = 0.f;
#pragma unroll
                for (int bj = 0; bj < 2; ++bj)
#pragma unroll
                    for (int n = 0; n < 2; ++n) { const int co = bj * HALF + n * 16; const f32x4 v = *(const f32x4*)(xrow + co) + acc[ai][bj][m][n];
                        *(f32x4*)(X1 + off + co) = v; ss += (v[0] * v[0] + v[1] * v[1]) + (v[2] * v[2] + v[3] * v[3]);
                        const f32x4 gv = *(const f32x4*)(gn + col0 + co); v2u w; w.x = pk2(v[0] * gv[0], v[1] * gv[1]); w.y = pk2(v[2] * gv[2], v[3] * gv[3]);
                        *(v2u*)(X1G + (size_t)row * LDX + col0 + co) = w; }
                ss += __shfl_xor(ss, 16); ss += __shfl_xor(ss, 32);
                if (fq == 0) atomicAdd(RS + row, ss * ssw); }
    }
};
struct EpiGate {
    static constexpr bool PERM = false;
    const float* X1; const bf16* PP; const float* RS1; float* out; float* RS2; float ssw;
    __device__ __forceinline__ void operator()(const f32x4 (&acc)[2][2][4][2], const Unit& u, int wr, int wc, int fr, int fq) const {
        const int row0 = u.pm * BM + wr * 64 + fr, col0 = u.pn * BM + wc * 32 + 4 * fq;
#pragma unroll
        for (int ai = 0; ai < 2; ++ai)
#pragma unroll
            for (int m = 0; m < 4; ++m) { const int row = row0 + ai * HALF + m * 16; const size_t off = (size_t)row * DM + col0; float ss = 0.f;
                const float rstd = rsqrtf(RS1[row] * (1.f / DM) + EPS);
#pragma unroll
                for (int bj = 0; bj < 2; ++bj)
#pragma unroll
                    for (int n = 0; n < 2; ++n) { const int co = bj * HALF + n * 16; const f32x4 a = acc[ai][bj][m][n] * rstd; const v2u pw = *(const v2u*)(PP + off + co);
                        const f32x4 x1 = *(const f32x4*)(X1 + off + co); f32x4 v;
                        v[0] = x1[0] + sigm(a[0]) * bflo(pw.x); v[1] = x1[1] + sigm(a[1]) * bfhi(pw.x); v[2] = x1[2] + sigm(a[2]) * bflo(pw.y); v[3] = x1[3] + sigm(a[3]) * bfhi(pw.y);
                        *(f32x4*)(out + off + co) = v; ss += (v[0] * v[0] + v[1] * v[1]) + (v[2] * v[2] + v[3] * v[3]); }
                ss += __shfl_xor(ss, 16); ss += __shfl_xor(ss, 32);
                if (fq == 0) atomicAdd(RS2 + row, ss * ssw); }
    }
};
}

#define XB_TMO      128
#define XB_XCNT(j)  (256  + 64 * (j))
#define XB_XSUB(j)  (1280 + 64 * (j))
#define XB_XGEN(j)  (2304 + 64 * (j))
#define XB_TOP      3328
#define XB_TOPGEN   3392
#define XCD_BAR_WORDS 3456
#define XB_SPIN_CAP (1u << 18)
__device__ __forceinline__ unsigned xb_ld(unsigned* p)              { return __hip_atomic_load(p, __ATOMIC_RELAXED, __HIP_MEMORY_SCOPE_AGENT); }
__device__ __forceinline__ unsigned xb_add(unsigned* p, unsigned v) { return __hip_atomic_fetch_add(p, v, __ATOMIC_RELAXED, __HIP_MEMORY_SCOPE_AGENT); }
__device__ __forceinline__ unsigned xb_xcc_id() { return (unsigned)__builtin_amdgcn_s_getreg((3 << 11) | 20) & 0xFu; }
#define XB_SPIN(cond, bar) do { unsigned _sp = 0; while (cond) { __builtin_amdgcn_s_sleep(1); \
    if ((++_sp & 255u) == 0u) { if (xb_ld(&(bar)[XB_TMO])) break; if (_sp > XB_SPIN_CAP) { atomicAdd(&(bar)[XB_TMO], 1u); break; } } } } while (0)
struct XcdBarrier { unsigned* bar; unsigned x; volatile LAS unsigned* st; };
__device__ __forceinline__ XcdBarrier xcd_barrier_post(unsigned* bar, volatile LAS unsigned* st) {
    XcdBarrier b; b.bar = bar; b.x = xb_xcc_id(); b.st = st;
    if (threadIdx.x == 0) (void)xb_add(&bar[XB_XCNT(b.x)], 1u);
    return b;
}
__device__ __forceinline__ void xcd_barrier_complete(unsigned* bar, unsigned x, unsigned& nloc, unsigned& nx) {
    const unsigned G = gridDim.x * gridDim.y * gridDim.z;
    unsigned sum, cnt, mine, sp = 0u;
    for (;;) {
        sum = 0u; cnt = 0u; mine = 0u;
#pragma unroll
        for (unsigned j = 0; j < 16; ++j) { const unsigned c = xb_ld(&bar[XB_XCNT(j)]); sum += c; cnt += (c > 0u) ? 1u : 0u; mine = (j == x) ? c : mine; }
        if (sum == G) break;
        __builtin_amdgcn_s_sleep(1);
        if ((++sp & 255u) == 0u) { if (xb_ld(&bar[XB_TMO])) break; if (sp > XB_SPIN_CAP) { atomicAdd(&bar[XB_TMO], 1u); break; } }
    }
    nloc = mine > 0u ? mine : 1u; nx = cnt > 0u ? cnt : 1u;
}
__device__ __forceinline__ void xcd_barrier(const XcdBarrier& b) {
    asm volatile("s_waitcnt vmcnt(0)" ::: "memory");
    __syncthreads();
    if (threadIdx.x == 0) {
        unsigned* bar = b.bar;
        __builtin_amdgcn_s_waitcnt(0);
        unsigned nloc = b.st[0], nx = b.st[1];
        if (nloc == 0u) { xcd_barrier_complete(bar, b.x, nloc, nx); b.st[0] = nloc; b.st[1] = nx; }
        const unsigned old = xb_add(&bar[XB_XSUB(b.x)], 1u);
        const unsigned gen = old / nloc;
        if (old + 1u == (gen + 1u) * nloc) {
            __builtin_amdgcn_fence(__ATOMIC_RELEASE, "agent");
            asm volatile("s_waitcnt vmcnt(0)" ::: "memory");
            const unsigned og = xb_add(&bar[XB_TOP], 1u);
            const unsigned tg = og / nx;
            if (og + 1u == (tg + 1u) * nx) xb_add(&bar[XB_TOPGEN], 1u);
            else XB_SPIN(xb_ld(&bar[XB_TOPGEN]) == tg, bar);
            __builtin_amdgcn_fence(__ATOMIC_ACQUIRE, "agent");
            xb_add(&bar[XB_XGEN(b.x)], 1u);
            asm volatile("s_waitcnt vmcnt(0)" ::: "memory");
        } else {
            XB_SPIN(xb_ld(&bar[XB_XGEN(b.x)]) == gen, bar);
            __builtin_amdgcn_fence(__ATOMIC_ACQUIRE, "agent");
            asm volatile("s_waitcnt vmcnt(0)" ::: "memory");
        }
    }
    __syncthreads();
}

struct Args { const float* in[N_IN]; float* out; unsigned char* ws; int ph_lo, ph_hi; };

template <int K>
__device__ __forceinline__ f32x4 mma_nt(const LAS bf16* X, int ldx, const LAS bf16* Y, int ldy, f32x4 acc, int lane) {
    const int r = lane & 15, kq = (lane >> 4) * 8;
#pragma unroll
    for (int k0 = 0; k0 < K; k0 += 32) {
        const bf16x8 a = *(const LAS bf16x8*)(X + r * ldx + k0 + kq);
        const bf16x8 b = *(const LAS bf16x8*)(Y + r * ldy + k0 + kq);
        acc = __builtin_amdgcn_mfma_f32_16x16x32_bf16(a, b, acc, 0, 0, 0);
    }
    return acc;
}

__device__ __forceinline__ int w1_colmap(int n) { return n < 16384 ? n : (n < 26624 ? n + 16 : (n < 26640 ? n - 26624 + 16384 : (n < INCOLS ? n : -1))); }
template <bool MAP>
__device__ __forceinline__ void transpose_item(const float* W, int ldw, bf16* WT, int ldt, int k0, int n0, LAS float* scr, int lane, float scale) {
    const int nn = n0 + (lane & 31); const int oc = MAP ? w1_colmap(nn) : nn;
    const int loff = (lane >> 5) * ldw + (oc >= 0 ? oc : 0);
    float tv[32];
#pragma unroll
    for (int i = 0; i < 32; ++i) { const float* rowp = W + (size_t)(k0 + 2 * i) * ldw; tv[i] = rowp[loff]; }
#pragma unroll
    for (int i = 0; i < 32; ++i) { const int kk = 2 * i + (lane >> 5); scr[kk * 33 + (lane & 31)] = (oc >= 0) ? tv[i] * scale : 0.f; }
    LDS_WAIT(); asm volatile("" ::: "memory");
    const int c = lane & 7;
#pragma unroll
    for (int j = 0; j < 4; ++j) { const int n = (lane >> 3) + 8 * j; const LAS float* s = scr + (8 * c) * 33 + n;
        v4u o; o.x = pk2(s[0 * 33], s[1 * 33]); o.y = pk2(s[2 * 33], s[3 * 33]); o.z = pk2(s[4 * 33], s[5 * 33]); o.w = pk2(s[6 * 33], s[7 * 33]);
        *(v4u*)(WT + (size_t)(n0 + n) * ldt + k0 + 8 * c) = o; }
    LDS_WAIT(); asm volatile("" ::: "memory");
}
__device__ __forceinline__ void p0_prologue(const Args& A, LAS unsigned char* lds, int gw, int NGW, int lane, int wave) {
    LAS float* scr = (LAS float*)(lds + wave * 16384);
    unsigned char* ws = A.ws;
    constexpr int I1 = 64 * 840, I2 = 128 * 128, I3 = 64 * 128, I4 = 4 * 128, I5 = 1024;
    for (int it = gw; it < I1 + I2 + I3 + I4 + I5; it += NGW) {
        int r = it;
        if (r < I1) { transpose_item<true>(A.in[I_WIN], INCOLS, (bf16*)(ws + WS_W1T), LDX, (r / 840) * 64, (r % 840) * 32, scr, lane, 1.f); continue; } r -= I1;
        if (r < I2) { transpose_item<false>(A.in[I_WOUT], DM, (bf16*)(ws + WS_W2T), LDM, (r / 128) * 64, (r % 128) * 32, scr, lane, 1.f); continue; } r -= I2;
        if (r < I3) { transpose_item<false>(A.in[I_PLEGATE], DM, (bf16*)(ws + WS_WGT), LDX, (r / 128) * 64, (r % 128) * 32, scr, lane, 1.f); continue; } r -= I3;
        if (r < I4) { transpose_item<false>(A.in[I_PLEPROJ], DM, (bf16*)(ws + WS_WPT), LDP, (r / 128) * 64, (r % 128) * 32, scr, lane, 1.f); continue; } r -= I4;
        { const int hw = r >> 6, h = hw >> 1, which = hw & 1, q = r & 63;
          const float* W = (which ? A.in[I_WK] : A.in[I_WQ]) + (size_t)h * 512 * 256;
          transpose_item<false>(W, 256, (bf16*)(ws + WS_WQK) + (size_t)(h * 512 + which * 256) * LDQ, LDQ, (q >> 3) * 64, (q & 7) * 32, scr, lane, which ? 0.0625f : 1.f); }
    }
    const float* gn = A.in[I_NORMIN];
    for (int m = gw; m < MTOK; m += NGW) {
        const float* xrow = m < MPR ? A.in[I_XP] + (size_t)m * DM : A.in[I_XS] + (size_t)(m - MPR) * DM;
        f32x4 v[16]; float s = 0.f;
#pragma unroll
        for (int j = 0; j < 16; ++j) { v[j] = ((const f32x4*)xrow)[lane + 64 * j]; s += (v[j][0] * v[j][0] + v[j][1] * v[j][1]) + (v[j][2] * v[j][2] + v[j][3] * v[j][3]); }
        const float rstd = rsqrtf(wave_sum(s) * (1.f / DM) + EPS);
        bf16* orow = (bf16*)(ws + WS_XN) + (size_t)m * LDX;
#pragma unroll
        for (int j = 0; j < 16; ++j) { const f32x4 g4 = ((const f32x4*)gn)[lane + 64 * j]; v2u w; w.x = pk2(v[j][0] * rstd * g4[0], v[j][1] * rstd * g4[1]); w.y = pk2(v[j][2] * rstd * g4[2], v[j][3] * rstd * g4[3]);
            ((v2u*)orow)[lane + 64 * j] = w; }
    }
    { const int gt = gw * 64 + lane, NGT = NGW * 64;
      for (int i = gt; i < MTOK * 32; i += NGT) { const int row = i >> 5, c8 = (i & 31) * 8;
          const float* src = (row < MPR ? A.in[I_PP] + (size_t)row * 256 : A.in[I_PS] + (size_t)(row - MPR) * 256) + c8;
          const f32x4 a = *(const f32x4*)src, b = *(const f32x4*)(src + 4);
          v4u w; w.x = pk2(a[0], a[1]); w.y = pk2(a[2], a[3]); w.z = pk2(b[0], b[1]); w.w = pk2(b[2], b[3]);
          *(v4u*)((bf16*)(ws + WS_PB) + (size_t)row * LDP + c8) = w; } }
}

template <int NCH, int NT, bool PROMPT>
__device__ __forceinline__ void conv_part(const bf16* src  , const float* state_in, const float* w, const float* bias, bf16* dst, int dst_ld, float* out_state, int gt, int NGT) {
    constexpr int CG = NCH / 8, NBLK = PROMPT ? SEQ / NT : 1, NSEQ = PROMPT ? 4 : 128;
    for (int it = gt; it < NSEQ * NBLK * CG; it += NGT) {
        const int cg = it % CG, q = it / CG, seq = q / NBLK, blk = q % NBLK, c0 = cg * 8;
        const int row0 = PROMPT ? seq * SEQ + blk * NT : MPR + seq * 4;
        v4u rows[NT]; float win[3][8];
#pragma unroll
        for (int i = 0; i < NT; ++i) rows[i] = *(const v4u*)(src + (size_t)(row0 + i) * NPROJ + c0);
        if (PROMPT) {
#pragma unroll
            for (int j = 0; j < 3; ++j) { v4u v = (v4u){0u, 0u, 0u, 0u}; if (blk != 0) v = *(const v4u*)(src + (size_t)(row0 - 3 + j) * NPROJ + c0);
                win[j][0] = bflo(v.x); win[j][1] = bfhi(v.x); win[j][2] = bflo(v.y); win[j][3] = bfhi(v.y); win[j][4] = bflo(v.z); win[j][5] = bfhi(v.z); win[j][6] = bflo(v.w); win[j][7] = bfhi(v.w); }
        } else {
#pragma unroll
            for (int j = 0; j < 3; ++j) { const float* sp = state_in + ((size_t)seq * 3 + j) * NCH + c0; const f32x4 a = *(const f32x4*)sp, b = *(const f32x4*)(sp + 4);
#pragma unroll
                for (int e = 0; e < 4; ++e) { win[j][e] = a[e]; win[j][4 + e] = b[e]; } }
        }
        float wv[4][8], bv[8];
#pragma unroll
        for (int j = 0; j < 4; ++j) { const f32x4 a = *(const f32x4*)(w + j * NCH + c0), b = *(const f32x4*)(w + j * NCH + c0 + 4);
#pragma unroll
            for (int e = 0; e < 4; ++e) { wv[j][e] = a[e]; wv[j][4 + e] = b[e]; } }
        { const f32x4 a = *(const f32x4*)(bias + c0), b = *(const f32x4*)(bias + c0 + 4);
#pragma unroll
          for (int e = 0; e < 4; ++e) { bv[e] = a[e]; bv[4 + e] = b[e]; } }
#pragma unroll
        for (int i = 0; i < NT; ++i) {
            const v4u v = rows[i];
            const float cur[8] = {bflo(v.x), bfhi(v.x), bflo(v.y), bfhi(v.y), bflo(v.z), bfhi(v.z), bflo(v.w), bfhi(v.w)};
            float y[8];
#pragma unroll
            for (int e = 0; e < 8; ++e) { y[e] = silu(bv[e] + wv[0][e] * win[0][e] + wv[1][e] * win[1][e] + wv[2][e] * win[2][e] + wv[3][e] * cur[e]); win[0][e] = win[1][e]; win[1][e] = win[2][e]; win[2][e] = cur[e]; }
            v4u o; o.x = pk2(y[0], y[1]); o.y = pk2(y[2], y[3]); o.z = pk2(y[4], y[5]); o.w = pk2(y[6], y[7]);
            *(v4u*)(dst + (size_t)(row0 + i) * dst_ld + c0) = o;
        }
        if (!PROMPT || blk == NBLK - 1) { float* op = out_state + (size_t)seq * 3 * NCH + c0;
#pragma unroll
            for (int j = 0; j < 3; ++j) { *(f32x4*)(op + j * NCH) = (f32x4){win[j][0], win[j][1], win[j][2], win[j][3]}; *(f32x4*)(op + j * NCH + 4) = (f32x4){win[j][4], win[j][5], win[j][6], win[j][7]}; } }
    }
}
template <int W> __device__ __forceinline__ float scan_add(float v, int lane) {
#pragma unroll
    for (int o = 1; o < W; o <<= 1) { const float t = __shfl_up(v, o, W); if ((lane & (W - 1)) >= o) v += t; }
    return v;
}
template <int W> __device__ __forceinline__ float scan_max(float v, int lane) {
#pragma unroll
    for (int o = 1; o < W; o <<= 1) { const float t = __shfl_up(v, o, W); if ((lane & (W - 1)) >= o) v = fmaxf(v, t); }
    return v;
}
__device__ __forceinline__ void gate_scans(const Args& A, int gw, int NGW, int lane) {
    const float* GT = (const float*)(A.ws + WS_GATES);
    f32x4* MG = (f32x4*)(A.ws + WS_MG); f32x2* SG = (f32x2*)(A.ws + WS_SG); f32x2* CS = (f32x2*)(A.ws + WS_CS);
    for (int it = gw; it < 512; it += NGW) {
        if (it < 128) {
            const int seq = it >> 5, c = it & 31, row = seq * SEQ + c * 64 + lane;
            const f32x4 g0 = *(const f32x4*)(GT + (size_t)row * 256), g1 = *(const f32x4*)(GT + (size_t)row * 256 + 4), g2 = *(const f32x4*)(GT + (size_t)row * 256 + 8), g3 = *(const f32x4*)(GT + (size_t)row * 256 + 12);
            const float gi[8] = {g0[0], g0[1], g0[2], g0[3], g1[0], g1[1], g1[2], g1[3]}, gf[8] = {g2[0], g2[1], g2[2], g2[3], g3[0], g3[1], g3[2], g3[3]};
#pragma unroll
            for (int h = 0; h < 8; ++h) {
                const float ig = softcap(gi[h] + A.in[I_BIG][h]), lf = -softplus(-softcap(gf[h] + A.in[I_BFG][h]));
                const float bc = scan_add<64>(lf, lane), g = ig - bc, gmax = scan_max<64>(g, lane);
                MG[(size_t)row * 8 + h] = (f32x4){bc, g, gmax, 0.f};
                if (lane == 63) CS[(seq * 8 + h) * 32 + c] = (f32x2){bc, gmax};
            }
        } else if (it < 256) {
            const int seq = it - 128, h = (lane >> 2) & 7, t = lane & 3, row = MPR + seq * 4 + t;
            const float m = A.in[I_MM][seq * 8 + h];
            const float ig = softcap(GT[(size_t)row * 256 + h] + A.in[I_BIG][h]), lf = -softplus(-softcap(GT[(size_t)row * 256 + 8 + h] + A.in[I_BFG][h]));
            const float bc = scan_add<4>(lf, lane), g = ig - bc, gmax = scan_max<4>(g, lane);
            const float mm = fmaxf(m, gmax), alpha = -mm, a = __expf(m - mm), ex = __expf(alpha - bc);
            if (lane < 32) { MG[(size_t)row * 8 + h] = (f32x4){alpha, g, a, ex}; if (t == 3) A.out[O_SM + seq * 8 + h] = bc + mm; }
        } else if (it < 384) {
            const int q = it - 256, seq = q >> 5, c = q & 31, hd = lane, rowb = seq * SEQ + c * 64;
            const float dtb = A.in[I_DTB][hd], Aneg = -__expf(A.in[I_ALOG][hd]); float ac = 0.f;
            float gv[64];
#pragma unroll
            for (int t = 0; t < 64; ++t) { const float* rp = GT + (size_t)(rowb + t) * 256 + 16; gv[t] = rp[hd]; }
#pragma unroll
            for (int t = 0; t < 64; ++t) { const float dt = softplus(gv[t] + dtb); ac += dt * Aneg; SG[(size_t)(rowb + t) * 64 + hd] = (f32x2){dt, ac}; }
        } else {
            const int seq = it - 384, hd = lane; const float dtb = A.in[I_DTB][hd], Aneg = -__expf(A.in[I_ALOG][hd]); float ac = 0.f;
#pragma unroll
            for (int t = 0; t < 4; ++t) { const int row = MPR + seq * 4 + t; const float dt = softplus(GT[(size_t)row * 256 + 16 + hd] + dtb); ac += dt * Aneg; SG[(size_t)row * 64 + hd] = (f32x2){dt, ac}; }
        }
    }
}
__device__ __forceinline__ void mlstm_m_carry(const Args& A, int lane) {
    if (lane < 32) { const f32x2* CS = (const f32x2*)(A.ws + WS_CS); f32x2* MPD = (f32x2*)(A.ws + WS_MPD); float m = -INFINITY;
        for (int c = 0; c < 32; ++c) { const f32x2 cs = CS[lane * 32 + c]; const float mm = fmaxf(m, cs[1]); MPD[lane * 32 + c] = (f32x2){m, __expf(m - mm)}; m = cs[0] + mm; }
        A.out[O_PM + lane] = m; }
}

__device__ __forceinline__ bf16x8 as_bf16x8(v4u v) { return __builtin_bit_cast(bf16x8, v); }
__device__ __forceinline__ f32x4 mfma16(bf16x8 a, bf16x8 b, f32x4 c) { return __builtin_amdgcn_mfma_f32_16x16x32_bf16(a, b, c, 0, 0, 0); }
__device__ __forceinline__ v4u pack8(f32x4 a, f32x4 b) { v4u r; r.x = pk2(a[0], a[1]); r.y = pk2(a[2], a[3]); r.z = pk2(b[0], b[1]); r.w = pk2(b[2], b[3]); return r; }
__device__ __forceinline__ float sum8bf(v4u v) { return ((bflo(v.x) + bfhi(v.x)) + (bflo(v.y) + bfhi(v.y))) + ((bflo(v.z) + bfhi(v.z)) + (bflo(v.w) + bfhi(v.w))); }

constexpr int M1_Q = 0, M1_K = 33792, M1_VT = 70656, M1_P = 107520, M1_G = 116736;
__device__ __forceinline__ void m1_unit(const Args& A, LAS unsigned char* lds, int unit, int tid, int lane, int wave) {
    const int bh = unit >> 5, c = unit & 31, b = bh >> 3, h = bh & 7, row0 = b * SEQ + c * 64;
    LAS bf16* Qs = (LAS bf16*)(lds + M1_Q); LAS bf16* Ks = (LAS bf16*)(lds + M1_K); LAS bf16* Kw = Ks; LAS bf16* Vt = (LAS bf16*)(lds + M1_VT); LAS bf16* Ps = (LAS bf16*)(lds + M1_P);
    LAS float* aS = (LAS float*)(lds + M1_G); LAS float* gS = aS + 64; LAS float* wkS = aS + 128;
    const bf16* QK = (const bf16*)(A.ws + WS_QK); const bf16* PROJ = (const bf16*)(A.ws + WS_PROJ); const f32x4* MG = (const f32x4*)(A.ws + WS_MG); const f32x2* MPD = (const f32x2*)(A.ws + WS_MPD);
    bf16* NUMI = (bf16*)(A.ws + WS_NUMI); bf16* KWT = (bf16*)(A.ws + WS_KWT) + (size_t)unit * 16384; bf16* VTG = (bf16*)(A.ws + WS_VT) + (size_t)unit * 32768;
    float* KWS = (float*)(A.ws + WS_KWS); float* DENI = (float*)(A.ws + WS_DENI);
    const int l4 = lane >> 4, l15 = lane & 15;
    v4u vr0[4], vr1[4];
#pragma unroll
    for (int i = 0; i < 4; ++i) { const int piece = tid + NTHREADS * i, r = piece >> 5, cc = piece & 31;
        const bf16* sp = QK + (size_t)(row0 + r) * DM + h * 512 + cc * 8;
        const v4u q = *(const v4u*)sp, k = *(const v4u*)(sp + 256);
        { const int rv = piece & 63, cv = piece >> 6; const bf16* vp = PROJ + (size_t)(row0 + rv) * NPROJ + 4096 + h * 512 + cv * 8;
          vr0[i] = *(const v4u*)vp; vr1[i] = *(const v4u*)(vp + 256); }
        *(LAS v4u*)(Qs + r * 264 + cc * 8) = q; *(LAS v4u*)(Ks + r * 264 + cc * 8) = k; }
    if (tid < 64) { const f32x4 mg = MG[(size_t)(row0 + tid) * 8 + h]; const float mp = MPD[unit][0]; aS[tid] = -fmaxf(mp, mg[2]); gS[tid] = mg[1]; }
#define M1_VT_WRITE(vr) do { _Pragma("unroll") for (int i = 0; i < 4; ++i) { const int piece = tid + NTHREADS * i, r = piece & 63, cc = piece >> 6; const unsigned w_[4] = {vr[i].x, vr[i].y, vr[i].z, vr[i].w}; \
        _Pragma("unroll") for (int e = 0; e < 4; ++e) { Vt[(cc * 8 + 2 * e) * 72 + r] = (bf16)(w_[e] & 0xffffu); Vt[(cc * 8 + 2 * e + 1) * 72 + r] = (bf16)(w_[e] >> 16); } } } while (0)
    M1_VT_WRITE(vr0);
    __syncthreads();
    if (tid < 64) wkS[tid] = __expf(aS[63] + gS[tid]);
    { const int mt = wave >> 1;
#pragma unroll
      for (int e = 0; e < 2; ++e) { const int nt = (wave & 1) * 2 + e;
          const f32x4 acc = mma_nt<256>(Qs + mt * 16 * 264, 264, Ks + nt * 16 * 264, 264, (f32x4){0.f, 0.f, 0.f, 0.f}, lane);
#pragma unroll
          for (int i = 0; i < 4; ++i) { const int t = mt * 16 + 4 * l4 + i, s = nt * 16 + l15;
              const float p = (s <= t) ? acc[i] * __expf(aS[t] + gS[s]) : 0.f; Ps[t * 72 + s] = (bf16)f2bf(p); } } }
    unsigned kreg[4][4];
#pragma unroll
    for (int i = 0; i < 4; ++i) { const int pair = tid + NTHREADS * i, d = pair & 255, sg = pair >> 8;
#pragma unroll
        for (int e = 0; e < 4; ++e) kreg[i][e] = (unsigned)Ks[(sg * 8 + 2 * e) * 264 + d] | ((unsigned)Ks[(sg * 8 + 2 * e + 1) * 264 + d] << 16); }
    __syncthreads();
#pragma unroll
    for (int i = 0; i < 4; ++i) { const int pair = tid + NTHREADS * i, d = pair & 255, sg = pair >> 8; v4u w;
        w.x = pk2(bflo(kreg[i][0]) * wkS[sg * 8 + 0], bfhi(kreg[i][0]) * wkS[sg * 8 + 1]); w.y = pk2(bflo(kreg[i][1]) * wkS[sg * 8 + 2], bfhi(kreg[i][1]) * wkS[sg * 8 + 3]);
        w.z = pk2(bflo(kreg[i][2]) * wkS[sg * 8 + 4], bfhi(kreg[i][2]) * wkS[sg * 8 + 5]); w.w = pk2(bflo(kreg[i][3]) * wkS[sg * 8 + 6], bfhi(kreg[i][3]) * wkS[sg * 8 + 7]);
        *(LAS v4u*)(Kw + d * 72 + sg * 8) = w; }
    { const int t = tid >> 3, sg = tid & 7; float ps = sum8bf(*(const LAS v4u*)(Ps + t * 72 + sg * 8));
      ps += __shfl_xor(ps, 1); ps += __shfl_xor(ps, 2); ps += __shfl_xor(ps, 4);
      if (sg == 0) DENI[(size_t)(row0 + t) * 8 + h] = ps; }
    __syncthreads();
#define M1_NUMI(hf) do { const int tt = wave & 3, vbase = (wave >> 2) * 8; \
        _Pragma("unroll") for (int i = 0; i < 8; ++i) { const int vtile = vbase + i; \
            const f32x4 acc = mma_nt<64>(Vt + vtile * 16 * 72, 72, Ps + tt * 16 * 72, 72, (f32x4){0.f, 0.f, 0.f, 0.f}, lane); \
            v2u w_; w_.x = pk2(acc[0], acc[1]); w_.y = pk2(acc[2], acc[3]); \
            *(v2u*)(NUMI + (size_t)(row0 + tt * 16 + l15) * DM + h * 512 + (hf) * 256 + vtile * 16 + 4 * l4) = w_; } } while (0)
#define M1_VT_EXPORT(hf) do { _Pragma("unroll") for (int i = 0; i < 4; ++i) { const int pair = tid + NTHREADS * i, v = pair >> 3, sg = pair & 7; \
            *(v4u*)(VTG + (size_t)((hf) * 256 + v) * 64 + sg * 8) = *(const LAS v4u*)(Vt + v * 72 + sg * 8); } } while (0)
    M1_NUMI(0);
#pragma unroll
    for (int i = 0; i < 4; ++i) { const int pair = tid + NTHREADS * i, d = pair >> 3, sg = pair & 7; *(v4u*)(KWT + (size_t)d * 64 + sg * 8) = *(const LAS v4u*)(Kw + d * 72 + sg * 8); }
    if (tid < 256) { float s = 0.f;
#pragma unroll
        for (int i = 0; i < 8; ++i) s += sum8bf(*(const LAS v4u*)(Kw + tid * 72 + i * 8));
        KWS[(size_t)unit * 256 + tid] = s; }
    M1_VT_EXPORT(0);
    __syncthreads();
    M1_VT_WRITE(vr1);
    __syncthreads();
    M1_NUMI(1);
    M1_VT_EXPORT(1);
    __syncthreads();
#undef M1_VT_WRITE
#undef M1_NUMI
#undef M1_VT_EXPORT
}

constexpr int S1_C = 0, S1_B = 17408, S1_CB = 0, S1_BT = 34816, S1_XT = 53248, S1_DT = 126976, S1_AC = 129024;
__device__ __forceinline__ void s1_unit(const Args& A, LAS unsigned char* lds, int unit, int tid, int lane, int wave) {
    const int bg = unit >> 5, c = unit & 31, b = bg >> 3, g = bg & 7, row0 = b * SEQ + c * 64;
    LAS bf16* Cs = (LAS bf16*)(lds + S1_C); LAS bf16* Bs = (LAS bf16*)(lds + S1_B); LAS float* CBs = (LAS float*)(lds + S1_CB); LAS bf16* Bt = (LAS bf16*)(lds + S1_BT); LAS bf16* Xt = (LAS bf16*)(lds + S1_XT);
    LAS float* dtS = (LAS float*)(lds + S1_DT); LAS float* acS = (LAS float*)(lds + S1_AC);
    const bf16* XBC = (const bf16*)(A.ws + WS_XBC); const f32x2* SG = (const f32x2*)(A.ws + WS_SG);
    bf16* YI = (bf16*)(A.ws + WS_YI); bf16* BMT = (bf16*)(A.ws + WS_BMT) + (size_t)unit * 8192; bf16* XWT = (bf16*)(A.ws + WS_XWT);
    const int l4 = lane >> 4, l15 = lane & 15;
#pragma unroll
    for (int i = 0; i < 2; ++i) { const int piece = tid + NTHREADS * i, r = piece & 63, cc = piece >> 6;
        const bf16* sp = XBC + (size_t)(row0 + r) * 6144 + 4096 + g * 128 + cc * 8;
        const v4u bm = *(const v4u*)sp, cm = *(const v4u*)(sp + 1024);
        *(LAS v4u*)(Cs + r * 136 + cc * 8) = cm; *(LAS v4u*)(Bs + r * 136 + cc * 8) = bm;
        const unsigned w[4] = {bm.x, bm.y, bm.z, bm.w};
#pragma unroll
        for (int e = 0; e < 4; ++e) { Bt[(cc * 8 + 2 * e) * 72 + r] = (bf16)(w[e] & 0xffffu); Bt[(cc * 8 + 2 * e + 1) * 72 + r] = (bf16)(w[e] >> 16); } }
#pragma unroll
    for (int i = 0; i < 8; ++i) { const int piece = tid + NTHREADS * i, r = piece & 63, cc = piece >> 6;
        const v4u xv = *(const v4u*)(XBC + (size_t)(row0 + r) * 6144 + g * 512 + cc * 8); const unsigned w[4] = {xv.x, xv.y, xv.z, xv.w};
#pragma unroll
        for (int e = 0; e < 4; ++e) { Xt[(cc * 8 + 2 * e) * 72 + r] = (bf16)(w[e] & 0xffffu); Xt[(cc * 8 + 2 * e + 1) * 72 + r] = (bf16)(w[e] >> 16); } }
    { const int hh = tid >> 6, t = tid & 63; const f32x2 sg = SG[(size_t)(row0 + t) * 64 + g * 8 + hh]; dtS[hh * 64 + t] = sg[0]; acS[hh * 64 + t] = sg[1]; }
    __syncthreads();
    f32x4 cb[2];
    { const int mt = wave >> 1;
#pragma unroll
      for (int e = 0; e < 2; ++e) { const int nt = (wave & 1) * 2 + e; cb[e] = mma_nt<128>(Cs + mt * 16 * 136, 136, Bs + nt * 16 * 136, 136, (f32x4){0.f, 0.f, 0.f, 0.f}, lane); } }
    __syncthreads();
    { const int mt = wave >> 1;
#pragma unroll
      for (int e = 0; e < 2; ++e) { const int nt = (wave & 1) * 2 + e;
#pragma unroll
          for (int i = 0; i < 4; ++i) CBs[(mt * 16 + 4 * l4 + i) * 68 + nt * 16 + l15] = cb[e][i]; } }
#pragma unroll
    for (int i = 0; i < 2; ++i) { const int pair = tid + NTHREADS * i, n = pair >> 3, sg = pair & 7; *(v4u*)(BMT + (size_t)n * 64 + sg * 8) = *(const LAS v4u*)(Bt + n * 72 + sg * 8); }
    __syncthreads();
    { const int hh = wave, head = g * 8 + hh; const float a_end = acS[hh * 64 + 63];
      bf16* xw = XWT + (size_t)((b * 64 + head) * 32 + c) * 4096;
#pragma unroll
      for (int i = 0; i < 8; ++i) { const int piece = lane + 64 * i, p = piece >> 3, sg = piece & 7; const v4u xv = *(const LAS v4u*)(Xt + (hh * 64 + p) * 72 + sg * 8);
          float wg[8];
#pragma unroll
          for (int e = 0; e < 8; ++e) wg[e] = dtS[hh * 64 + sg * 8 + e] * __expf(a_end - acS[hh * 64 + sg * 8 + e]);
          v4u o; o.x = pk2(bflo(xv.x) * wg[0], bfhi(xv.x) * wg[1]); o.y = pk2(bflo(xv.y) * wg[2], bfhi(xv.y) * wg[3]); o.z = pk2(bflo(xv.z) * wg[4], bfhi(xv.z) * wg[5]); o.w = pk2(bflo(xv.w) * wg[6], bfhi(xv.w) * wg[7]);
          *(v4u*)(xw + (size_t)p * 64 + sg * 8) = o; }
#pragma unroll
      for (int tt = 0; tt < 4; ++tt) { const int t = tt * 16 + l15; const float act = acS[hh * 64 + t];
          bf16x8 Y[2];
#pragma unroll
          for (int ks = 0; ks < 2; ++ks) { const int s0 = 32 * ks + 8 * l4; const f32x4 c0 = *(const LAS f32x4*)(CBs + t * 68 + s0), c1 = *(const LAS f32x4*)(CBs + t * 68 + s0 + 4); float gv[8];
#pragma unroll
              for (int e = 0; e < 8; ++e) { const int s = s0 + e; const float cbv = e < 4 ? c0[e & 3] : c1[e & 3]; gv[e] = (s <= t) ? cbv * __expf(act - acS[hh * 64 + s]) * dtS[hh * 64 + s] : 0.f; }
              v4u yv; yv.x = pk2(gv[0], gv[1]); yv.y = pk2(gv[2], gv[3]); yv.z = pk2(gv[4], gv[5]); yv.w = pk2(gv[6], gv[7]); Y[ks] = as_bf16x8(yv); }
#pragma unroll
          for (int pt = 0; pt < 4; ++pt) { f32x4 acc = (f32x4){0.f, 0.f, 0.f, 0.f};
#pragma unroll
              for (int ks = 0; ks < 2; ++ks) acc = mfma16(*(const LAS bf16x8*)(Xt + (hh * 64 + pt * 16 + l15) * 72 + 32 * ks + 8 * l4), Y[ks], acc);
              v2u w; w.x = pk2(acc[0], acc[1]); w.y = pk2(acc[2], acc[3]);
              *(v2u*)(YI + (size_t)(row0 + t) * DM + head * 64 + pt * 16 + 4 * l4) = w; } } }
    __syncthreads();
}

__device__ __forceinline__ void nscan_item(const Args& A, int bh, int tid) {
    if (tid < 256) { const float* KWS = (const float*)(A.ws + WS_KWS); const f32x2* MPD = (const f32x2*)(A.ws + WS_MPD); float* NALL = (float*)(A.ws + WS_NALL);
        float kw[32], dc[32];
#pragma unroll
        for (int c = 0; c < 32; ++c) { kw[c] = KWS[(size_t)(bh * 32 + c) * 256 + tid]; dc[c] = MPD[bh * 32 + c][1]; }
        float n = 0.f;
#pragma unroll
        for (int c = 0; c < 32; ++c) { NALL[(size_t)(bh * 32 + c) * 256 + tid] = n; n = dc[c] * n + kw[c]; }
        A.out[O_PN + bh * 256 + tid] = n; }
}

constexpr int M2_Q = 0, M2_KW = 33792, M2_VT = 70656;
__device__ __forceinline__ void m2_item(const Args& A, LAS unsigned char* lds, int item, int tid, int lane, int wave) {
    const int bh = item >> 2, j = item & 3, b = bh >> 3, h = bh & 7;
    LAS bf16* Qs = (LAS bf16*)(lds + M2_Q); LAS bf16* Kw = (LAS bf16*)(lds + M2_KW); LAS bf16* Vt = (LAS bf16*)(lds + M2_VT);
    const bf16* QK = (const bf16*)(A.ws + WS_QK); const bf16* KWT = (const bf16*)(A.ws + WS_KWT); const bf16* VTG = (const bf16*)(A.ws + WS_VT); const f32x2* MPD = (const f32x2*)(A.ws + WS_MPD);
    bf16* INTER = (bf16*)(A.ws + WS_INTER);
    const int l4 = lane >> 4, l15 = lane & 15;
    f32x4 acc[16];
#pragma unroll
    for (int i = 0; i < 16; ++i) acc[i] = (f32x4){0.f, 0.f, 0.f, 0.f};
    v4u rq[4], rk[4], rv[2]; float dnext;
#define M2_LOAD(cc_) do { const int r0_ = b * SEQ + (cc_) * 64; const size_t un_ = (size_t)(bh * 32 + (cc_)); \
        _Pragma("unroll") for (int i = 0; i < 4; ++i) { const int piece = tid + NTHREADS * i; rq[i] = *(const v4u*)(QK + (size_t)(r0_ + (piece >> 5)) * DM + h * 512 + (piece & 31) * 8); rk[i] = *(const v4u*)(KWT + un_ * 16384 + (size_t)piece * 8); } \
        _Pragma("unroll") for (int i = 0; i < 2; ++i) { const int piece = tid + NTHREADS * i; rv[i] = *(const v4u*)(VTG + un_ * 32768 + (size_t)(j * 128) * 64 + (size_t)piece * 8); } \
        dnext = MPD[un_][1]; } while (0)
    M2_LOAD(0);
    for (int c = 0; c < 32; ++c) {
        const int row0 = b * SEQ + c * 64;
#pragma unroll
        for (int i = 0; i < 4; ++i) { const int piece = tid + NTHREADS * i; *(LAS v4u*)(Qs + (piece >> 5) * 264 + (piece & 31) * 8) = rq[i]; *(LAS v4u*)(Kw + (piece >> 3) * 72 + (piece & 7) * 8) = rk[i]; }
#pragma unroll
        for (int i = 0; i < 2; ++i) { const int piece = tid + NTHREADS * i; *(LAS v4u*)(Vt + (piece >> 3) * 72 + (piece & 7) * 8) = rv[i]; }
        const float decay = dnext;
        if (c < 31) M2_LOAD(c + 1);
        __syncthreads();
        f32x4 ia[4];
#pragma unroll
        for (int tt = 0; tt < 4; ++tt) ia[tt] = (f32x4){0.f, 0.f, 0.f, 0.f};
#pragma unroll
        for (int ks = 0; ks < 8; ++ks) { const bf16x8 X = as_bf16x8(pack8(acc[2 * ks], acc[2 * ks + 1]));
#pragma unroll
            for (int tt = 0; tt < 4; ++tt) { const LAS bf16* qp = Qs + (tt * 16 + l15) * 264 + 32 * ks + 4 * l4; const v2u y0 = *(const LAS v2u*)qp, y1 = *(const LAS v2u*)(qp + 16);
                ia[tt] = mfma16(X, as_bf16x8((v4u){y0.x, y0.y, y1.x, y1.y}), ia[tt]); } }
#pragma unroll
        for (int tt = 0; tt < 4; ++tt) { v2u w; w.x = pk2(ia[tt][0], ia[tt][1]); w.y = pk2(ia[tt][2], ia[tt][3]);
            *(v2u*)(INTER + (size_t)(row0 + tt * 16 + l15) * DM + h * 512 + j * 128 + wave * 16 + 4 * l4) = w; }
        bf16x8 yv[2];
#pragma unroll
        for (int ks = 0; ks < 2; ++ks) yv[ks] = *(const LAS bf16x8*)(Vt + (wave * 16 + l15) * 72 + ks * 32 + l4 * 8);
#pragma unroll
        for (int dt = 0; dt < 16; ++dt) { acc[dt] = acc[dt] * decay;
#pragma unroll
            for (int ks = 0; ks < 2; ++ks) acc[dt] = mfma16(*(const LAS bf16x8*)(Kw + (dt * 16 + l15) * 72 + ks * 32 + l4 * 8), yv[ks], acc[dt]); }
        __syncthreads();
    }
#undef M2_LOAD
    float* pC = A.out + O_PC + (size_t)(bh * 256) * 512 + j * 128 + wave * 16 + l15;
#pragma unroll
    for (int dt = 0; dt < 16; ++dt)
#pragma unroll
        for (int i = 0; i < 4; ++i) pC[(size_t)(dt * 16 + 4 * l4 + i) * 512] = acc[dt][i];
}

constexpr int S2_C = 0, S2_BT = 17408, S2_XW = 35840;
__device__ __forceinline__ void s2_item(const Args& A, LAS unsigned char* lds, int item, int tid, int lane, int wave) {
    const int b = item >> 5, pair = item & 31, hsel = wave >> 2, head = pair * 2 + hsel, g = pair >> 2, pt = wave & 3;
    LAS bf16* Cs = (LAS bf16*)(lds + S2_C); LAS bf16* Bt = (LAS bf16*)(lds + S2_BT); LAS bf16* Xw = (LAS bf16*)(lds + S2_XW);
    const bf16* XBC = (const bf16*)(A.ws + WS_XBC); const bf16* BMT = (const bf16*)(A.ws + WS_BMT); const bf16* XWT = (const bf16*)(A.ws + WS_XWT); const f32x2* SG = (const f32x2*)(A.ws + WS_SG);
    bf16* YS = (bf16*)(A.ws + WS_YS);
    const int l4 = lane >> 4, l15 = lane & 15;
    f32x4 acc[8];
#pragma unroll
    for (int i = 0; i < 8; ++i) acc[i] = (f32x4){0.f, 0.f, 0.f, 0.f};
    v4u rc[2], rb[2], rx[2]; float enext;
#define S2_LOAD(cc_) do { const int r0_ = b * SEQ + (cc_) * 64; \
        _Pragma("unroll") for (int i = 0; i < 2; ++i) { const int piece = tid + NTHREADS * i; rc[i] = *(const v4u*)(XBC + (size_t)(r0_ + (piece >> 4)) * 6144 + 5120 + g * 128 + (piece & 15) * 8); \
            rb[i] = *(const v4u*)(BMT + (size_t)((b * 8 + g) * 32 + (cc_)) * 8192 + (size_t)piece * 8); \
            rx[i] = *(const v4u*)(XWT + (size_t)((b * 64 + pair * 2 + (piece >> 9)) * 32 + (cc_)) * 4096 + (size_t)(piece & 511) * 8); } \
        enext = __expf(SG[(size_t)(r0_ + 63) * 64 + head][1]); } while (0)
    S2_LOAD(0);
    for (int c = 0; c < 32; ++c) {
        const int row0 = b * SEQ + c * 64;
#pragma unroll
        for (int i = 0; i < 2; ++i) { const int piece = tid + NTHREADS * i; *(LAS v4u*)(Cs + (piece >> 4) * 136 + (piece & 15) * 8) = rc[i]; *(LAS v4u*)(Bt + (piece >> 3) * 72 + (piece & 7) * 8) = rb[i]; *(LAS v4u*)(Xw + (piece >> 3) * 72 + (piece & 7) * 8) = rx[i]; }
        const float ea = enext;
        if (c < 31) S2_LOAD(c + 1);
        __syncthreads();
        f32x4 ia[4];
#pragma unroll
        for (int tt = 0; tt < 4; ++tt) ia[tt] = (f32x4){0.f, 0.f, 0.f, 0.f};
#pragma unroll
        for (int ks = 0; ks < 4; ++ks) { const bf16x8 X = as_bf16x8(pack8(acc[2 * ks], acc[2 * ks + 1]));
#pragma unroll
            for (int tt = 0; tt < 4; ++tt) { const LAS bf16* cp = Cs + (tt * 16 + l15) * 136 + 32 * ks + 4 * l4; const v2u y0 = *(const LAS v2u*)cp, y1 = *(const LAS v2u*)(cp + 16);
                ia[tt] = mfma16(X, as_bf16x8((v4u){y0.x, y0.y, y1.x, y1.y}), ia[tt]); } }
#pragma unroll
        for (int tt = 0; tt < 4; ++tt) { v2u w; w.x = pk2(ia[tt][0], ia[tt][1]); w.y = pk2(ia[tt][2], ia[tt][3]);
            *(v2u*)(YS + (size_t)(row0 + tt * 16 + l15) * DM + head * 64 + pt * 16 + 4 * l4) = w; }
        bf16x8 yv[2];
#pragma unroll
        for (int ks = 0; ks < 2; ++ks) yv[ks] = *(const LAS bf16x8*)(Xw + (hsel * 64 + pt * 16 + l15) * 72 + ks * 32 + l4 * 8);
#pragma unroll
        for (int nt = 0; nt < 8; ++nt) { acc[nt] = acc[nt] * ea;
#pragma unroll
            for (int ks = 0; ks < 2; ++ks) acc[nt] = mfma16(*(const LAS bf16x8*)(Bt + (nt * 16 + l15) * 72 + ks * 32 + l4 * 8), yv[ks], acc[nt]); }
        __syncthreads();
    }
#undef S2_LOAD
    float* pH = A.out + O_PSSM + (size_t)((b * 64 + head) * 64 + pt * 16 + l15) * 128 + 4 * l4;
#pragma unroll
    for (int nt = 0; nt < 8; ++nt) *(f32x4*)(pH + nt * 16) = acc[nt];
}

__device__ __forceinline__ void m3_pass(const Args& A, int gw, int NGW, int lane) {
    const bf16* NUMI = (const bf16*)(A.ws + WS_NUMI); const bf16* INTER = (const bf16*)(A.ws + WS_INTER); const bf16* PROJ = (const bf16*)(A.ws + WS_PROJ); const bf16* QK = (const bf16*)(A.ws + WS_QK);
    const f32x4* MG = (const f32x4*)(A.ws + WS_MG); const f32x2* MPD = (const f32x2*)(A.ws + WS_MPD); const float* NALL = (const float*)(A.ws + WS_NALL); const float* DENI = (const float*)(A.ws + WS_DENI);
    bf16* MIX = (bf16*)(A.ws + WS_MIX); const float* mnorm = A.in[I_MNORM];
    for (int it = gw; it < MPR * 8; it += NGW) {
        const int row = it >> 3, h = it & 7, b = row >> 11, c = (row >> 6) & 31, unit = (b * 8 + h) * 32 + c, col = h * 512 + lane * 8;
        const v4u ni = *(const v4u*)(NUMI + (size_t)row * DM + col), iw = *(const v4u*)(INTER + (size_t)row * DM + col);
        const v4u ow = *(const v4u*)(PROJ + (size_t)row * NPROJ + 8192 + col), zw = *(const v4u*)(PROJ + (size_t)row * NPROJ + 12288 + col);
        const v2u qw = *(const v2u*)(QK + (size_t)row * DM + h * 512 + lane * 4); const f32x4 n4 = *(const f32x4*)(NALL + (size_t)unit * 256 + lane * 4);
        const f32x4 mg = MG[(size_t)row * 8 + h]; const float mp = MPD[unit][0]; const float deni = DENI[(size_t)row * 8 + h];
        const f32x4 mn0 = *(const f32x4*)(mnorm + col), mn1 = *(const f32x4*)(mnorm + col + 4);
        const float mm = fmaxf(mp, mg[2]), a = __expf(mp - mm), ex = __expf(-mm - mg[0]);
        const float qn = wave_sum((bflo(qw.x) * n4[0] + bfhi(qw.x) * n4[1]) + (bflo(qw.y) * n4[2] + bfhi(qw.y) * n4[3]));
        const float dn = fmaxf(fabsf(deni + a * qn), ex), rdn = 1.f / dn;
        const float nv[8] = {bflo(ni.x), bfhi(ni.x), bflo(ni.y), bfhi(ni.y), bflo(ni.z), bfhi(ni.z), bflo(ni.w), bfhi(ni.w)};
        const float iv[8] = {bflo(iw.x), bfhi(iw.x), bflo(iw.y), bfhi(iw.y), bflo(iw.z), bfhi(iw.z), bflo(iw.w), bfhi(iw.w)};
        const float ov[8] = {bflo(ow.x), bfhi(ow.x), bflo(ow.y), bfhi(ow.y), bflo(ow.z), bfhi(ow.z), bflo(ow.w), bfhi(ow.w)};
        const float zv[8] = {bflo(zw.x), bfhi(zw.x), bflo(zw.y), bfhi(zw.y), bflo(zw.z), bfhi(zw.z), bflo(zw.w), bfhi(zw.w)};
        const float mn[8] = {mn0[0], mn0[1], mn0[2], mn0[3], mn1[0], mn1[1], mn1[2], mn1[3]};
        float pre[8], ss = 0.f;
#pragma unroll
        for (int e = 0; e < 8; ++e) { pre[e] = (nv[e] + a * iv[e]) * rdn * sigm(ov[e]); ss += pre[e] * pre[e]; }
        const float rstd = rsqrtf(wave_sum(ss) * (1.f / 512.f) + EPS);
        float val[8];
#pragma unroll
        for (int e = 0; e < 8; ++e) val[e] = pre[e] * rstd * mn[e] * silu(zv[e]);
        v4u o; o.x = pk2(val[0], val[1]); o.y = pk2(val[2], val[3]); o.z = pk2(val[4], val[5]); o.w = pk2(val[6], val[7]);
        *(v4u*)(MIX + (size_t)row * LDM + col) = o;
    }
}
__device__ __forceinline__ void s3_pass(const Args& A, int gw, int NGW, int lane) {
    const bf16* YI = (const bf16*)(A.ws + WS_YI); const bf16* YS = (const bf16*)(A.ws + WS_YS); const bf16* PROJ = (const bf16*)(A.ws + WS_PROJ); const bf16* XBC = (const bf16*)(A.ws + WS_XBC);
    const f32x2* SG = (const f32x2*)(A.ws + WS_SG); bf16* MIX = (bf16*)(A.ws + WS_MIX); const float* snorm = A.in[I_SNORM];
    for (int it = gw; it < MPR * 8; it += NGW) {
        const int row = it >> 3, g = it & 7, col = g * 512 + lane * 8, head = g * 8 + (lane >> 3);
        const v4u yi = *(const v4u*)(YI + (size_t)row * DM + col), ys = *(const v4u*)(YS + (size_t)row * DM + col);
        const v4u xw = *(const v4u*)(XBC + (size_t)row * 6144 + col), zw = *(const v4u*)(PROJ + (size_t)row * NPROJ + 16384 + col);
        const f32x2 sg = SG[(size_t)row * 64 + head]; const float eac = __expf(sg[1]), dsk = A.in[I_DSKIP][head];
        const f32x4 sn0 = *(const f32x4*)(snorm + col), sn1 = *(const f32x4*)(snorm + col + 4);
        const float a1[8] = {bflo(yi.x), bfhi(yi.x), bflo(yi.y), bfhi(yi.y), bflo(yi.z), bfhi(yi.z), bflo(yi.w), bfhi(yi.w)};
        const float a2[8] = {bflo(ys.x), bfhi(ys.x), bflo(ys.y), bfhi(ys.y), bflo(ys.z), bfhi(ys.z), bflo(ys.w), bfhi(ys.w)};
        const float xv[8] = {bflo(xw.x), bfhi(xw.x), bflo(xw.y), bfhi(xw.y), bflo(xw.z), bfhi(xw.z), bflo(xw.w), bfhi(xw.w)};
        const float zv[8] = {bflo(zw.x), bfhi(zw.x), bflo(zw.y), bfhi(zw.y), bflo(zw.z), bfhi(zw.z), bflo(zw.w), bfhi(zw.w)};
        const float sn[8] = {sn0[0], sn0[1], sn0[2], sn0[3], sn1[0], sn1[1], sn1[2], sn1[3]};
        float pre[8], ss = 0.f;
#pragma unroll
        for (int e = 0; e < 8; ++e) { pre[e] = (a1[e] + eac * a2[e] + dsk * xv[e]) * silu(zv[e]); ss += pre[e] * pre[e]; }
        const float rstd = rsqrtf(wave_sum(ss) * (1.f / 512.f) + EPS);
        v4u o; o.x = pk2(pre[0] * rstd * sn[0], pre[1] * rstd * sn[1]); o.y = pk2(pre[2] * rstd * sn[2], pre[3] * rstd * sn[3]); o.z = pk2(pre[4] * rstd * sn[4], pre[5] * rstd * sn[5]); o.w = pk2(pre[6] * rstd * sn[6], pre[7] * rstd * sn[7]);
        *(v4u*)(MIX + (size_t)row * LDM + 4096 + col) = o;
    }
}


__device__ __forceinline__ void mlstm_sample_item(const Args& A, LAS unsigned char* lds, int item, int tid, int lane, int wave) {
    const int seq = item >> 3, h = item & 7;
    LAS float* qT = (LAS float*)lds; LAS float* kT = qT + 1024; LAS float* kwT = qT + 2048; LAS float* vS = qT + 3072; LAS float* n0S = qT + 5120; LAS float* gt = qT + 5376;
    LAS float* SSd = qT + 5408; LAS float* PSd = qT + 5440; LAS float* denS = qT + 5472; LAS float* wkS = qT + 5480; LAS float* ssS = qT + 5488; LAS float* accl = qT + 6144;
    const bf16* QK = (const bf16*)(A.ws + WS_QK); const bf16* PROJ = (const bf16*)(A.ws + WS_PROJ); const float* MG = (const float*)(A.ws + WS_MG);
    bf16* MIX = (bf16*)(A.ws + WS_MIX); const float* mnorm = A.in[I_MNORM];
    const int rowb = MPR + seq * 4;
    { const int idx = tid * 2, t = idx >> 8, d = idx & 255; const bf16* sp = QK + (size_t)(rowb + t) * DM + h * 512 + d;
      const unsigned qw = *(const unsigned*)sp, kw = *(const unsigned*)(sp + 256);
      qT[d * 4 + t] = bflo(qw); qT[(d + 1) * 4 + t] = bfhi(qw); kT[d * 4 + t] = bflo(kw); kT[(d + 1) * 4 + t] = bfhi(kw); }
    { const int idx = tid * 4, t = idx >> 9, v = idx & 511; const v2u vw = *(const v2u*)(PROJ + (size_t)(rowb + t) * NPROJ + 4096 + h * 512 + v);
      *(LAS f32x4*)(vS + t * 512 + v) = (f32x4){bflo(vw.x), bfhi(vw.x), bflo(vw.y), bfhi(vw.y)}; }
    if (tid < 256) n0S[tid] = A.in[I_MN][(size_t)(seq * 8 + h) * 256 + tid];
    if (tid < 16) { const int comp = tid >> 2, t = tid & 3; gt[comp * 4 + t] = MG[((size_t)(rowb + t) * 8 + h) * 4 + comp]; }
    __syncthreads();
    for (int pp = wave; pp < 20; pp += NWAVES) { float part = 0.f;
        if (pp < 16) { const int t = pp >> 2, s = pp & 3;
#pragma unroll
            for (int i = 0; i < 4; ++i) part += qT[(lane + 64 * i) * 4 + t] * kT[(lane + 64 * i) * 4 + s]; }
        else { const int t = pp - 16;
#pragma unroll
            for (int i = 0; i < 4; ++i) part += qT[(lane + 64 * i) * 4 + t] * n0S[lane + 64 * i]; }
        part = wave_sum(part); if (lane == 0) SSd[pp] = part; }
    __syncthreads();
    if (tid < 16) { const int t = tid >> 2, s = tid & 3; PSd[tid] = (s <= t) ? SSd[tid] * __expf(gt[t] + gt[4 + s]) : 0.f; }
    if (tid >= 64 && tid < 68) { const int s = tid - 64; wkS[s] = __expf(gt[3] + gt[4 + s]); }
    __syncthreads();
    if (tid < 4) denS[tid] = (PSd[tid * 4] + PSd[tid * 4 + 1]) + (PSd[tid * 4 + 2] + PSd[tid * 4 + 3]) + gt[8 + tid] * SSd[16 + tid];
    { const int i0 = tid * 2; kwT[i0] = kT[i0] * wkS[i0 & 3]; kwT[i0 + 1] = kT[i0 + 1] * wkS[(i0 + 1) & 3]; }
    __syncthreads();
    const float decay = gt[8 + 3];
    const int dr = wave >> 1, v4 = (tid & 127) * 4;
    f32x4 vv[4], acc[4];
#pragma unroll
    for (int s = 0; s < 4; ++s) { vv[s] = *(const LAS f32x4*)(vS + s * 512 + v4); acc[s] = (f32x4){0.f, 0.f, 0.f, 0.f}; }
    const float* C0 = A.in[I_MC] + (size_t)((seq * 8 + h) * 256 + dr) * 512; float* C1 = A.out + O_SC + (size_t)((seq * 8 + h) * 256 + dr) * 512;
    f32x4 cbuf[2][8];
#pragma unroll
    for (int r = 0; r < 8; ++r) { const float* rp = C0 + (size_t)(4 * r) * 512; cbuf[0][r] = __builtin_nontemporal_load((const f32x4*)(rp + v4)); }
#pragma unroll
    for (int bt = 0; bt < 8; ++bt) {
        if (bt < 7) {
#pragma unroll
            for (int r = 0; r < 8; ++r) { const float* rp = C0 + (size_t)(4 * ((bt + 1) * 8 + r)) * 512; cbuf[(bt + 1) & 1][r] = __builtin_nontemporal_load((const f32x4*)(rp + v4)); } }
#pragma unroll
        for (int r = 0; r < 8; ++r) { const int d = dr + 4 * (bt * 8 + r); const f32x4 c0 = cbuf[bt & 1][r];
            const f32x4 q4 = *(const LAS f32x4*)(qT + d * 4), kw4 = *(const LAS f32x4*)(kwT + d * 4);
#pragma unroll
            for (int t = 0; t < 4; ++t) acc[t] += q4[t] * c0;
            const f32x4 cn = decay * c0 + kw4[0] * vv[0] + kw4[1] * vv[1] + kw4[2] * vv[2] + kw4[3] * vv[3];
            { float* wp = C1 + (size_t)(4 * (bt * 8 + r)) * 512; __builtin_nontemporal_store(cn, (f32x4*)(wp + v4)); } } }
#pragma unroll
    for (int t = 0; t < 4; ++t) *(LAS f32x4*)(accl + (dr * 4 + t) * 512 + v4) = acc[t];
    __syncthreads();
    float val[4];
    { const int t = dr; f32x4 a = (f32x4){0.f, 0.f, 0.f, 0.f};
#pragma unroll
      for (int r = 0; r < 4; ++r) a += *(const LAS f32x4*)(accl + (r * 4 + t) * 512 + v4);
      f32x4 num = gt[8 + t] * a;
#pragma unroll
      for (int s = 0; s < 4; ++s) num += PSd[t * 4 + s] * vv[s];
      const float dn = fmaxf(fabsf(denS[t]), gt[12 + t]); const int row = rowb + t, col = h * 512 + v4;
      const v2u ow = *(const v2u*)(PROJ + (size_t)row * NPROJ + 8192 + col), zw = *(const v2u*)(PROJ + (size_t)row * NPROJ + 12288 + col);
      const f32x4 o4 = (f32x4){bflo(ow.x), bfhi(ow.x), bflo(ow.y), bfhi(ow.y)}, z4 = (f32x4){bflo(zw.x), bfhi(zw.x), bflo(zw.y), bfhi(zw.y)}; const f32x4 mn = *(const f32x4*)(mnorm + col);
      f32x4 pre; float ss = 0.f;
#pragma unroll
      for (int e = 0; e < 4; ++e) { pre[e] = (num[e] / dn) * sigm(o4[e]); ss += pre[e] * pre[e]; val[e] = pre[e] * mn[e] * silu(z4[e]); }
      ss = wave_sum(ss); if (lane == 0) ssS[wave] = ss; }
    __syncthreads();
    { const float rstd = rsqrtf((ssS[2 * dr] + ssS[2 * dr + 1]) * (1.f / 512.f) + EPS);
      v2u w; w.x = pk2(val[0] * rstd, val[1] * rstd); w.y = pk2(val[2] * rstd, val[3] * rstd); *(v2u*)(MIX + (size_t)(rowb + dr) * LDM + h * 512 + v4) = w; }
    if (tid < 256) { const f32x4 kw = *(const LAS f32x4*)(kwT + tid * 4); A.out[O_SN + (size_t)(seq * 8 + h) * 256 + tid] = decay * n0S[tid] + ((kw[0] + kw[1]) + (kw[2] + kw[3])); }
    __syncthreads();
}

__device__ __forceinline__ void ssd_sample_item(const Args& A, LAS unsigned char* lds, int item, int tid, int lane, int wave) {
    const int seq = item >> 3, gi = item & 7, hd = gi * 8 + wave;
    LAS float* Cf = (LAS float*)lds; LAS float* Bf = Cf + 512; LAS float* xf = Cf + 1024; LAS float* dtS = Cf + 3072; LAS float* acS = Cf + 3104; LAS float* CBs = Cf + 3136;
    LAS float* xw = Cf + 3200; LAS float* yp = Cf + 5248; LAS float* ssS = Cf + 7296;
    const bf16* XBC = (const bf16*)(A.ws + WS_XBC); const bf16* PROJ = (const bf16*)(A.ws + WS_PROJ); const f32x2* SG = (const f32x2*)(A.ws + WS_SG);
    bf16* MIX = (bf16*)(A.ws + WS_MIX); const float* snorm = A.in[I_SNORM];
    const int rowb = MPR + seq * 4;
    { const int t = tid >> 7, n = tid & 127; const bf16* sp = XBC + (size_t)(rowb + t) * 6144 + 4096 + gi * 128 + n; Bf[t * 128 + n] = bf2f(sp[0]); Cf[t * 128 + n] = bf2f(sp[1024]); }
    { const int idx = tid * 4, t = idx >> 9, cidx = idx & 511; const v2u xv = *(const v2u*)(XBC + (size_t)(rowb + t) * 6144 + gi * 512 + cidx);
      *(LAS f32x4*)(xf + t * 512 + cidx) = (f32x4){bflo(xv.x), bfhi(xv.x), bflo(xv.y), bfhi(xv.y)}; }
    if (tid < 32) { const int hh = tid >> 2, t = tid & 3; const f32x2 sg = SG[(size_t)(rowb + t) * 64 + gi * 8 + hh]; dtS[hh * 4 + t] = sg[0]; acS[hh * 4 + t] = sg[1]; }
    __syncthreads();
#pragma unroll
    for (int e = 0; e < 2; ++e) { const int pp = wave * 2 + e, t = pp >> 2, s = pp & 3;
        float part = Cf[t * 128 + lane] * Bf[s * 128 + lane] + Cf[t * 128 + 64 + lane] * Bf[s * 128 + 64 + lane];
        part = wave_sum(part); if (lane == 0) CBs[pp] = part; }
#pragma unroll
    for (int i = 0; i < 4; ++i) { const int idx = tid + NTHREADS * i, hh = idx >> 8, p = (idx >> 2) & 63, s = idx & 3;
        xw[idx] = xf[s * 512 + hh * 64 + p] * dtS[hh * 4 + s] * __expf(acS[hh * 4 + 3] - acS[hh * 4 + s]); }
    __syncthreads();
    { const int n4 = (lane & 31) * 4, half = lane >> 5; f32x4 c4[4], b4[4];
#pragma unroll
      for (int t = 0; t < 4; ++t) { c4[t] = *(const LAS f32x4*)(Cf + t * 128 + n4); b4[t] = *(const LAS f32x4*)(Bf + t * 128 + n4); }
      const float ea = __expf(acS[wave * 4 + 3]);
      const float* H0 = A.in[I_SSSM] + (size_t)((seq * 64 + hd) * 64) * 128; float* H1 = A.out + O_SSSM + (size_t)((seq * 64 + hd) * 64) * 128; const int hoff = half * 128 + n4;
      f32x4 hbuf[2][8];
#pragma unroll
      for (int r = 0; r < 8; ++r) { const float* rp = H0 + (size_t)(2 * r) * 128; hbuf[0][r] = __builtin_nontemporal_load((const f32x4*)(rp + hoff)); }
#pragma unroll
      for (int bt = 0; bt < 4; ++bt) {
          if (bt < 3) {
#pragma unroll
              for (int r = 0; r < 8; ++r) { const float* rp = H0 + (size_t)(2 * ((bt + 1) * 8 + r)) * 128; hbuf[(bt + 1) & 1][r] = __builtin_nontemporal_load((const f32x4*)(rp + hoff)); } }
#pragma unroll
          for (int r = 0; r < 8; ++r) { const int p = half + 2 * (bt * 8 + r); const f32x4 h4 = hbuf[bt & 1][r];
              const f32x4 xw4 = *(const LAS f32x4*)(xw + (wave * 64 + p) * 4);
              const f32x4 hn = ea * h4 + xw4[0] * b4[0] + xw4[1] * b4[1] + xw4[2] * b4[2] + xw4[3] * b4[3];
              { float* wp = H1 + (size_t)(2 * (bt * 8 + r)) * 128; __builtin_nontemporal_store(hn, (f32x4*)(wp + hoff)); }
              float part[4];
#pragma unroll
              for (int t = 0; t < 4; ++t) { part[t] = (c4[t][0] * h4[0] + c4[t][1] * h4[1]) + (c4[t][2] * h4[2] + c4[t][3] * h4[3]);
                  part[t] += __shfl_xor(part[t], 1); part[t] += __shfl_xor(part[t], 2); part[t] += __shfl_xor(part[t], 4); part[t] += __shfl_xor(part[t], 8); part[t] += __shfl_xor(part[t], 16); }
              if ((lane & 31) == 0) {
#pragma unroll
                  for (int t = 0; t < 4; ++t) yp[(wave * 4 + t) * 64 + p] = part[t]; } } } }
    __syncthreads();
    { const int p = lane; const float dskip = A.in[I_DSKIP][hd]; float pre[4];
#pragma unroll
      for (int t = 0; t < 4; ++t) { float y = __expf(acS[wave * 4 + t]) * yp[(wave * 4 + t) * 64 + p];
#pragma unroll
          for (int s = 0; s < 4; ++s) if (s <= t) y += CBs[t * 4 + s] * __expf(acS[wave * 4 + t] - acS[wave * 4 + s]) * dtS[wave * 4 + s] * xf[s * 512 + wave * 64 + p];
          y += dskip * xf[t * 512 + wave * 64 + p];
          const int row = rowb + t, col = hd * 64 + p; const float z = bf2f(PROJ[(size_t)row * NPROJ + 16384 + col]); pre[t] = y * silu(z);
          const float ss = wave_sum(pre[t] * pre[t]); if (lane == 0) ssS[wave * 4 + t] = ss; }
      __syncthreads();
#pragma unroll
      for (int t = 0; t < 4; ++t) { float tot = 0.f;
#pragma unroll
          for (int w = 0; w < 8; ++w) tot += ssS[w * 4 + t];
          const float rstd = rsqrtf(tot * (1.f / 512.f) + EPS); const int col = hd * 64 + p;
          MIX[(size_t)(rowb + t) * LDM + 4096 + col] = (bf16)f2bf(pre[t] * rstd * snorm[col]); } }
    __syncthreads();
}


__global__ void __launch_bounds__(NTHREADS, 2) mk_fwd(Args args) {
    extern __shared__ __attribute__((aligned(16))) unsigned char lds_raw[];
    LAS unsigned char* lds = (LAS unsigned char*)lds_raw;
    volatile LAS unsigned* MISC = (volatile LAS unsigned*)(lds + LDSCTL_OFF);
    const int tid = threadIdx.x, lane = tid & 63, wave = __builtin_amdgcn_readfirstlane(tid >> 6);
    const int G = gridDim.x, bid = blockIdx.x;
    const int gw = bid * NWAVES + wave, NGW = G * NWAVES, gt = bid * NTHREADS + tid, NGT = G * NTHREADS;
    unsigned char* ws = args.ws;
    unsigned* ctl = (unsigned*)(ws + WS_CTL);
    if (tid < 64) MISC[tid] = 0u;
    __syncthreads();
    XcdBarrier bar; bar.bar = ctl + CW_BAR; bar.x = 0; bar.st = nullptr;
    if (MK_N_LAUNCHES == 1) bar = xcd_barrier_post(ctl + CW_BAR, MISC + 8);
#define GRID_BAR() do { if (MK_N_LAUNCHES == 1) xcd_barrier(bar); } while (0)
    const int lo = args.ph_lo, hi = args.ph_hi;
#define IN(k) (lo <= (k) && (k) < hi)
#define BOTH(k) (IN(k) && IN((k) + 1))

    if (IN(0)) {
#pragma nounroll
        for (int rep = 0; rep < (PROBE_DUP == 0 ? 2 : 1); ++rep) p0_prologue(args, lds, gw, NGW, lane, wave);
        if (BOTH(0)) GRID_BAR(); }
    if (IN(1)) {
        pg8::Gemm g{(const bf16*)(ws + WS_XN), (const bf16*)(ws + WS_W1T), LDX, LDX, DM}; pg8::Order S; S.init(MTOK / 256, NW1 / 256, G, bid, 0, 0, PROBE_DUP == 1 ? 2 : 1);
        pg8::EpiProj E{(bf16*)(ws + WS_PROJ), (float*)(ws + WS_GATES)};
        pg8::gemm_phase<pg8::EpiProj, pg8::Order>(lds, g, S, E);
        if (BOTH(1)) GRID_BAR();
    }
    if (IN(2)) {
        const bf16* PROJ = (const bf16*)(ws + WS_PROJ);
#pragma nounroll
        for (int rep = 0; rep < (PROBE_DUP == 2 ? 2 : 1); ++rep) {
        gate_scans(args, gw, NGW, lane);
        conv_part<4096, 8, true>(PROJ, nullptr, args.in[I_MCW], args.in[I_MCB], (bf16*)(ws + WS_UC), LDX, args.out + O_PMCONV, gt, NGT);
        conv_part<4096, 4, false>(PROJ, args.in[I_MCONV], args.in[I_MCW], args.in[I_MCB], (bf16*)(ws + WS_UC), LDX, args.out + O_SMCONV, gt, NGT);
        conv_part<6144, 8, true>(PROJ + 20480, nullptr, args.in[I_SCW], args.in[I_SCB], (bf16*)(ws + WS_XBC), 6144, args.out + O_PSCONV, gt, NGT);
        conv_part<6144, 4, false>(PROJ + 20480, args.in[I_SCONV], args.in[I_SCW], args.in[I_SCB], (bf16*)(ws + WS_XBC), 6144, args.out + O_SSCONV, gt, NGT); }
        if (BOTH(2)) GRID_BAR();
    }
    if (IN(3)) {
        if (bid == 0 && wave == 0) mlstm_m_carry(args, lane);
        { pg8::Gemm g{(const bf16*)(ws + WS_UC), (const bf16*)(ws + WS_WQK), LDX, LDQ, 512}; pg8::Order S; S.init(MTOK / 256, 16, G, bid, 1, 512, PROBE_DUP == 3 ? 2 : 1);
          pg8::EpiBf16 E{(bf16*)(ws + WS_QK), DM};
          pg8::gemm_phase<pg8::EpiBf16, pg8::Order>(lds, g, S, E); }
        { pg8::Gemm g{(const bf16*)(ws + WS_PB), (const bf16*)(ws + WS_WPT), LDP, LDP, 256}; pg8::Order S; S.init(MTOK / 256, 16, G, bid, 0, 0, PROBE_DUP == 3 ? 2 : 1);
          pg8::EpiBf16 E{(bf16*)(ws + WS_PPB), DM};
          pg8::gemm_phase<pg8::EpiBf16, pg8::Order>(lds, g, S, E); }
        if (BOTH(3)) GRID_BAR();
    }
    if (IN(4)) {
#pragma nounroll
        for (int rep = 0; rep < (PROBE_DUP == 40 ? 2 : 1); ++rep) for (int it = bid; it < 1024; it += G) m1_unit(args, lds, it, tid, lane, wave);
#pragma nounroll
        for (int rep = 0; rep < (PROBE_DUP == 41 ? 2 : 1); ++rep) for (int it = bid; it < 1024; it += G) s1_unit(args, lds, it, tid, lane, wave);
        if (BOTH(4)) GRID_BAR();
    }
    if (IN(5)) {
        if (bid >= G - 32) nscan_item(args, bid - (G - 32), tid);
#pragma nounroll
        for (int rep = 0; rep < (PROBE_DUP == 50 ? 2 : 1); ++rep)
        for (int it = bid; it < 256; it += G) { if (it < 128) m2_item(args, lds, it, tid, lane, wave); else s2_item(args, lds, it - 128, tid, lane, wave); }
#pragma nounroll
        for (int rep = 0; rep < (PROBE_DUP == 52 ? 2 : 1); ++rep) for (int it = bid; it < 1024; it += G) mlstm_sample_item(args, lds, it, tid, lane, wave);
#pragma nounroll
        for (int rep = 0; rep < (PROBE_DUP == 53 ? 2 : 1); ++rep) for (int it = bid; it < 1024; it += G) ssd_sample_item(args, lds, it, tid, lane, wave);
        if (BOTH(5)) GRID_BAR();
    }
    if (IN(6)) {
#pragma nounroll
        for (int rep = 0; rep < (PROBE_DUP == 6 ? 2 : 1); ++rep) { m3_pass(args, gw, NGW, lane); s3_pass(args, gw, NGW, lane); }
        if (BOTH(6)) GRID_BAR();
    }
    if (IN(7)) {
        { pg8::Gemm g{(const bf16*)(ws + WS_MIX), (const bf16*)(ws + WS_W2T), LDM, LDM, 8192}; pg8::Order S; S.init(MPR / 256, 16, G, bid, 0, 0, PROBE_DUP == 7 ? 2 : 1);
          pg8::EpiX1 E{args.in[I_XP], args.in[I_XS], args.in[I_PLENORM], (float*)(ws + WS_X1), (bf16*)(ws + WS_X1G), (float*)(ws + WS_RS1), PROBE_DUP == 7 ? 0.5f : 1.f};
          pg8::gemm_phase<pg8::EpiX1, pg8::Order>(lds, g, S, E); }
        { pg8::Gemm g{(const bf16*)(ws + WS_MIX), (const bf16*)(ws + WS_W2T), LDM, LDM, 1024}; pg8::SplitOrder S{G, bid, MPR / 256, 1024};
          pg8::EpiSlab E{(float*)(ws + WS_SLAB2)};
          pg8::gemm_phase<pg8::EpiSlab, pg8::SplitOrder>(lds, g, S, E); }
        if (BOTH(7)) GRID_BAR();
    }
    if (IN(8)) {
        { const float* SL = (const float*)(ws + WS_SLAB2); const float* gn = args.in[I_PLENORM]; float* X1 = (float*)(ws + WS_X1); bf16* X1G = (bf16*)(ws + WS_X1G); float* RS1 = (float*)(ws + WS_RS1);
          for (int it = gw; it < 512 * 4; it += NGW) { const int rl = it >> 2, qd = it & 3, row = MPR + rl; float ss = 0.f;
#pragma unroll
              for (int j = 0; j < 4; ++j) { const int c = qd * 1024 + j * 256 + lane * 4; f32x4 v = *(const f32x4*)(args.in[I_XS] + (size_t)rl * DM + c);
#pragma unroll
                  for (int ks = 0; ks < 8; ++ks) v += *(const f32x4*)(SL + ((size_t)ks * 512 + rl) * DM + c);
                  *(f32x4*)(X1 + (size_t)row * DM + c) = v; ss += (v[0] * v[0] + v[1] * v[1]) + (v[2] * v[2] + v[3] * v[3]);
                  const f32x4 gv = *(const f32x4*)(gn + c); v2u w; w.x = pk2(v[0] * gv[0], v[1] * gv[1]); w.y = pk2(v[2] * gv[2], v[3] * gv[3]); *(v2u*)(X1G + (size_t)row * LDX + c) = w; }
              ss = wave_sum(ss); if (lane == 0) atomicAdd(RS1 + row, ss); } }
        { pg8::Gemm g{(const bf16*)(ws + WS_X1G), (const bf16*)(ws + WS_WGT), LDX, LDX, DM}; pg8::Order S; S.init(MPR / 256, 16, G, bid, 0, 0, PROBE_DUP == 8 ? 2 : 1);
          pg8::EpiGate E{(const float*)(ws + WS_X1), (const bf16*)(ws + WS_PPB), (const float*)(ws + WS_RS1), args.out + O_Y, (float*)(ws + WS_RS2), PROBE_DUP == 8 ? 0.5f : 1.f};
          pg8::gemm_phase<pg8::EpiGate, pg8::Order>(lds, g, S, E); }
        if (BOTH(8)) GRID_BAR();
    }
    if (IN(9)) {
        pg8::Gemm g{(const bf16*)(ws + WS_X1G), (const bf16*)(ws + WS_WGT), LDX, LDX, 512}; pg8::SplitOrder S{G, bid, MPR / 256, 512};
        pg8::EpiSlab E{(float*)(ws + WS_SLAB3)};
        pg8::gemm_phase<pg8::EpiSlab, pg8::SplitOrder>(lds, g, S, E);
        if (BOTH(9)) GRID_BAR();
    }
    if (IN(10)) {
        const float* RS1 = (const float*)(ws + WS_RS1); const float* RS2 = (const float*)(ws + WS_RS2); const float* fn = args.in[I_FNORM]; float* Y = args.out + O_Y;
        { const float* SL = (const float*)(ws + WS_SLAB3); const float* X1 = (const float*)(ws + WS_X1); const bf16* PP = (const bf16*)(ws + WS_PPB);
          for (int rl = gw; rl < 512; rl += NGW) { const int row = MPR + rl; const float rstd1 = rsqrtf(RS1[row] * (1.f / DM) + EPS); f32x4 x2[16]; float ss = 0.f;
#pragma unroll
              for (int j = 0; j < 16; ++j) { const int c = j * 256 + lane * 4; f32x4 a = *(const f32x4*)(SL + (size_t)rl * DM + c);
#pragma unroll
                  for (int ks = 1; ks < 8; ++ks) a += *(const f32x4*)(SL + ((size_t)ks * 512 + rl) * DM + c);
                  const v2u pw = *(const v2u*)(PP + (size_t)row * DM + c); const f32x4 x1 = *(const f32x4*)(X1 + (size_t)row * DM + c); a = a * rstd1; f32x4 v;
                  v[0] = x1[0] + sigm(a[0]) * bflo(pw.x); v[1] = x1[1] + sigm(a[1]) * bfhi(pw.x); v[2] = x1[2] + sigm(a[2]) * bflo(pw.y); v[3] = x1[3] + sigm(a[3]) * bfhi(pw.y);
                  x2[j] = v; ss += (v[0] * v[0] + v[1] * v[1]) + (v[2] * v[2] + v[3] * v[3]); }
              const float rstd = rsqrtf(wave_sum(ss) * (1.f / DM) + EPS);
#pragma unroll
              for (int j = 0; j < 16; ++j) { const int c = j * 256 + lane * 4; const f32x4 g4 = *(const f32x4*)(fn + c); *(f32x4*)(Y + (size_t)row * DM + c) = x2[j] * rstd * g4; } } }
        for (int i = gt; i < MPR * 1024; i += NGT) { const int row = i >> 10, c4 = (i & 1023) * 4;
            const float rstd = rsqrtf(RS2[row] * (1.f / DM) + EPS);
            const f32x4 g4 = *(const f32x4*)(fn + c4); f32x4 v = *(f32x4*)(Y + (size_t)row * DM + c4);
            v = v * rstd * g4; *(f32x4*)(Y + (size_t)row * DM + c4) = v; }
    }
#undef IN
#undef BOTH
#undef GRID_BAR
}

extern "C" void kernel_launch(void* const* d_in, const int* in_sizes, int n_in, void* d_out, int out_size, void* d_ws, size_t ws_size, hipStream_t stream) {
    static int grid = 0;
    if (grid == 0) {
        if (n_in != N_IN || (size_t)out_size != O_END || ws_size < WS_END) { fprintf(stderr, "kernel_launch: unexpected sizes n_in %d out %d ws %zu\n", n_in, out_size, ws_size); grid = -1; return; }
        int dev = 0, cus = 0, per_cu = 0;
        if (hipGetDevice(&dev) != hipSuccess || hipDeviceGetAttribute(&cus, hipDeviceAttributeMultiprocessorCount, dev) != hipSuccess) { grid = -1; return; }
        if (hipFuncSetAttribute((const void*)mk_fwd, hipFuncAttributeMaxDynamicSharedMemorySize, LDS_BYTES) != hipSuccess) { fprintf(stderr, "kernel_launch: hipFuncSetAttribute failed\n"); grid = -1; return; }
        if (hipOccupancyMaxActiveBlocksPerMultiprocessor(&per_cu, (const void*)mk_fwd, NTHREADS, LDS_BYTES) != hipSuccess || per_cu < 1) { fprintf(stderr, "kernel_launch: occupancy query says %d\n", per_cu); }
        (void)hipGetLastError();
        grid = cus;
    }
    if (grid < 0) return;
    if (hipMemsetAsync((char*)d_ws + WS_CTL, 0, CTL_ZERO_BYTES, stream) != hipSuccess) return;
    Args a{};
    for (int i = 0; i < N_IN; ++i) a.in[i] = (const float*)d_in[i];
    a.out = (float*)d_out; a.ws = (unsigned char*)d_ws;
    constexpr int NPH = 11;
    if (MK_N_LAUNCHES == 1) { a.ph_lo = 0; a.ph_hi = NPH; hipLaunchKernelGGL(mk_fwd, dim3(grid), dim3(NTHREADS), LDS_BYTES, stream, a); }
    else for (int p = 0; p < NPH; ++p) { a.ph_lo = p; a.ph_hi = p + 1; hipLaunchKernelGGL(mk_fwd, dim3(grid), dim3(NTHREADS), LDS_BYTES, stream, a); }
}
```

```cpp
#include <hip/hip_runtime.h>
#include <cstdio>

#ifndef PROBE_DUP
#define PROBE_DUP -1
#endif
#ifndef PG8_SP2
#define PG8_SP2 true
#endif
#ifndef MK_N_LAUNCHES
#define MK_N_LAUNCHES 1
#endif

#define GAS __attribute__((address_space(1)))
#define LAS __attribute__((address_space(3)))
typedef unsigned short bf16;
typedef unsigned v4u __attribute__((ext_vector_type(4)));
typedef unsigned v2u __attribute__((ext_vector_type(2)));
typedef float f32x4 __attribute__((ext_vector_type(4)));
typedef float f32x2 __attribute__((ext_vector_type(2)));
typedef short bf16x8 __attribute__((ext_vector_type(8)));

constexpr int NWAVES = 8, NTHREADS = 512;
constexpr int MTOK = 8704, MPR = 8192, DM = 4096, SEQ = 2048;
constexpr int NPROJ = 26624, NW1 = 26880, INCOLS = 26704;
constexpr int LDX = 4160, LDM = 8256, LDP = 320, LDQ = 576;
constexpr float EPS = 1e-6f;
enum { I_XP = 0, I_XS, I_PP, I_PS, I_MC, I_MN, I_MM, I_MCONV, I_SSSM, I_SCONV, I_NORMIN, I_WIN, I_BIG, I_BFG, I_MCW, I_MCB, I_WQ, I_WK, I_MNORM,
       I_SCW, I_SCB, I_DTB, I_ALOG, I_DSKIP, I_SNORM, I_WOUT, I_PLEPROJ, I_PLEGATE, I_PLENORM, I_FNORM, N_IN };
constexpr size_t O_Y = 0, O_PC = 35651584, O_PN = 39845888, O_PM = 39854080, O_PMCONV = 39854112, O_PSSM = 39903264, O_PSCONV = 42000416,
                 O_SC = 42074144, O_SN = 176291872, O_SM = 176554016, O_SMCONV = 176555040, O_SSSM = 178127904, O_SSCONV = 245236768, O_END = 247596064;
constexpr size_t MiB = 1u << 20;
constexpr size_t WS_CTL = 0, CTL_ZERO_BYTES = 4 * MiB;
constexpr size_t WS_NRM = 1 * MiB, WS_RS1 = 2 * MiB, WS_RS2 = 2 * MiB + 65536;
constexpr size_t WS_W1T = 4 * MiB, WS_W2T = 218 * MiB, WS_WGT = 283 * MiB, WS_WPT = 316 * MiB, WS_WQK = 319 * MiB, WS_XN = 324 * MiB, WS_PB = 394 * MiB,
                 WS_PROJ = 400 * MiB, WS_GATES = 842 * MiB, WS_UC = 851 * MiB, WS_QK = 921 * MiB, WS_XBC = 989 * MiB, WS_MG = 1091 * MiB, WS_SG = 1093 * MiB,
                 WS_MIX = 1098 * MiB, WS_X1 = 1236 * MiB, WS_X1G = 1372 * MiB, WS_PPB = 1442 * MiB,
                 WS_KWT = 1510 * MiB, WS_XWT = 1542 * MiB, WS_BMT = 1606 * MiB, WS_KWS = 1622 * MiB, WS_NALL = 1623 * MiB, WS_DENI = 1624 * MiB, WS_CS = 1625 * MiB, WS_MPD = 1626 * MiB, WS_END = 1627 * MiB;
constexpr size_t WS_NUMI = WS_UC, WS_INTER = WS_XN, WS_YI = WS_W1T, WS_YS = WS_W1T + 64 * MiB, WS_VT = WS_W1T + 128 * MiB;
constexpr size_t WS_SLAB2 = WS_W1T, WS_SLAB3 = WS_W1T + 64 * MiB;
constexpr int CW_TMO = 0, CW_BAR = 4096, CW_Q4 = 8192, CW_Q5 = 8512;
constexpr int LDSCTL_OFF = 131072, LDS_BYTES = 147456;

__device__ __forceinline__ unsigned f2bf(float f) { unsigned u = __builtin_bit_cast(unsigned, f); return (u + 0x7fffu + ((u >> 16) & 1u)) >> 16; }
typedef __bf16 bf16x2_t __attribute__((ext_vector_type(2)));
__device__ __forceinline__ unsigned pk2(float lo, float hi) { const f32x2 v = {lo, hi}; return __builtin_bit_cast(unsigned, __builtin_convertvector(v, bf16x2_t)); }
__device__ __forceinline__ float bflo(unsigned w) { return __builtin_bit_cast(float, w << 16); }
__device__ __forceinline__ float bfhi(unsigned w) { return __builtin_bit_cast(float, w & 0xffff0000u); }
__device__ __forceinline__ float bf2f(bf16 b) { return __builtin_bit_cast(float, (unsigned)b << 16); }
__device__ __forceinline__ float sigm(float x) { return 1.f / (1.f + __expf(-x)); }
__device__ __forceinline__ float silu(float x) { return x / (1.f + __expf(-x)); }
__device__ __forceinline__ float silu_fast(float x) { return x * __builtin_amdgcn_rcpf(1.f + __expf(-x)); }
__device__ __forceinline__ float softplus(float x) { return fmaxf(x, 0.f) + log1pf(__expf(-fabsf(x))); }
__device__ __forceinline__ float softcap(float x) { return 15.f * tanhf(x * (1.f / 15.f)); }
#define DPP_ADD(v_, ctrl_, rmask_) (v_) += __builtin_bit_cast(float, __builtin_amdgcn_update_dpp(0, __builtin_bit_cast(int, (v_)), (ctrl_), (rmask_), 0xF, false))
__device__ __forceinline__ float sum8(float v) { DPP_ADD(v, 0xB1, 0xF); DPP_ADD(v, 0x4E, 0xF); DPP_ADD(v, 0x141, 0xF); return v; }
__device__ __forceinline__ float sum16(float v) { v = sum8(v); DPP_ADD(v, 0x140, 0xF); return v; }
__device__ __forceinline__ float sum32_hi(float v) { v = sum16(v); DPP_ADD(v, 0x142, 0xA); return v; }
__device__ __forceinline__ float wave_sum(float v) {
    v = sum16(v); DPP_ADD(v, 0x142, 0xA); DPP_ADD(v, 0x143, 0xC);
    return __builtin_bit_cast(float, __builtin_amdgcn_readlane(__builtin_bit_cast(int, v), 63));
}
#define LDS_WAIT() asm volatile("s_waitcnt lgkmcnt(0)" ::: "memory")

namespace pg8 {
constexpr int BM = 256, BK = 64, HALF = 128, HTB = HALF * BK * 2, STAGE_BYTES = 8 * HTB, NXCD = 8, WGM = 8;
__host__ __device__ __forceinline__ int lds_byte(int r, int c) { const int st = (r >> 4) * 2 + (c >> 5), rr = r & 15, cc = c & 31, ob = rr * 64 + cc * 2; return st * 1024 + (ob ^ (((ob >> 9) & 1) << 5)); }
__host__ __device__ __forceinline__ void stage_rc(int b, int& R, int& C) { const int st = b / 1024, sb = b % 1024, swz = sb ^ (((sb >> 9) & 1) << 5); R = (st >> 1) * 16 + swz / 64; C = (st & 1) * 32 + (swz % 64) / 2; }
__host__ __device__ __forceinline__ int perm32(int rho) { const int n = rho >> 4, i = rho & 15; return 8 * (i >> 2) + 4 * n + (i & 3); }
struct Unit { int pm, pn, ks; };
struct Gemm { const bf16* A; const bf16* Bt; int lda, ldb, K; };
struct Order {
    int nM, nN, nwg, G, c, kshift, kmul, rep, quad;
    __device__ void init(int nM_, int nN_, int G_, int c_, int kshift_ = 0, int kmul_ = 0, int rep_ = 1) { nM = nM_; nN = nN_; nwg = nM * nN; G = G_; c = c_; kshift = kshift_; kmul = kmul_; rep = rep_; quad = 0; }
    __device__ bool next(int i, Unit& u) const {
        const int L = i * G + c; if (L >= nwg * rep) return false;
        int wgid = (rep == 1) ? L : (L % nwg); { const int q = nwg / NXCD, r = nwg % NXCD, xcd = wgid % NXCD, off = wgid / NXCD; wgid = (xcd < r ? xcd * (q + 1) : r * (q + 1) + (xcd - r) * q) + off; }
        if (quad) {
            const int full = (nN >> 2) * (nM * 4);
            if (wgid < full) { const int q = wgid / (nM * 4), rem = wgid % (nM * 4); u.pm = rem >> 2; u.pn = 4 * q + (rem & 3); }
            else { const int rem = wgid - full, nr = nN & 3; u.pm = rem / nr; u.pn = (nN & ~3) + rem % nr; }
            u.ks = 0; return true; }
        const int nig = WGM * nN, gid = wgid / nig, fm = gid * WGM, gsz = (nM - fm) < WGM ? (nM - fm) : WGM;
        u.pm = fm + ((wgid % nig) % gsz); u.pn = (wgid % nig) / gsz; u.ks = 0; return true;
    }
    __device__ __forceinline__ int a_koff(const Unit& u) const { return (u.pn >> kshift) * kmul; }
    __device__ __forceinline__ int b_koff(const Unit&) const { return 0; }
    __device__ __forceinline__ void a_ready(const Unit&) const {}
    __device__ __forceinline__ void done(const Unit&) const {}
};

struct SplitOrder {
    int G, c, pm0, kchunk;
    __device__ bool next(int i, Unit& u) const { const int L = i * G + c; if (L >= 256) return false; u.pm = pm0 + (L >> 7); u.pn = (L >> 3) & 15; u.ks = L & 7; return true; }
    __device__ __forceinline__ int a_koff(const Unit& u) const { return u.ks * kchunk; }
    __device__ __forceinline__ int b_koff(const Unit& u) const { return u.ks * kchunk; }
    __device__ __forceinline__ void a_ready(const Unit&) const {}
    __device__ __forceinline__ void done(const Unit&) const {}
};
template <class Epi, class Sched, bool ALIGN_EPI = true, bool SP2 = PG8_SP2>
__device__ __forceinline__ void gemm_phase(LAS unsigned char* lds, const Gemm g, const Sched& S, const Epi& E) {
    const int tid = threadIdx.x, wid = __builtin_amdgcn_readfirstlane(tid >> 6), lane = tid & 63, wr = wid >> 2, wc = wid & 3, fr = lane & 15, fq = lane >> 4;
    const int K = g.K, nt = K / BK;
    unsigned voffA[2], voffB[2];
#pragma unroll
    for (int i = 0; i < 2; ++i) { int R, C; stage_rc(tid * 16 + i * 8192, R, C); const int Rb = Epi::PERM ? ((R & ~31) + perm32(R & 31)) : R;
        voffA[i] = (unsigned)(R * g.lda + C) * 2u; voffB[i] = (unsigned)(Rb * g.ldb + C) * 2u; }
    const size_t kstep = (size_t)(BK * 2);
    const size_t hstepA = (size_t)HALF * g.lda * 2, hstepB = (size_t)HALF * g.ldb * 2;
    const size_t tstepA = 2 * hstepA, tstepB = 2 * hstepB;
    const unsigned ldsw = (unsigned)wid * 1024u;
    const int aoff = lds_byte(wr * 64 + fr, fq * 8), boff = lds_byte(wc * 32 + fr, fq * 8);
#define PG8_SA(b, h) (((b) * 2 + (h)) * HTB)
#define PG8_SB(b, h) ((4 + (b) * 2 + (h)) * HTB)
#define PG8_STAGE(bufoff, gbase, voff) do { _Pragma("unroll") for (int _i = 0; _i < 2; ++_i) \
        __builtin_amdgcn_global_load_lds((const unsigned*)((const char*)(gbase) + (voff)[_i]), (LAS unsigned*)(lds + (bufoff) + ldsw + _i * 8192), 16, 0, 0); } while (0)
#define PG8_LDA(dst, b, h) do { _Pragma("unroll") for (int m = 0; m < 4; ++m) _Pragma("unroll") for (int k = 0; k < 2; ++k) dst[m][k] = *(const LAS bf16x8*)(lds + PG8_SA(b, h) + aoff + m * 2048 + k * 1024); } while (0)
#define PG8_LDB(dst, b, h) do { _Pragma("unroll") for (int n = 0; n < 2; ++n) _Pragma("unroll") for (int k = 0; k < 2; ++k) dst[n][k] = *(const LAS bf16x8*)(lds + PG8_SB(b, h) + boff + n * 2048 + k * 1024); } while (0)
#define PG8_MMA(ai, bj, At, Bt) do { __builtin_amdgcn_s_setprio(1); _Pragma("unroll") for (int m = 0; m < 4; ++m) _Pragma("unroll") for (int n = 0; n < 2; ++n) _Pragma("unroll") for (int k = 0; k < 2; ++k) \
        acc[ai][bj][m][n] = __builtin_amdgcn_mfma_f32_16x16x32_bf16(Bt[n][k], At[m][k], acc[ai][bj][m][n], 0, 0, 0); __builtin_amdgcn_s_setprio(0); } while (0)
#define PG8_WAIT_V(n) asm volatile("s_waitcnt vmcnt(" #n ")" ::: "memory")
#define PG8_WAIT_L(n) asm volatile("s_waitcnt lgkmcnt(" #n ")" ::: "memory")
#define PG8_BAR __builtin_amdgcn_s_barrier()
#define PG8_SCHED __builtin_amdgcn_sched_barrier(0)
    Unit cur, nxt; int ui = 0;
    if (!S.next(0, cur)) return;
    f32x4 acc[2][2][4][2];
#pragma unroll
    for (int a = 0; a < 2; ++a)
#pragma unroll
        for (int b = 0; b < 2; ++b)
#pragma unroll
            for (int m = 0; m < 4; ++m)
#pragma unroll
                for (int n = 0; n < 2; ++n) acc[a][b][m][n] = (f32x4){0.f, 0.f, 0.f, 0.f};
    bf16x8 At[4][2], B0[2][2], B1[2][2];
    const char* cA = (const char*)g.A + (size_t)cur.pm * tstepA + (size_t)S.a_koff(cur) * 2; const char* cB = (const char*)g.Bt + (size_t)cur.pn * tstepB + (size_t)S.b_koff(cur) * 2;
    S.a_ready(cur);
    if constexpr (SP2) {
    PG8_STAGE(PG8_SB(0, 0), cB, voffB); PG8_STAGE(PG8_SB(0, 1), cB + hstepB, voffB); PG8_STAGE(PG8_SA(0, 0), cA, voffA); PG8_STAGE(PG8_SA(0, 1), cA + hstepA, voffA);
    if (wr == 1) PG8_BAR;
    PG8_WAIT_V(2); PG8_BAR;
    PG8_STAGE(PG8_SB(1, 0), cB + kstep, voffB); PG8_STAGE(PG8_SA(1, 0), cA + kstep, voffA); PG8_STAGE(PG8_SB(1, 1), cB + hstepB + kstep, voffB);
    PG8_WAIT_V(6); PG8_BAR;
    } else {
    PG8_STAGE(PG8_SB(0, 0), cB, voffB); PG8_STAGE(PG8_SA(0, 0), cA, voffA); PG8_STAGE(PG8_SB(0, 1), cB + hstepB, voffB); PG8_STAGE(PG8_SA(0, 1), cA + hstepA, voffA);
    if (wr == 1) PG8_BAR;
    PG8_WAIT_V(4); PG8_BAR;
    PG8_STAGE(PG8_SB(1, 0), cB + kstep, voffB); PG8_STAGE(PG8_SA(1, 0), cA + kstep, voffA); PG8_STAGE(PG8_SB(1, 1), cB + hstepB + kstep, voffB);
    PG8_WAIT_V(6); PG8_BAR;
    }
    for (;;) {
        const bool has_next = S.next(ui + 1, nxt);
        const char* nA = has_next ? (const char*)g.A + (size_t)nxt.pm * tstepA + (size_t)S.a_koff(nxt) * 2 : cA; const char* nB = has_next ? (const char*)g.Bt + (size_t)nxt.pn * tstepB + (size_t)S.b_koff(nxt) * 2 : cB;
        for (int t = 0; t < nt; t += 2) {
            const bool last = (t == nt - 2);
            const char* a1 = cA + (size_t)(t + 1) * kstep;
            const char* a2 = last ? nA : cA + (size_t)(t + 2) * kstep; const char* b2 = last ? nB : cB + (size_t)(t + 2) * kstep;
            const char* a3 = a2 + kstep; const char* b3 = b2 + kstep;
            if (last && has_next) S.a_ready(nxt);
            if constexpr (SP2) {
            PG8_LDB(B0, 0, 0); PG8_LDB(B1, 0, 1); PG8_SCHED; PG8_LDA(At, 0, 0); PG8_STAGE(PG8_SA(1, 1), a1 + hstepA, voffA);
            PG8_WAIT_V(8); PG8_WAIT_L(0); PG8_BAR; PG8_MMA(0, 0, At, B0); PG8_MMA(0, 1, At, B1); PG8_BAR; PG8_SCHED;
            PG8_LDA(At, 0, 1); PG8_STAGE(PG8_SB(0, 0), b2, voffB); PG8_STAGE(PG8_SB(0, 1), b2 + hstepB, voffB); PG8_STAGE(PG8_SA(0, 0), a2, voffA);
            PG8_WAIT_V(8); PG8_WAIT_L(0); PG8_BAR; PG8_MMA(1, 0, At, B0); PG8_MMA(1, 1, At, B1); PG8_BAR; PG8_SCHED;
            PG8_LDB(B0, 1, 0); PG8_LDB(B1, 1, 1); PG8_SCHED; PG8_LDA(At, 1, 0); PG8_STAGE(PG8_SA(0, 1), a2 + hstepA, voffA);
            PG8_WAIT_V(8); PG8_WAIT_L(0); PG8_BAR; PG8_MMA(0, 0, At, B0); PG8_MMA(0, 1, At, B1); PG8_BAR; PG8_SCHED;
            PG8_LDA(At, 1, 1); PG8_STAGE(PG8_SB(1, 0), b3, voffB); PG8_STAGE(PG8_SB(1, 1), b3 + hstepB, voffB); PG8_STAGE(PG8_SA(1, 0), a3, voffA);
            PG8_WAIT_V(8); PG8_WAIT_L(0); PG8_BAR; PG8_MMA(1, 0, At, B0); PG8_MMA(1, 1, At, B1); PG8_BAR; PG8_SCHED;
            } else {
            PG8_LDB(B0, 0, 0); PG8_SCHED; PG8_LDA(At, 0, 0); PG8_STAGE(PG8_SA(1, 1), a1 + hstepA, voffA);
            PG8_WAIT_L(8); PG8_BAR; PG8_WAIT_L(0); PG8_MMA(0, 0, At, B0); PG8_BAR; PG8_SCHED;
            PG8_LDB(B1, 0, 1); PG8_STAGE(PG8_SB(0, 0), b2, voffB);
            PG8_BAR; PG8_WAIT_L(0); PG8_MMA(0, 1, At, B1); PG8_BAR;
            PG8_LDA(At, 0, 1); PG8_STAGE(PG8_SA(0, 0), a2, voffA);
            PG8_BAR; PG8_WAIT_L(0); PG8_MMA(1, 0, At, B0); PG8_BAR; PG8_SCHED;
            PG8_STAGE(PG8_SB(0, 1), b2 + hstepB, voffB);
            PG8_WAIT_V(6); PG8_BAR; PG8_MMA(1, 1, At, B1); PG8_BAR;
            PG8_LDB(B0, 1, 0); PG8_SCHED; PG8_LDA(At, 1, 0); PG8_STAGE(PG8_SA(0, 1), a2 + hstepA, voffA);
            PG8_WAIT_L(8); PG8_BAR; PG8_WAIT_L(0); PG8_MMA(0, 0, At, B0); PG8_BAR; PG8_SCHED;
            PG8_LDB(B1, 1, 1); PG8_STAGE(PG8_SB(1, 0), b3, voffB);
            PG8_BAR; PG8_WAIT_L(0); PG8_MMA(0, 1, At, B1); PG8_BAR;
            PG8_LDA(At, 1, 1); PG8_STAGE(PG8_SA(1, 0), a3, voffA);
            PG8_BAR; PG8_WAIT_L(0); PG8_MMA(1, 0, At, B0); PG8_BAR; PG8_SCHED;
            PG8_STAGE(PG8_SB(1, 1), b3 + hstepB, voffB);
            PG8_WAIT_V(6); PG8_BAR; PG8_MMA(1, 1, At, B1); PG8_BAR;
            }
        }
        if constexpr (ALIGN_EPI) { if (wr == 0) PG8_BAR; }
        E(acc, cur, wr, wc, fr, fq); S.done(cur);
        if (!has_next) break;
#pragma unroll
        for (int a = 0; a < 2; ++a)
#pragma unroll
            for (int b = 0; b < 2; ++b)
#pragma unroll
                for (int m = 0; m < 4; ++m)
#pragma unroll
                    for (int n = 0; n < 2; ++n) acc[a][b][m][n] = (f32x4){0.f, 0.f, 0.f, 0.f};
        cur = nxt; cA = nA; cB = nB; ++ui;
        if constexpr (ALIGN_EPI) { if (wr == 1) PG8_BAR; }
    }
    PG8_WAIT_V(0);
    if constexpr (!ALIGN_EPI) { if (wr == 0) PG8_BAR; }
    PG8_BAR;
#undef PG8_SA
#undef PG8_SB
#undef PG8_STAGE
#undef PG8_LDA
#undef PG8_LDB
#undef PG8_MMA
#undef PG8_WAIT_V
#undef PG8_WAIT_L
#undef PG8_BAR
#undef PG8_SCHED
}

struct EpiBf16 {
    static constexpr bool PERM = true;
    bf16* O; int ldc;
    __device__ __forceinline__ void operator()(const f32x4 (&acc)[2][2][4][2], const Unit& u, int wr, int wc, int fr, int fq) const {
        const int row0 = u.pm * BM + wr * 64 + fr, col0 = u.pn * BM + wc * 32 + 8 * fq;
#pragma unroll
        for (int ai = 0; ai < 2; ++ai)
#pragma unroll
            for (int m = 0; m < 4; ++m) { bf16* rowp = O + (size_t)(row0 + ai * HALF + m * 16) * ldc + col0;
#pragma unroll
                for (int bj = 0; bj < 2; ++bj) { const f32x4 v0 = acc[ai][bj][m][0], v1 = acc[ai][bj][m][1];
                    v4u w; w.x = pk2(v0[0], v0[1]); w.y = pk2(v0[2], v0[3]); w.z = pk2(v1[0], v1[1]); w.w = pk2(v1[2], v1[3]);
                    *(v4u*)(rowp + bj * HALF) = w; } }
    }
};
struct EpiProj {
    static constexpr bool PERM = true;
    bf16* O; float* Gt;
    __device__ __forceinline__ void operator()(const f32x4 (&acc)[2][2][4][2], const Unit& u, int wr, int wc, int fr, int fq) const {
        const int row0 = u.pm * BM + wr * 64 + fr;
        if (u.pn < 104) {
            const int col0 = u.pn * BM + wc * 32 + 8 * fq;
#pragma unroll
            for (int ai = 0; ai < 2; ++ai)
#pragma unroll
                for (int m = 0; m < 4; ++m) { bf16* rowp = O + (size_t)(row0 + ai * HALF + m * 16) * NPROJ + col0;
#pragma unroll
                    for (int bj = 0; bj < 2; ++bj) { const f32x4 v0 = acc[ai][bj][m][0], v1 = acc[ai][bj][m][1];
                        v4u w; w.x = pk2(v0[0], v0[1]); w.y = pk2(v0[2], v0[3]); w.z = pk2(v1[0], v1[1]); w.w = pk2(v1[2], v1[3]);
                        *(v4u*)(rowp + bj * HALF) = w; } }
        } else {
            const int col0 = wc * 32 + 8 * fq;
#pragma unroll
            for (int ai = 0; ai < 2; ++ai)
#pragma unroll
                for (int m = 0; m < 4; ++m) { float* rowp = Gt + (size_t)(row0 + ai * HALF + m * 16) * 256 + col0;
#pragma unroll
                    for (int bj = 0; bj < 2; ++bj)
#pragma unroll
                        for (int n = 0; n < 2; ++n) *(f32x4*)(rowp + bj * HALF + 4 * n) = acc[ai][bj][m][n]; }
        }
    }
};
struct EpiSlab {
    static constexpr bool PERM = false;
    float* slab;
    __device__ __forceinline__ void operator()(const f32x4 (&acc)[2][2][4][2], const Unit& u, int wr, int wc, int fr, int fq) const {
        const int row0 = u.pm * BM - MPR + wr * 64 + fr, col0 = u.pn * BM + wc * 32 + 4 * fq;
#pragma unroll
        for (int ai = 0; ai < 2; ++ai)
#pragma unroll
            for (int m = 0; m < 4; ++m) { float* rowp = slab + ((size_t)u.ks * 512 + row0 + ai * HALF + m * 16) * DM + col0;
#pragma unroll
                for (int bj = 0; bj < 2; ++bj)
#pragma unroll
                    for (int n = 0; n < 2; ++n) *(f32x4*)(rowp + bj * HALF + n * 16) = acc[ai][bj][m][n]; }
    }
};
struct EpiX1 {
    static constexpr bool PERM = false;
    const float* xp; const float* xs; const float* gn; float* X1; bf16* X1G; float* RS; float ssw;
    __device__ __forceinline__ void operator()(const f32x4 (&acc)[2][2][4][2], const Unit& u, int wr, int wc, int fr, int fq) const {
        const int row0 = u.pm * BM + wr * 64 + fr, col0 = u.pn * BM + wc * 32 + 4 * fq;
#pragma unroll
        for (int ai = 0; ai < 2; ++ai)
#pragma unroll
            for (int m = 0; m < 4; ++m) { const int row = row0 + ai * HALF + m * 16;
                const float* xrow = (row < MPR ? xp + (size_t)row * DM : xs + (size_t)(row - MPR) * DM) + col0; const size_t off = (size_t)row * DM + col0; float ss = 0.f;
#pragma unroll
                for (int bj = 0; bj < 2; ++bj)
#pragma unroll
                    for (int n = 0; n < 2; ++n) { const int co = bj * HALF + n * 16; const f32x4 v = *(const f32x4*)(xrow + co) + acc[ai][bj][m][n];
                        *(f32x4*)(X1 + off + co) = v; ss += (v[0] * v[0] + v[1] * v[1]) + (v[2] * v[2] + v[3] * v[3]);
                        const f32x4 gv = *(const f32x4*)(gn + col0 + co); v2u w; w.x = pk2(v[0] * gv[0], v[1] * gv[1]); w.y = pk2(v[2] * gv[2], v[3] * gv[3]);
                        *(v2u*)(X1G + (size_t)row * LDX + col0 + co) = w; }
                ss += __shfl_xor(ss, 16); ss += __shfl_xor(ss, 32);
                if (fq == 0) atomicAdd(RS + row, ss * ssw); }
    }
};
struct EpiGate {
    static constexpr bool PERM = false;
    const float* X1; const bf16* PP; const float* RS1; float* out; float* RS2; float ssw;
    __device__ __forceinline__ void operator()(const f32x4 (&acc)[2][2][4][2], const Unit& u, int wr, int wc, int fr, int fq) const {
        const int row0 = u.pm * BM + wr * 64 + fr, col0 = u.pn * BM + wc * 32 + 4 * fq;
#pragma unroll
        for (int ai = 0; ai < 2; ++ai)
#pragma unroll
            for (int m = 0; m < 4; ++m) { const int row = row0 + ai * HALF + m * 16; const size_t off = (size_t)row * DM + col0; float ss = 0.f;
                const float rstd = rsqrtf(RS1[row] * (1.f / DM) + EPS);
#pragma unroll
                for (int bj = 0; bj < 2; ++bj)
#pragma unroll
                    for (int n = 0; n < 2; ++n) { const int co = bj * HALF + n * 16; const f32x4 a = acc[ai][bj][m][n] * rstd; const v2u pw = *(const v2u*)(PP + off + co);
                        const f32x4 x1 = *(const f32x4*)(X1 + off + co); f32x4 v;
                        v[0] = x1[0] + sigm(a[0]) * bflo(pw.x); v[1] = x1[1] + sigm(a[1]) * bfhi(pw.x); v[2] = x1[2] + sigm(a[2]) * bflo(pw.y); v[3] = x1[3] + sigm(a[3]) * bfhi(pw.y);
                        *(f32x4*)(out + off + co) = v; ss += (v[0] * v[0] + v[1] * v[1]) + (v[2] * v[2] + v[3] * v[3]); }
                ss += __shfl_xor(ss, 16); ss += __shfl_xor(ss, 32);
                if (fq == 0) atomicAdd(RS2 + row, ss * ssw); }
    }
};
}

#define XB_TMO      128
#define XB_XCNT(j)  (256  + 64 * (j))
#define XB_XSUB(j)  (1280 + 64 * (j))
#define XB_XGEN(j)  (2304 + 64 * (j))
#define XB_TOP      3328
#define XB_TOPGEN   3392
#define XCD_BAR_WORDS 3456
#define XB_SPIN_CAP (1u << 18)
__device__ __forceinline__ unsigned xb_ld(unsigned* p)              { return __hip_atomic_load(p, __ATOMIC_RELAXED, __HIP_MEMORY_SCOPE_AGENT); }
__device__ __forceinline__ unsigned xb_add(unsigned* p, unsigned v) { return __hip_atomic_fetch_add(p, v, __ATOMIC_RELAXED, __HIP_MEMORY_SCOPE_AGENT); }
__device__ __forceinline__ unsigned xb_xcc_id() { return (unsigned)__builtin_amdgcn_s_getreg((3 << 11) | 20) & 0xFu; }
#define XB_SPIN(cond, bar) do { unsigned _sp = 0; while (cond) { __builtin_amdgcn_s_sleep(1); \
    if ((++_sp & 255u) == 0u) { if (xb_ld(&(bar)[XB_TMO])) break; if (_sp > XB_SPIN_CAP) { atomicAdd(&(bar)[XB_TMO], 1u); break; } } } } while (0)
struct XcdBarrier { unsigned* bar; unsigned x; volatile LAS unsigned* st; };
__device__ __forceinline__ XcdBarrier xcd_barrier_post(unsigned* bar, volatile LAS unsigned* st) {
    XcdBarrier b; b.bar = bar; b.x = xb_xcc_id(); b.st = st;
    if (threadIdx.x == 0) (void)xb_add(&bar[XB_XCNT(b.x)], 1u);
    return b;
}
__device__ __forceinline__ void xcd_barrier_complete(unsigned* bar, unsigned x, unsigned& nloc, unsigned& nx) {
    const unsigned G = gridDim.x * gridDim.y * gridDim.z;
    unsigned sum, cnt, mine, sp = 0u;
    for (;;) {
        sum = 0u; cnt = 0u; mine = 0u;
#pragma unroll
        for (unsigned j = 0; j < 16; ++j) { const unsigned c = xb_ld(&bar[XB_XCNT(j)]); sum += c; cnt += (c > 0u) ? 1u : 0u; mine = (j == x) ? c : mine; }
        if (sum == G) break;
        __builtin_amdgcn_s_sleep(1);
        if ((++sp & 255u) == 0u) { if (xb_ld(&bar[XB_TMO])) break; if (sp > XB_SPIN_CAP) { atomicAdd(&bar[XB_TMO], 1u); break; } }
    }
    nloc = mine > 0u ? mine : 1u; nx = cnt > 0u ? cnt : 1u;
}
__device__ __forceinline__ void xcd_barrier(const XcdBarrier& b) {
    asm volatile("s_waitcnt vmcnt(0)" ::: "memory");
    __syncthreads();
    if (threadIdx.x == 0) {
        unsigned* bar = b.bar;
        __builtin_amdgcn_s_waitcnt(0);
        unsigned nloc = b.st[0], nx = b.st[1];
        if (nloc == 0u) { xcd_barrier_complete(bar, b.x, nloc, nx); b.st[0] = nloc; b.st[1] = nx; }
        const unsigned old = xb_add(&bar[XB_XSUB(b.x)], 1u);
        const unsigned gen = old / nloc;
        if (old + 1u == (gen + 1u) * nloc) {
            __builtin_amdgcn_fence(__ATOMIC_RELEASE, "agent");
            asm volatile("s_waitcnt vmcnt(0)" ::: "memory");
            const unsigned og = xb_add(&bar[XB_TOP], 1u);
            const unsigned tg = og / nx;
            if (og + 1u == (tg + 1u) * nx) xb_add(&bar[XB_TOPGEN], 1u);
            else XB_SPIN(xb_ld(&bar[XB_TOPGEN]) == tg, bar);
            __builtin_amdgcn_fence(__ATOMIC_ACQUIRE, "agent");
            xb_add(&bar[XB_XGEN(b.x)], 1u);
            asm volatile("s_waitcnt vmcnt(0)" ::: "memory");
        } else {
            XB_SPIN(xb_ld(&bar[XB_XGEN(b.x)]) == gen, bar);
            __builtin_amdgcn_fence(__ATOMIC_ACQUIRE, "agent");
            asm volatile("s_waitcnt vmcnt(0)" ::: "memory");
        }
    }
    __syncthreads();
}

struct Args { const float* in[N_IN]; float* out; unsigned char* ws; int ph_lo, ph_hi; };

template <int K>
__device__ __forceinline__ f32x4 mma_nt(const LAS bf16* X, int ldx, const LAS bf16* Y, int ldy, f32x4 acc, int lane) {
    const int r = lane & 15, kq = (lane >> 4) * 8;
#pragma unroll
    for (int k0 = 0; k0 < K; k0 += 32) {
        const bf16x8 a = *(const LAS bf16x8*)(X + r * ldx + k0 + kq);
        const bf16x8 b = *(const LAS bf16x8*)(Y + r * ldy + k0 + kq);
        acc = __builtin_amdgcn_mfma_f32_16x16x32_bf16(a, b, acc, 0, 0, 0);
    }
    return acc;
}

__device__ __forceinline__ int w1_colmap(int n) { return n < 16384 ? n : (n < 26624 ? n + 16 : (n < 26640 ? n - 26624 + 16384 : (n < INCOLS ? n : -1))); }
struct TItem { const float* W; bf16* WT; int ldw, ldt, k0, n0, map; float scale; };
__device__ __forceinline__ TItem t_decode(const Args& A, int r) {
    constexpr int I1 = 64 * 840, I2 = 128 * 128, I3 = 64 * 128, I4 = 4 * 128;
    unsigned char* ws = A.ws; TItem t; t.map = 0; t.scale = 1.f;
    if (r < I1) { t.W = A.in[I_WIN]; t.ldw = INCOLS; t.WT = (bf16*)(ws + WS_W1T); t.ldt = LDX; t.k0 = (r % 64) * 64; t.n0 = (r / 64) * 32; t.map = 1; return t; } r -= I1;
    if (r < I2) { t.W = A.in[I_WOUT]; t.ldw = DM; t.WT = (bf16*)(ws + WS_W2T); t.ldt = LDM; t.k0 = (r % 128) * 64; t.n0 = (r / 128) * 32; return t; } r -= I2;
    if (r < I3) { t.W = A.in[I_PLEGATE]; t.ldw = DM; t.WT = (bf16*)(ws + WS_WGT); t.ldt = LDX; t.k0 = (r % 64) * 64; t.n0 = (r / 64) * 32; return t; } r -= I3;
    if (r < I4) { t.W = A.in[I_PLEPROJ]; t.ldw = DM; t.WT = (bf16*)(ws + WS_WPT); t.ldt = LDP; t.k0 = (r / 128) * 64; t.n0 = (r % 128) * 32; return t; } r -= I4;
    { const int hw = r >> 6, h = hw >> 1, which = hw & 1, q = r & 63;
      t.W = (which ? A.in[I_WK] : A.in[I_WQ]) + (size_t)h * 512 * 256; t.ldw = 256; t.WT = (bf16*)(ws + WS_WQK) + (size_t)(h * 512 + which * 256) * LDQ; t.ldt = LDQ;
      t.k0 = (q >> 3) * 64; t.n0 = (q & 7) * 32; t.scale = which ? 0.0625f : 1.f; return t; }
}
__device__ __forceinline__ void t_load(const TItem& t, int lane, float (&tv)[32]) {
    const int nn = t.n0 + (lane & 31); const int oc = t.map ? w1_colmap(nn) : nn;
    const int loff = (lane >> 5) * t.ldw + (oc >= 0 ? oc : 0);
#pragma unroll
    for (int i = 0; i < 32; ++i) { const float* rowp = t.W + (size_t)(t.k0 + 2 * i) * t.ldw; tv[i] = rowp[loff]; }
}
__device__ __forceinline__ void t_store(const TItem& t, LAS float* scr, int lane, const float (&tv)[32]) {
    const int nn = t.n0 + (lane & 31); const bool ok = !t.map || w1_colmap(nn) >= 0;
#pragma unroll
    for (int i = 0; i < 32; ++i) { const int kk = 2 * i + (lane >> 5); scr[kk * 33 + (lane & 31)] = ok ? tv[i] * t.scale : 0.f; }
    LDS_WAIT(); asm volatile("" ::: "memory");
    const int c = lane & 7;
#pragma unroll
    for (int j = 0; j < 4; ++j) { const int n = (lane >> 3) + 8 * j; const LAS float* sp = scr + (8 * c) * 33 + n;
        v4u o; o.x = pk2(sp[0 * 33], sp[1 * 33]); o.y = pk2(sp[2 * 33], sp[3 * 33]); o.z = pk2(sp[4 * 33], sp[5 * 33]); o.w = pk2(sp[6 * 33], sp[7 * 33]);
        *(v4u*)(t.WT + (size_t)(t.n0 + n) * t.ldt + t.k0 + 8 * c) = o; }
    LDS_WAIT(); asm volatile("" ::: "memory");
}
__device__ __forceinline__ void p0_prologue(const Args& A, LAS unsigned char* lds, int gw, int NGW, int lane, int wave) {
    LAS float* scr = (LAS float*)(lds + wave * 16384);
    unsigned char* ws = A.ws;
    constexpr int NIT = 64 * 840 + 128 * 128 + 64 * 128 + 4 * 128 + 1024;
    if (gw < NIT) { int it = gw; TItem cur = t_decode(A, it); float tva[32], tvb[32]; t_load(cur, lane, tva);
        for (;;) { const int nit = it + NGW; const bool has = nit < NIT; TItem nxt = cur; if (has) { nxt = t_decode(A, nit); t_load(nxt, lane, tvb); }
            t_store(cur, scr, lane, tva); if (!has) break;
#pragma unroll
            for (int i = 0; i < 32; ++i) tva[i] = tvb[i];
            cur = nxt; it = nit; } }
    const float* gn = A.in[I_NORMIN];
    for (int m = gw; m < MTOK; m += NGW) {
        const float* xrow = m < MPR ? A.in[I_XP] + (size_t)m * DM : A.in[I_XS] + (size_t)(m - MPR) * DM;
        f32x4 v[16]; float s = 0.f;
#pragma unroll
        for (int j = 0; j < 16; ++j) { v[j] = ((const f32x4*)xrow)[lane + 64 * j]; s += (v[j][0] * v[j][0] + v[j][1] * v[j][1]) + (v[j][2] * v[j][2] + v[j][3] * v[j][3]); }
        const float rstd = rsqrtf(wave_sum(s) * (1.f / DM) + EPS);
        bf16* orow = (bf16*)(ws + WS_XN) + (size_t)m * LDX;
#pragma unroll
        for (int j = 0; j < 16; ++j) { const f32x4 g4 = ((const f32x4*)gn)[lane + 64 * j]; v2u w; w.x = pk2(v[j][0] * rstd * g4[0], v[j][1] * rstd * g4[1]); w.y = pk2(v[j][2] * rstd * g4[2], v[j][3] * rstd * g4[3]);
            ((v2u*)orow)[lane + 64 * j] = w; }
    }
    { const int gt = gw * 64 + lane, NGT = NGW * 64;
      for (int i = gt; i < MTOK * 32; i += NGT) { const int row = i >> 5, c8 = (i & 31) * 8;
          const float* src = (row < MPR ? A.in[I_PP] + (size_t)row * 256 : A.in[I_PS] + (size_t)(row - MPR) * 256) + c8;
          const f32x4 a = *(const f32x4*)src, b = *(const f32x4*)(src + 4);
          v4u w; w.x = pk2(a[0], a[1]); w.y = pk2(a[2], a[3]); w.z = pk2(b[0], b[1]); w.w = pk2(b[2], b[3]);
          *(v4u*)((bf16*)(ws + WS_PB) + (size_t)row * LDP + c8) = w; } }
}

template <int NCH, int NT, bool PROMPT>
__device__ __forceinline__ void conv_part(const bf16* src  , const float* state_in, const float* w, const float* bias, bf16* dst, int dst_ld, float* out_state, int gt, int NGT) {
    constexpr int CG = NCH / 8, NBLK = PROMPT ? SEQ / NT : 1, NSEQ = PROMPT ? 4 : 128, NQ = NSEQ * NBLK;
    const int qstep = NGT / CG;
    if (gt >= qstep * CG) return;
    const int cg = gt % CG, c0 = cg * 8;
    float wv[4][8], bv[8];
#pragma unroll
    for (int j = 0; j < 4; ++j) { const f32x4 a = *(const f32x4*)(w + j * NCH + c0), b = *(const f32x4*)(w + j * NCH + c0 + 4);
#pragma unroll
        for (int e = 0; e < 4; ++e) { wv[j][e] = a[e]; wv[j][4 + e] = b[e]; } }
    { const f32x4 a = *(const f32x4*)(bias + c0), b = *(const f32x4*)(bias + c0 + 4);
#pragma unroll
      for (int e = 0; e < 4; ++e) { bv[e] = a[e]; bv[4 + e] = b[e]; } }
    for (int q = gt / CG; q < NQ; q += qstep) {
        const int seq = q / NBLK, blk = q % NBLK;
        const int row0 = PROMPT ? seq * SEQ + blk * NT : MPR + seq * 4;
        v4u rows[NT]; float win[3][8];
#pragma unroll
        for (int i = 0; i < NT; ++i) rows[i] = *(const v4u*)(src + (size_t)(row0 + i) * NPROJ + c0);
        if (PROMPT) {
#pragma unroll
            for (int j = 0; j < 3; ++j) { v4u v = (v4u){0u, 0u, 0u, 0u}; if (blk != 0) v = *(const v4u*)(src + (size_t)(row0 - 3 + j) * NPROJ + c0);
                win[j][0] = bflo(v.x); win[j][1] = bfhi(v.x); win[j][2] = bflo(v.y); win[j][3] = bfhi(v.y); win[j][4] = bflo(v.z); win[j][5] = bfhi(v.z); win[j][6] = bflo(v.w); win[j][7] = bfhi(v.w); }
        } else {
#pragma unroll
            for (int j = 0; j < 3; ++j) { const float* sp = state_in + ((size_t)seq * 3 + j) * NCH + c0; const f32x4 a = *(const f32x4*)sp, b = *(const f32x4*)(sp + 4);
#pragma unroll
                for (int e = 0; e < 4; ++e) { win[j][e] = a[e]; win[j][4 + e] = b[e]; } }
        }
#pragma unroll
        for (int i = 0; i < NT; ++i) {
            const v4u v = rows[i];
            const float cur[8] = {bflo(v.x), bfhi(v.x), bflo(v.y), bfhi(v.y), bflo(v.z), bfhi(v.z), bflo(v.w), bfhi(v.w)};
            float y[8];
#pragma unroll
            for (int e = 0; e < 8; ++e) { y[e] = silu_fast(bv[e] + wv[0][e] * win[0][e] + wv[1][e] * win[1][e] + wv[2][e] * win[2][e] + wv[3][e] * cur[e]); win[0][e] = win[1][e]; win[1][e] = win[2][e]; win[2][e] = cur[e]; }
            v4u o; o.x = pk2(y[0], y[1]); o.y = pk2(y[2], y[3]); o.z = pk2(y[4], y[5]); o.w = pk2(y[6], y[7]);
            *(v4u*)(dst + (size_t)(row0 + i) * dst_ld + c0) = o;
        }
        if (!PROMPT || blk == NBLK - 1) { float* op = out_state + (size_t)seq * 3 * NCH + c0;
#pragma unroll
            for (int j = 0; j < 3; ++j) { *(f32x4*)(op + j * NCH) = (f32x4){win[j][0], win[j][1], win[j][2], win[j][3]}; *(f32x4*)(op + j * NCH + 4) = (f32x4){win[j][4], win[j][5], win[j][6], win[j][7]}; } }
    }
}
template <int W> __device__ __forceinline__ float scan_add(float v, int lane) {
#pragma unroll
    for (int o = 1; o < W; o <<= 1) { const float t = __shfl_up(v, o, W); if ((lane & (W - 1)) >= o) v += t; }
    return v;
}
template <int W> __device__ __forceinline__ float scan_max(float v, int lane) {
#pragma unroll
    for (int o = 1; o < W; o <<= 1) { const float t = __shfl_up(v, o, W); if ((lane & (W - 1)) >= o) v = fmaxf(v, t); }
    return v;
}
__device__ __forceinline__ void gate_scans(const Args& A, int gw, int NGW, int lane) {
    const float* GT = (const float*)(A.ws + WS_GATES);
    f32x4* MG = (f32x4*)(A.ws + WS_MG); f32x2* SG = (f32x2*)(A.ws + WS_SG); f32x2* CS = (f32x2*)(A.ws + WS_CS);
    for (int it = gw; it < 512; it += NGW) {
        if (it < 128) {
            const int seq = it >> 5, c = it & 31, row = seq * SEQ + c * 64 + lane;
            const f32x4 g0 = *(const f32x4*)(GT + (size_t)row * 256), g1 = *(const f32x4*)(GT + (size_t)row * 256 + 4), g2 = *(const f32x4*)(GT + (size_t)row * 256 + 8), g3 = *(const f32x4*)(GT + (size_t)row * 256 + 12);
            const float gi[8] = {g0[0], g0[1], g0[2], g0[3], g1[0], g1[1], g1[2], g1[3]}, gf[8] = {g2[0], g2[1], g2[2], g2[3], g3[0], g3[1], g3[2], g3[3]};
#pragma unroll
            for (int h = 0; h < 8; ++h) {
                const float ig = softcap(gi[h] + A.in[I_BIG][h]), lf = -softplus(-softcap(gf[h] + A.in[I_BFG][h]));
                const float bc = scan_add<64>(lf, lane), g = ig - bc, gmax = scan_max<64>(g, lane);
                MG[(size_t)row * 8 + h] = (f32x4){bc, g, gmax, 0.f};
                if (lane == 63) CS[(seq * 8 + h) * 32 + c] = (f32x2){bc, gmax};
            }
        } else if (it < 256) {
            const int seq = it - 128, h = (lane >> 2) & 7, t = lane & 3, row = MPR + seq * 4 + t;
            const float m = A.in[I_MM][seq * 8 + h];
            const float ig = softcap(GT[(size_t)row * 256 + h] + A.in[I_BIG][h]), lf = -softplus(-softcap(GT[(size_t)row * 256 + 8 + h] + A.in[I_BFG][h]));
            const float bc = scan_add<4>(lf, lane), g = ig - bc, gmax = scan_max<4>(g, lane);
            const float mm = fmaxf(m, gmax), alpha = -mm, a = __expf(m - mm), ex = __expf(alpha - bc);
            if (lane < 32) { MG[(size_t)row * 8 + h] = (f32x4){alpha, g, a, ex}; if (t == 3) A.out[O_SM + seq * 8 + h] = bc + mm; }
        } else if (it < 384) {
            const int q = it - 256, seq = q >> 5, c = q & 31, hd = lane, rowb = seq * SEQ + c * 64;
            const float dtb = A.in[I_DTB][hd], Aneg = -__expf(A.in[I_ALOG][hd]); float ac = 0.f;
            float gv[64];
#pragma unroll
            for (int t = 0; t < 64; ++t) { const float* rp = GT + (size_t)(rowb + t) * 256 + 16; gv[t] = rp[hd]; }
#pragma unroll
            for (int t = 0; t < 64; ++t) { const float dt = softplus(gv[t] + dtb); ac += dt * Aneg; SG[(size_t)(rowb + t) * 64 + hd] = (f32x2){dt, ac}; }
        } else {
            const int seq = it - 384, hd = lane; const float dtb = A.in[I_DTB][hd], Aneg = -__expf(A.in[I_ALOG][hd]); float ac = 0.f;
#pragma unroll
            for (int t = 0; t < 4; ++t) { const int row = MPR + seq * 4 + t; const float dt = softplus(GT[(size_t)row * 256 + 16 + hd] + dtb); ac += dt * Aneg; SG[(size_t)row * 64 + hd] = (f32x2){dt, ac}; }
        }
    }
}
__device__ __forceinline__ void mlstm_m_carry(const Args& A, int lane) {
    if (lane < 32) { const f32x2* CS = (const f32x2*)(A.ws + WS_CS); f32x2* MPD = (f32x2*)(A.ws + WS_MPD); float m = -INFINITY;
        for (int c = 0; c < 32; ++c) { const f32x2 cs = CS[lane * 32 + c]; const float mm = fmaxf(m, cs[1]); MPD[lane * 32 + c] = (f32x2){m, __expf(m - mm)}; m = cs[0] + mm; }
        A.out[O_PM + lane] = m; }
}

__device__ __forceinline__ bf16x8 as_bf16x8(v4u v) { return __builtin_bit_cast(bf16x8, v); }
__device__ __forceinline__ f32x4 mfma16(bf16x8 a, bf16x8 b, f32x4 c) { return __builtin_amdgcn_mfma_f32_16x16x32_bf16(a, b, c, 0, 0, 0); }
__device__ __forceinline__ v4u pack8(f32x4 a, f32x4 b) { v4u r; r.x = pk2(a[0], a[1]); r.y = pk2(a[2], a[3]); r.z = pk2(b[0], b[1]); r.w = pk2(b[2], b[3]); return r; }
__device__ __forceinline__ float sum8bf(v4u v) { return ((bflo(v.x) + bfhi(v.x)) + (bflo(v.y) + bfhi(v.y))) + ((bflo(v.z) + bfhi(v.z)) + (bflo(v.w) + bfhi(v.w))); }

constexpr int M1_Q = 0, M1_K = 33792, M1_VT = 70656, M1_P = 107520, M1_G = 116736;
__device__ __forceinline__ void m1_unit(const Args& A, LAS unsigned char* lds, int unit, int tid, int lane, int wave) {
    const int bh = unit >> 5, c = unit & 31, b = bh >> 3, h = bh & 7, row0 = b * SEQ + c * 64;
    LAS bf16* Qs = (LAS bf16*)(lds + M1_Q); LAS bf16* Ks = (LAS bf16*)(lds + M1_K); LAS bf16* Kw = Ks; LAS bf16* Vt = (LAS bf16*)(lds + M1_VT); LAS bf16* Ps = (LAS bf16*)(lds + M1_P);
    LAS float* aS = (LAS float*)(lds + M1_G); LAS float* gS = aS + 64; LAS float* wkS = aS + 128;
    const bf16* QK = (const bf16*)(A.ws + WS_QK); const bf16* PROJ = (const bf16*)(A.ws + WS_PROJ); const f32x4* MG = (const f32x4*)(A.ws + WS_MG); const f32x2* MPD = (const f32x2*)(A.ws + WS_MPD);
    bf16* NUMI = (bf16*)(A.ws + WS_NUMI); bf16* KWT = (bf16*)(A.ws + WS_KWT) + (size_t)unit * 16384; bf16* VTG = (bf16*)(A.ws + WS_VT) + (size_t)unit * 32768;
    float* KWS = (float*)(A.ws + WS_KWS); float* DENI = (float*)(A.ws + WS_DENI);
    const int l4 = lane >> 4, l15 = lane & 15;
    v4u vr0[4], vr1[4], qr[4], kr[4];
#pragma unroll
    for (int i = 0; i < 4; ++i) { const int piece = tid + NTHREADS * i, r = piece >> 5, cc = piece & 31;
        const bf16* sp = QK + (size_t)(row0 + r) * DM + h * 512 + cc * 8;
        qr[i] = *(const v4u*)sp; kr[i] = *(const v4u*)(sp + 256);
        { const int rv = piece & 63, cv = piece >> 6; const bf16* vp = PROJ + (size_t)(row0 + rv) * NPROJ + 4096 + h * 512 + cv * 8;
          vr0[i] = *(const v4u*)vp; vr1[i] = *(const v4u*)(vp + 256); } }
    __builtin_amdgcn_sched_barrier(0);
#pragma unroll
    for (int i = 0; i < 4; ++i) { const int piece = tid + NTHREADS * i, r = piece >> 5, cc = piece & 31;
        *(LAS v4u*)(Qs + r * 264 + cc * 8) = qr[i]; *(LAS v4u*)(Ks + r * 264 + cc * 8) = kr[i]; }
    if (tid < 64) { const f32x4 mg = MG[(size_t)(row0 + tid) * 8 + h]; const float mp = MPD[unit][0]; aS[tid] = -fmaxf(mp, mg[2]); gS[tid] = mg[1]; }
#define M1_VT_WRITE(vr) do { _Pragma("unroll") for (int i = 0; i < 4; ++i) { const int piece = tid + NTHREADS * i, r = piece & 63, cc = piece >> 6; const unsigned w_[4] = {vr[i].x, vr[i].y, vr[i].z, vr[i].w}; \
        _Pragma("unroll") for (int e = 0; e < 4; ++e) { Vt[(cc * 8 + 2 * e) * 72 + r] = (bf16)(w_[e] & 0xffffu); Vt[(cc * 8 + 2 * e + 1) * 72 + r] = (bf16)(w_[e] >> 16); } } } while (0)
    M1_VT_WRITE(vr0);
    __syncthreads();
    if (tid < 64) wkS[tid] = __expf(aS[63] + gS[tid]);
    { const int mt = wave >> 1;
#pragma unroll
      for (int e = 0; e < 2; ++e) { const int nt = (wave & 1) * 2 + e;
          const f32x4 acc = mma_nt<256>(Qs + mt * 16 * 264, 264, Ks + nt * 16 * 264, 264, (f32x4){0.f, 0.f, 0.f, 0.f}, lane);
#pragma unroll
          for (int i = 0; i < 4; ++i) { const int t = mt * 16 + 4 * l4 + i, s = nt * 16 + l15;
              const float p = (s <= t) ? acc[i] * __expf(aS[t] + gS[s]) : 0.f; Ps[t * 72 + s] = (bf16)f2bf(p); } } }
    unsigned kreg[4][4];
#pragma unroll
    for (int i = 0; i < 4; ++i) { const int pair = tid + NTHREADS * i, d = pair & 255, sg = pair >> 8;
#pragma unroll
        for (int e = 0; e < 4; ++e) kreg[i][e] = (unsigned)Ks[(sg * 8 + 2 * e) * 264 + d] | ((unsigned)Ks[(sg * 8 + 2 * e + 1) * 264 + d] << 16); }
    __syncthreads();
#pragma unroll
    for (int i = 0; i < 4; ++i) { const int pair = tid + NTHREADS * i, d = pair & 255, sg = pair >> 8; v4u w;
        w.x = pk2(bflo(kreg[i][0]) * wkS[sg * 8 + 0], bfhi(kreg[i][0]) * wkS[sg * 8 + 1]); w.y = pk2(bflo(kreg[i][1]) * wkS[sg * 8 + 2], bfhi(kreg[i][1]) * wkS[sg * 8 + 3]);
        w.z = pk2(bflo(kreg[i][2]) * wkS[sg * 8 + 4], bfhi(kreg[i][2]) * wkS[sg * 8 + 5]); w.w = pk2(bflo(kreg[i][3]) * wkS[sg * 8 + 6], bfhi(kreg[i][3]) * wkS[sg * 8 + 7]);
        *(LAS v4u*)(Kw + d * 72 + sg * 8) = w; }
    { const int t = tid >> 3, sg = tid & 7; float ps = sum8bf(*(const LAS v4u*)(Ps + t * 72 + sg * 8));
      ps = sum8(ps);
      if (sg == 0) DENI[(size_t)(row0 + t) * 8 + h] = ps; }
    __syncthreads();
#define M1_NUMI(hf) do { const int tt = wave & 3, vbase = (wave >> 2) * 8; \
        _Pragma("unroll") for (int i = 0; i < 8; ++i) { const int vtile = vbase + i; \
            const f32x4 acc = mma_nt<64>(Vt + vtile * 16 * 72, 72, Ps + tt * 16 * 72, 72, (f32x4){0.f, 0.f, 0.f, 0.f}, lane); \
            v2u w_; w_.x = pk2(acc[0], acc[1]); w_.y = pk2(acc[2], acc[3]); \
            *(v2u*)(NUMI + (size_t)(row0 + tt * 16 + l15) * DM + h * 512 + (hf) * 256 + vtile * 16 + 4 * l4) = w_; } } while (0)
#define M1_VT_EXPORT(hf) do { _Pragma("unroll") for (int i = 0; i < 4; ++i) { const int pair = tid + NTHREADS * i, v = pair >> 3, sg = pair & 7; \
            *(v4u*)(VTG + (size_t)((hf) * 256 + v) * 64 + sg * 8) = *(const LAS v4u*)(Vt + v * 72 + sg * 8); } } while (0)
    M1_NUMI(0);
#pragma unroll
    for (int i = 0; i < 4; ++i) { const int pair = tid + NTHREADS * i, d = pair >> 3, sg = pair & 7; *(v4u*)(KWT + (size_t)d * 64 + sg * 8) = *(const LAS v4u*)(Kw + d * 72 + sg * 8); }
    if (tid < 256) { float s = 0.f;
#pragma unroll
        for (int i = 0; i < 8; ++i) s += sum8bf(*(const LAS v4u*)(Kw + tid * 72 + i * 8));
        KWS[(size_t)unit * 256 + tid] = s; }
    M1_VT_EXPORT(0);
    __syncthreads();
    M1_VT_WRITE(vr1);
    __syncthreads();
    M1_NUMI(1);
    M1_VT_EXPORT(1);
    __syncthreads();
#undef M1_VT_WRITE
#undef M1_NUMI
#undef M1_VT_EXPORT
}

constexpr int S1_C = 0, S1_B = 17408, S1_CB = 0, S1_BT = 34816, S1_XT = 53248, S1_DT = 126976, S1_AC = 129024;
__device__ __forceinline__ void s1_unit(const Args& A, LAS unsigned char* lds, int unit, int tid, int lane, int wave) {
    const int bg = unit >> 5, c = unit & 31, b = bg >> 3, g = bg & 7, row0 = b * SEQ + c * 64;
    LAS bf16* Cs = (LAS bf16*)(lds + S1_C); LAS bf16* Bs = (LAS bf16*)(lds + S1_B); LAS float* CBs = (LAS float*)(lds + S1_CB); LAS bf16* Bt = (LAS bf16*)(lds + S1_BT); LAS bf16* Xt = (LAS bf16*)(lds + S1_XT);
    LAS float* dtS = (LAS float*)(lds + S1_DT); LAS float* acS = (LAS float*)(lds + S1_AC);
    const bf16* XBC = (const bf16*)(A.ws + WS_XBC); const f32x2* SG = (const f32x2*)(A.ws + WS_SG);
    bf16* YI = (bf16*)(A.ws + WS_YI); bf16* BMT = (bf16*)(A.ws + WS_BMT) + (size_t)unit * 8192; bf16* XWT = (bf16*)(A.ws + WS_XWT);
    const int l4 = lane >> 4, l15 = lane & 15;
    v4u bmr[2], cmr[2], xr[8];
#pragma unroll
    for (int i = 0; i < 2; ++i) { const int piece = tid + NTHREADS * i, r = piece & 63, cc = piece >> 6;
        const bf16* sp = XBC + (size_t)(row0 + r) * 6144 + 4096 + g * 128 + cc * 8; bmr[i] = *(const v4u*)sp; cmr[i] = *(const v4u*)(sp + 1024); }
#pragma unroll
    for (int i = 0; i < 8; ++i) { const int piece = tid + NTHREADS * i, r = piece & 63, cc = piece >> 6; xr[i] = *(const v4u*)(XBC + (size_t)(row0 + r) * 6144 + g * 512 + cc * 8); }
    __builtin_amdgcn_sched_barrier(0);
#pragma unroll
    for (int i = 0; i < 2; ++i) { const int piece = tid + NTHREADS * i, r = piece & 63, cc = piece >> 6;
        const v4u bm = bmr[i], cm = cmr[i];
        *(LAS v4u*)(Cs + r * 136 + cc * 8) = cm; *(LAS v4u*)(Bs + r * 136 + cc * 8) = bm;
        const unsigned w[4] = {bm.x, bm.y, bm.z, bm.w};
#pragma unroll
        for (int e = 0; e < 4; ++e) { Bt[(cc * 8 + 2 * e) * 72 + r] = (bf16)(w[e] & 0xffffu); Bt[(cc * 8 + 2 * e + 1) * 72 + r] = (bf16)(w[e] >> 16); } }
#pragma unroll
    for (int i = 0; i < 8; ++i) { const int piece = tid + NTHREADS * i, r = piece & 63, cc = piece >> 6;
        const v4u xv = xr[i]; const unsigned w[4] = {xv.x, xv.y, xv.z, xv.w};
#pragma unroll
        for (int e = 0; e < 4; ++e) { Xt[(cc * 8 + 2 * e) * 72 + r] = (bf16)(w[e] & 0xffffu); Xt[(cc * 8 + 2 * e + 1) * 72 + r] = (bf16)(w[e] >> 16); } }
    { const int hh = tid >> 6, t = tid & 63; const f32x2 sg = SG[(size_t)(row0 + t) * 64 + g * 8 + hh]; dtS[hh * 64 + t] = sg[0]; acS[hh * 64 + t] = sg[1]; }
    __syncthreads();
    f32x4 cb[2];
    { const int mt = wave >> 1;
#pragma unroll
      for (int e = 0; e < 2; ++e) { const int nt = (wave & 1) * 2 + e; cb[e] = mma_nt<128>(Cs + mt * 16 * 136, 136, Bs + nt * 16 * 136, 136, (f32x4){0.f, 0.f, 0.f, 0.f}, lane); } }
    __syncthreads();
    { const int mt = wave >> 1;
#pragma unroll
      for (int e = 0; e < 2; ++e) { const int nt = (wave & 1) * 2 + e;
#pragma unroll
          for (int i = 0; i < 4; ++i) CBs[(mt * 16 + 4 * l4 + i) * 68 + nt * 16 + l15] = cb[e][i]; } }
#pragma unroll
    for (int i = 0; i < 2; ++i) { const int pair = tid + NTHREADS * i, n = pair >> 3, sg = pair & 7; *(v4u*)(BMT + (size_t)n * 64 + sg * 8) = *(const LAS v4u*)(Bt + n * 72 + sg * 8); }
    __syncthreads();
    { const int hh = wave, head = g * 8 + hh; const float a_end = acS[hh * 64 + 63];
      bf16* xw = XWT + (size_t)((b * 64 + head) * 32 + c) * 4096;
#pragma unroll
      for (int i = 0; i < 8; ++i) { const int piece = lane + 64 * i, p = piece >> 3, sg = piece & 7; const v4u xv = *(const LAS v4u*)(Xt + (hh * 64 + p) * 72 + sg * 8);
          float wg[8];
#pragma unroll
          for (int e = 0; e < 8; ++e) wg[e] = dtS[hh * 64 + sg * 8 + e] * __expf(a_end - acS[hh * 64 + sg * 8 + e]);
          v4u o; o.x = pk2(bflo(xv.x) * wg[0], bfhi(xv.x) * wg[1]); o.y = pk2(bflo(xv.y) * wg[2], bfhi(xv.y) * wg[3]); o.z = pk2(bflo(xv.z) * wg[4], bfhi(xv.z) * wg[5]); o.w = pk2(bflo(xv.w) * wg[6], bfhi(xv.w) * wg[7]);
          *(v4u*)(xw + (size_t)p * 64 + sg * 8) = o; }
#pragma unroll
      for (int tt = 0; tt < 4; ++tt) { const int t = tt * 16 + l15; const float act = acS[hh * 64 + t];
          bf16x8 Y[2];
#pragma unroll
          for (int ks = 0; ks < 2; ++ks) { const int s0 = 32 * ks + 8 * l4; const f32x4 c0 = *(const LAS f32x4*)(CBs + t * 68 + s0), c1 = *(const LAS f32x4*)(CBs + t * 68 + s0 + 4); float gv[8];
#pragma unroll
              for (int e = 0; e < 8; ++e) { const int s = s0 + e; const float cbv = e < 4 ? c0[e & 3] : c1[e & 3]; gv[e] = (s <= t) ? cbv * __expf(act - acS[hh * 64 + s]) * dtS[hh * 64 + s] : 0.f; }
              v4u yv; yv.x = pk2(gv[0], gv[1]); yv.y = pk2(gv[2], gv[3]); yv.z = pk2(gv[4], gv[5]); yv.w = pk2(gv[6], gv[7]); Y[ks] = as_bf16x8(yv); }
#pragma unroll
          for (int pt = 0; pt < 4; ++pt) { f32x4 acc = (f32x4){0.f, 0.f, 0.f, 0.f};
#pragma unroll
              for (int ks = 0; ks < 2; ++ks) acc = mfma16(*(const LAS bf16x8*)(Xt + (hh * 64 + pt * 16 + l15) * 72 + 32 * ks + 8 * l4), Y[ks], acc);
              v2u w; w.x = pk2(acc[0], acc[1]); w.y = pk2(acc[2], acc[3]);
              *(v2u*)(YI + (size_t)(row0 + t) * DM + head * 64 + pt * 16 + 4 * l4) = w; } } }
    __syncthreads();
}

__device__ __forceinline__ void nscan_item(const Args& A, int bh, int tid) {
    if (tid < 256) { const float* KWS = (const float*)(A.ws + WS_KWS); const f32x2* MPD = (const f32x2*)(A.ws + WS_MPD); float* NALL = (float*)(A.ws + WS_NALL);
        float kw[32], dc[32];
#pragma unroll
        for (int c = 0; c < 32; ++c) { kw[c] = KWS[(size_t)(bh * 32 + c) * 256 + tid]; dc[c] = MPD[bh * 32 + c][1]; }
        float n = 0.f;
#pragma unroll
        for (int c = 0; c < 32; ++c) { NALL[(size_t)(bh * 32 + c) * 256 + tid] = n; n = dc[c] * n + kw[c]; }
        A.out[O_PN + bh * 256 + tid] = n; }
}

constexpr int M2_Q = 0, M2_KW = 33792, M2_VT = 70656;
__device__ __forceinline__ void m2_item(const Args& A, LAS unsigned char* lds, int item, int tid, int lane, int wave) {
    const int bh = item >> 2, j = item & 3, b = bh >> 3, h = bh & 7;
    LAS bf16* Qs = (LAS bf16*)(lds + M2_Q); LAS bf16* Kw = (LAS bf16*)(lds + M2_KW); LAS bf16* Vt = (LAS bf16*)(lds + M2_VT);
    const bf16* QK = (const bf16*)(A.ws + WS_QK); const bf16* KWT = (const bf16*)(A.ws + WS_KWT); const bf16* VTG = (const bf16*)(A.ws + WS_VT); const f32x2* MPD = (const f32x2*)(A.ws + WS_MPD);
    bf16* INTER = (bf16*)(A.ws + WS_INTER); const bf16* NUMI = (const bf16*)(A.ws + WS_NUMI); const float* MGf = (const float*)(A.ws + WS_MG);
    const int l4 = lane >> 4, l15 = lane & 15;
    f32x4 acc[16];
#pragma unroll
    for (int i = 0; i < 16; ++i) acc[i] = (f32x4){0.f, 0.f, 0.f, 0.f};
    v4u rq[4], rk[4], rv[2]; float dnext;
#define M2_LOAD(cc_) do { const int r0_ = b * SEQ + (cc_) * 64; const size_t un_ = (size_t)(bh * 32 + (cc_)); \
        _Pragma("unroll") for (int i = 0; i < 4; ++i) { const int piece = tid + NTHREADS * i; rq[i] = *(const v4u*)(QK + (size_t)(r0_ + (piece >> 5)) * DM + h * 512 + (piece & 31) * 8); rk[i] = *(const v4u*)(KWT + un_ * 16384 + (size_t)piece * 8); } \
        _Pragma("unroll") for (int i = 0; i < 2; ++i) { const int piece = tid + NTHREADS * i; rv[i] = *(const v4u*)(VTG + un_ * 32768 + (size_t)(j * 128) * 64 + (size_t)piece * 8); } \
        dnext = MPD[un_][1]; } while (0)
    M2_LOAD(0);
    for (int c = 0; c < 32; ++c) {
        const int row0 = b * SEQ + c * 64;
#pragma unroll
        for (int i = 0; i < 4; ++i) { const int piece = tid + NTHREADS * i; *(LAS v4u*)(Qs + (piece >> 5) * 264 + (piece & 31) * 8) = rq[i]; *(LAS v4u*)(Kw + (piece >> 3) * 72 + (piece & 7) * 8) = rk[i]; }
#pragma unroll
        for (int i = 0; i < 2; ++i) { const int piece = tid + NTHREADS * i; *(LAS v4u*)(Vt + (piece >> 3) * 72 + (piece & 7) * 8) = rv[i]; }
        const float decay = dnext;
        v2u nI[4]; float gmx[4];
#pragma unroll
        for (int tt = 0; tt < 4; ++tt) { const size_t r_ = (size_t)(row0 + tt * 16 + l15); nI[tt] = *(const v2u*)(NUMI + r_ * DM + h * 512 + j * 128 + wave * 16 + 4 * l4); gmx[tt] = MGf[(r_ * 8 + h) * 4 + 2]; }
        const float mp = MPD[(size_t)(bh * 32 + c)][0];
        if (c < 31) M2_LOAD(c + 1);
        __syncthreads();
        f32x4 ia[4];
#pragma unroll
        for (int tt = 0; tt < 4; ++tt) ia[tt] = (f32x4){0.f, 0.f, 0.f, 0.f};
#pragma unroll
        for (int ks = 0; ks < 8; ++ks) { const bf16x8 X = as_bf16x8(pack8(acc[2 * ks], acc[2 * ks + 1]));
#pragma unroll
            for (int tt = 0; tt < 4; ++tt) { const LAS bf16* qp = Qs + (tt * 16 + l15) * 264 + 32 * ks + 4 * l4; const v2u y0 = *(const LAS v2u*)qp, y1 = *(const LAS v2u*)(qp + 16);
                ia[tt] = mfma16(X, as_bf16x8((v4u){y0.x, y0.y, y1.x, y1.y}), ia[tt]); } }
#pragma unroll
        for (int tt = 0; tt < 4; ++tt) { const float a = __expf(mp - fmaxf(mp, gmx[tt])); v2u w;
            w.x = pk2(bflo(nI[tt].x) + a * ia[tt][0], bfhi(nI[tt].x) + a * ia[tt][1]); w.y = pk2(bflo(nI[tt].y) + a * ia[tt][2], bfhi(nI[tt].y) + a * ia[tt][3]);
            *(v2u*)(INTER + (size_t)(row0 + tt * 16 + l15) * DM + h * 512 + j * 128 + wave * 16 + 4 * l4) = w; }
        bf16x8 yv[2];
#pragma unroll
        for (int ks = 0; ks < 2; ++ks) yv[ks] = *(const LAS bf16x8*)(Vt + (wave * 16 + l15) * 72 + ks * 32 + l4 * 8);
#pragma unroll
        for (int dt = 0; dt < 16; ++dt) { acc[dt] = acc[dt] * decay;
#pragma unroll
            for (int ks = 0; ks < 2; ++ks) acc[dt] = mfma16(*(const LAS bf16x8*)(Kw + (dt * 16 + l15) * 72 + ks * 32 + l4 * 8), yv[ks], acc[dt]); }
        __syncthreads();
    }
#undef M2_LOAD
    float* pC = A.out + O_PC + (size_t)(bh * 256) * 512 + j * 128 + wave * 16 + l15;
#pragma unroll
    for (int dt = 0; dt < 16; ++dt)
#pragma unroll
        for (int i = 0; i < 4; ++i) pC[(size_t)(dt * 16 + 4 * l4 + i) * 512] = acc[dt][i];
}

constexpr int S2_C = 0, S2_BT = 17408, S2_XW = 35840;
__device__ __forceinline__ void s2_item(const Args& A, LAS unsigned char* lds, int item, int tid, int lane, int wave) {
    const int b = item >> 5, pair = item & 31, hsel = wave >> 2, head = pair * 2 + hsel, g = pair >> 2, pt = wave & 3;
    LAS bf16* Cs = (LAS bf16*)(lds + S2_C); LAS bf16* Bt = (LAS bf16*)(lds + S2_BT); LAS bf16* Xw = (LAS bf16*)(lds + S2_XW);
    const bf16* XBC = (const bf16*)(A.ws + WS_XBC); const bf16* BMT = (const bf16*)(A.ws + WS_BMT); const bf16* XWT = (const bf16*)(A.ws + WS_XWT); const f32x2* SG = (const f32x2*)(A.ws + WS_SG);
    bf16* YS = (bf16*)(A.ws + WS_YS); const bf16* YI = (const bf16*)(A.ws + WS_YI);
    const int l4 = lane >> 4, l15 = lane & 15;
    f32x4 acc[8];
#pragma unroll
    for (int i = 0; i < 8; ++i) acc[i] = (f32x4){0.f, 0.f, 0.f, 0.f};
    v4u rcA[2], rbA[2], rxA[2], rcB[2], rbB[2], rxB[2]; float enA, enB;
    const int clo = (tid >> 4) * 6144 + (tid & 15) * 8, klo = tid * 8, slo = l15 * DM + 4 * l4;
#define S2_LOAD(cc_, rc, rb, rx, en) do { const int r0_ = b * SEQ + (cc_) * 64; \
        _Pragma("unroll") for (int i = 0; i < 2; ++i) { const bf16* cb_ = XBC + (size_t)(r0_ + 32 * i) * 6144 + 5120 + g * 128; const bf16* bb_ = BMT + (size_t)((b * 8 + g) * 32 + (cc_)) * 8192 + (size_t)(NTHREADS * i) * 8; \
            const bf16* xb_ = XWT + (size_t)((b * 64 + pair * 2 + i) * 32 + (cc_)) * 4096; rc[i] = *(const v4u*)(cb_ + clo); rb[i] = *(const v4u*)(bb_ + klo); rx[i] = *(const v4u*)(xb_ + klo); } \
        en = SG[(size_t)(r0_ + 63) * 64 + head][1]; } while (0)
#define S2_STEP(c, rc, rb, rx, en) do { \
        const int row0 = b * SEQ + (c) * 64; \
        _Pragma("unroll") for (int i = 0; i < 2; ++i) { const int piece = tid + NTHREADS * i; *(LAS v4u*)(Cs + (piece >> 4) * 136 + (piece & 15) * 8) = rc[i]; *(LAS v4u*)(Bt + (piece >> 3) * 72 + (piece & 7) * 8) = rb[i]; *(LAS v4u*)(Xw + (piece >> 3) * 72 + (piece & 7) * 8) = rx[i]; } \
        const float ea = __expf(en); \
        v2u yI_[4]; float act_[4]; \
        _Pragma("unroll") for (int tt = 0; tt < 4; ++tt) { const size_t r_ = (size_t)(row0 + tt * 16 + l15); yI_[tt] = *(const v2u*)(YI + r_ * DM + head * 64 + pt * 16 + 4 * l4); act_[tt] = SG[r_ * 64 + head][1]; } \
        if ((c) + 2 < 32) S2_LOAD((c) + 2, rc, rb, rx, en); \
        __syncthreads(); \
        f32x4 ia[4]; \
        _Pragma("unroll") for (int tt = 0; tt < 4; ++tt) ia[tt] = (f32x4){0.f, 0.f, 0.f, 0.f}; \
        _Pragma("unroll") for (int ks = 0; ks < 4; ++ks) { const bf16x8 X = as_bf16x8(pack8(acc[2 * ks], acc[2 * ks + 1])); \
            _Pragma("unroll") for (int tt = 0; tt < 4; ++tt) { const LAS bf16* cp = Cs + (tt * 16 + l15) * 136 + 32 * ks + 4 * l4; const v2u y0 = *(const LAS v2u*)cp, y1 = *(const LAS v2u*)(cp + 16); \
                ia[tt] = mfma16(X, as_bf16x8((v4u){y0.x, y0.y, y1.x, y1.y}), ia[tt]); } } \
        _Pragma("unroll") for (int tt = 0; tt < 4; ++tt) { const float e_ = __expf(act_[tt]); v2u w; \
            w.x = pk2(bflo(yI_[tt].x) + e_ * ia[tt][0], bfhi(yI_[tt].x) + e_ * ia[tt][1]); w.y = pk2(bflo(yI_[tt].y) + e_ * ia[tt][2], bfhi(yI_[tt].y) + e_ * ia[tt][3]); \
            bf16* yb_ = YS + (size_t)(row0 + tt * 16) * DM + head * 64 + pt * 16; *(v2u*)(yb_ + slo) = w; } \
        bf16x8 yv[2]; \
        _Pragma("unroll") for (int ks = 0; ks < 2; ++ks) yv[ks] = *(const LAS bf16x8*)(Xw + (hsel * 64 + pt * 16 + l15) * 72 + ks * 32 + l4 * 8); \
        _Pragma("unroll") for (int nt = 0; nt < 8; ++nt) { acc[nt] = acc[nt] * ea; \
            _Pragma("unroll") for (int ks = 0; ks < 2; ++ks) acc[nt] = mfma16(*(const LAS bf16x8*)(Bt + (nt * 16 + l15) * 72 + ks * 32 + l4 * 8), yv[ks], acc[nt]); } \
        __syncthreads(); } while (0)
    S2_LOAD(0, rcA, rbA, rxA, enA); S2_LOAD(1, rcB, rbB, rxB, enB);
    for (int c = 0; c < 32; c += 2) { S2_STEP(c, rcA, rbA, rxA, enA); S2_STEP(c + 1, rcB, rbB, rxB, enB); }
#undef S2_STEP
#undef S2_LOAD
    float* pH = A.out + O_PSSM + (size_t)((b * 64 + head) * 64 + pt * 16 + l15) * 128 + 4 * l4;
#pragma unroll
    for (int nt = 0; nt < 8; ++nt) *(f32x4*)(pH + nt * 16) = acc[nt];
}

struct M3In { v4u iw, ow, zw; v2u qw; f32x4 n4, mg, mn0, mn1; float mp, deni; };
__device__ __forceinline__ M3In m3_load(const Args& A, int it, int lane) {
    const bf16* INTER = (const bf16*)(A.ws + WS_INTER); const bf16* PROJ = (const bf16*)(A.ws + WS_PROJ); const bf16* QK = (const bf16*)(A.ws + WS_QK);
    const f32x4* MG = (const f32x4*)(A.ws + WS_MG); const f32x2* MPD = (const f32x2*)(A.ws + WS_MPD); const float* NALL = (const float*)(A.ws + WS_NALL); const float* DENI = (const float*)(A.ws + WS_DENI);
    const int row = it >> 3, h = it & 7, b = row >> 11, c = (row >> 6) & 31, unit = (b * 8 + h) * 32 + c, col = h * 512 + lane * 8; M3In d;
    d.iw = *(const v4u*)(INTER + (size_t)row * DM + col);
    d.ow = *(const v4u*)(PROJ + (size_t)row * NPROJ + 8192 + col); d.zw = *(const v4u*)(PROJ + (size_t)row * NPROJ + 12288 + col);
    d.qw = *(const v2u*)(QK + (size_t)row * DM + h * 512 + lane * 4); d.n4 = *(const f32x4*)(NALL + (size_t)unit * 256 + lane * 4);
    d.mg = MG[(size_t)row * 8 + h]; d.mp = MPD[unit][0]; d.deni = DENI[(size_t)row * 8 + h];
    d.mn0 = *(const f32x4*)(A.in[I_MNORM] + col); d.mn1 = *(const f32x4*)(A.in[I_MNORM] + col + 4); return d;
}
__device__ __forceinline__ void m3_compute(const Args& A, const M3In& d, int it, int lane) {
    bf16* MIX = (bf16*)(A.ws + WS_MIX); const int row = it >> 3, h = it & 7, col = h * 512 + lane * 8;
    const float mm = fmaxf(d.mp, d.mg[2]), a = __expf(d.mp - mm), ex = __expf(-mm - d.mg[0]);
    const float qn = wave_sum((bflo(d.qw.x) * d.n4[0] + bfhi(d.qw.x) * d.n4[1]) + (bflo(d.qw.y) * d.n4[2] + bfhi(d.qw.y) * d.n4[3]));
    const float dn = fmaxf(fabsf(d.deni + a * qn), ex), rdn = 1.f / dn;
    const float iv[8] = {bflo(d.iw.x), bfhi(d.iw.x), bflo(d.iw.y), bfhi(d.iw.y), bflo(d.iw.z), bfhi(d.iw.z), bflo(d.iw.w), bfhi(d.iw.w)};
    const float ov[8] = {bflo(d.ow.x), bfhi(d.ow.x), bflo(d.ow.y), bfhi(d.ow.y), bflo(d.ow.z), bfhi(d.ow.z), bflo(d.ow.w), bfhi(d.ow.w)};
    const float zv[8] = {bflo(d.zw.x), bfhi(d.zw.x), bflo(d.zw.y), bfhi(d.zw.y), bflo(d.zw.z), bfhi(d.zw.z), bflo(d.zw.w), bfhi(d.zw.w)};
    const float mn[8] = {d.mn0[0], d.mn0[1], d.mn0[2], d.mn0[3], d.mn1[0], d.mn1[1], d.mn1[2], d.mn1[3]};
    float pre[8], ss = 0.f;
#pragma unroll
    for (int e = 0; e < 8; ++e) { pre[e] = iv[e] * rdn * sigm(ov[e]); ss += pre[e] * pre[e]; }
    const float rstd = rsqrtf(wave_sum(ss) * (1.f / 512.f) + EPS);
    float val[8];
#pragma unroll
    for (int e = 0; e < 8; ++e) val[e] = pre[e] * rstd * mn[e] * silu(zv[e]);
    v4u o; o.x = pk2(val[0], val[1]); o.y = pk2(val[2], val[3]); o.z = pk2(val[4], val[5]); o.w = pk2(val[6], val[7]);
    *(v4u*)(MIX + (size_t)row * LDM + col) = o;
}
__device__ __forceinline__ void m3_pass(const Args& A, int gw, int NGW, int lane) {
    int it = gw; if (it >= MPR * 8) return;
    M3In cur = m3_load(A, it, lane);
    for (;;) { const int nit = it + NGW; const bool has = nit < MPR * 8; M3In nxt; if (has) nxt = m3_load(A, nit, lane);
        m3_compute(A, cur, it, lane); if (!has) break; cur = nxt; it = nit; }
}
struct S3In { v4u ys, xw, zw; f32x4 sn0, sn1; float dsk; };
__device__ __forceinline__ S3In s3_load(const Args& A, int it, int lane) {
    const bf16* YS = (const bf16*)(A.ws + WS_YS); const bf16* PROJ = (const bf16*)(A.ws + WS_PROJ); const bf16* XBC = (const bf16*)(A.ws + WS_XBC);
    const int row = it >> 3, g = it & 7, col = g * 512 + lane * 8, head = g * 8 + (lane >> 3); S3In d;
    d.ys = *(const v4u*)(YS + (size_t)row * DM + col);
    d.xw = *(const v4u*)(XBC + (size_t)row * 6144 + col); d.zw = *(const v4u*)(PROJ + (size_t)row * NPROJ + 16384 + col);
    d.dsk = A.in[I_DSKIP][head];
    d.sn0 = *(const f32x4*)(A.in[I_SNORM] + col); d.sn1 = *(const f32x4*)(A.in[I_SNORM] + col + 4); return d;
}
__device__ __forceinline__ void s3_compute(const Args& A, const S3In& d, int it, int lane) {
    bf16* MIX = (bf16*)(A.ws + WS_MIX); const int row = it >> 3, g = it & 7, col = g * 512 + lane * 8;
    const float a2[8] = {bflo(d.ys.x), bfhi(d.ys.x), bflo(d.ys.y), bfhi(d.ys.y), bflo(d.ys.z), bfhi(d.ys.z), bflo(d.ys.w), bfhi(d.ys.w)};
    const float xv[8] = {bflo(d.xw.x), bfhi(d.xw.x), bflo(d.xw.y), bfhi(d.xw.y), bflo(d.xw.z), bfhi(d.xw.z), bflo(d.xw.w), bfhi(d.xw.w)};
    const float zv[8] = {bflo(d.zw.x), bfhi(d.zw.x), bflo(d.zw.y), bfhi(d.zw.y), bflo(d.zw.z), bfhi(d.zw.z), bflo(d.zw.w), bfhi(d.zw.w)};
    const float sn[8] = {d.sn0[0], d.sn0[1], d.sn0[2], d.sn0[3], d.sn1[0], d.sn1[1], d.sn1[2], d.sn1[3]};
    float pre[8], ss = 0.f;
#pragma unroll
    for (int e = 0; e < 8; ++e) { pre[e] = (a2[e] + d.dsk * xv[e]) * silu(zv[e]); ss += pre[e] * pre[e]; }
    const float rstd = rsqrtf(wave_sum(ss) * (1.f / 512.f) + EPS);
    v4u o; o.x = pk2(pre[0] * rstd * sn[0], pre[1] * rstd * sn[1]); o.y = pk2(pre[2] * rstd * sn[2], pre[3] * rstd * sn[3]); o.z = pk2(pre[4] * rstd * sn[4], pre[5] * rstd * sn[5]); o.w = pk2(pre[6] * rstd * sn[6], pre[7] * rstd * sn[7]);
    *(v4u*)(MIX + (size_t)row * LDM + 4096 + col) = o;
}
__device__ __forceinline__ void s3_pass(const Args& A, int gw, int NGW, int lane) {
    int it = gw; if (it >= MPR * 8) return;
    S3In cur = s3_load(A, it, lane);
    for (;;) { const int nit = it + NGW; const bool has = nit < MPR * 8; S3In nxt; if (has) nxt = s3_load(A, nit, lane);
        s3_compute(A, cur, it, lane); if (!has) break; cur = nxt; it = nit; }
}

__device__ __forceinline__ void mlstm_sample_item(const Args& A, LAS unsigned char* lds, int item, int tid, int lane, int wave) {
    const int seq = item >> 3, h = item & 7;
    LAS float* qT = (LAS float*)lds; LAS float* kT = qT + 1024; LAS float* kwT = qT + 2048; LAS float* vS = qT + 3072; LAS float* n0S = qT + 5120; LAS float* gt = qT + 5376;
    LAS float* SSd = qT + 5408; LAS float* PSd = qT + 5440; LAS float* denS = qT + 5472; LAS float* wkS = qT + 5480; LAS float* ssS = qT + 5488; LAS float* accl = qT + 6144;
    const bf16* QK = (const bf16*)(A.ws + WS_QK); const bf16* PROJ = (const bf16*)(A.ws + WS_PROJ); const float* MG = (const float*)(A.ws + WS_MG);
    bf16* MIX = (bf16*)(A.ws + WS_MIX); const float* mnorm = A.in[I_MNORM];
    const int rowb = MPR + seq * 4;
    { const int idx = tid * 2, t = idx >> 8, d = idx & 255; const bf16* sp = QK + (size_t)(rowb + t) * DM + h * 512 + d;
      const unsigned qw = *(const unsigned*)sp, kw = *(const unsigned*)(sp + 256);
      qT[d * 4 + t] = bflo(qw); qT[(d + 1) * 4 + t] = bfhi(qw); kT[d * 4 + t] = bflo(kw); kT[(d + 1) * 4 + t] = bfhi(kw); }
    { const int idx = tid * 4, t = idx >> 9, v = idx & 511; const v2u vw = *(const v2u*)(PROJ + (size_t)(rowb + t) * NPROJ + 4096 + h * 512 + v);
      *(LAS f32x4*)(vS + t * 512 + v) = (f32x4){bflo(vw.x), bfhi(vw.x), bflo(vw.y), bfhi(vw.y)}; }
    if (tid < 256) n0S[tid] = A.in[I_MN][(size_t)(seq * 8 + h) * 256 + tid];
    if (tid < 16) { const int comp = tid >> 2, t = tid & 3; gt[comp * 4 + t] = MG[((size_t)(rowb + t) * 8 + h) * 4 + comp]; }
    __syncthreads();
    for (int pp = wave; pp < 20; pp += NWAVES) { float part = 0.f;
        if (pp < 16) { const int t = pp >> 2, s = pp & 3;
#pragma unroll
            for (int i = 0; i < 4; ++i) part += qT[(lane + 64 * i) * 4 + t] * kT[(lane + 64 * i) * 4 + s]; }
        else { const int t = pp - 16;
#pragma unroll
            for (int i = 0; i < 4; ++i) part += qT[(lane + 64 * i) * 4 + t] * n0S[lane + 64 * i]; }
        part = wave_sum(part); if (lane == 0) SSd[pp] = part; }
    __syncthreads();
    if (tid < 16) { const int t = tid >> 2, s = tid & 3; PSd[tid] = (s <= t) ? SSd[tid] * __expf(gt[t] + gt[4 + s]) : 0.f; }
    if (tid >= 64 && tid < 68) { const int s = tid - 64; wkS[s] = __expf(gt[3] + gt[4 + s]); }
    __syncthreads();
    if (tid < 4) denS[tid] = (PSd[tid * 4] + PSd[tid * 4 + 1]) + (PSd[tid * 4 + 2] + PSd[tid * 4 + 3]) + gt[8 + tid] * SSd[16 + tid];
    { const int i0 = tid * 2; kwT[i0] = kT[i0] * wkS[i0 & 3]; kwT[i0 + 1] = kT[i0 + 1] * wkS[(i0 + 1) & 3]; }
    __syncthreads();
    const float decay = gt[8 + 3];
    const int dr = wave >> 1, v4 = (tid & 127) * 4;
    f32x4 vv[4], acc[4];
#pragma unroll
    for (int s = 0; s < 4; ++s) { vv[s] = *(const LAS f32x4*)(vS + s * 512 + v4); acc[s] = (f32x4){0.f, 0.f, 0.f, 0.f}; }
    const float* C0 = A.in[I_MC] + (size_t)((seq * 8 + h) * 256 + dr) * 512; float* C1 = A.out + O_SC + (size_t)((seq * 8 + h) * 256 + dr) * 512;
    f32x4 cbuf[2][8];
#pragma unroll
    for (int r = 0; r < 8; ++r) { const float* rp = C0 + (size_t)(4 * r) * 512; cbuf[0][r] = __builtin_nontemporal_load((const f32x4*)(rp + v4)); }
#pragma unroll
    for (int bt = 0; bt < 8; ++bt) {
        if (bt < 7) {
#pragma unroll
            for (int r = 0; r < 8; ++r) { const float* rp = C0 + (size_t)(4 * ((bt + 1) * 8 + r)) * 512; cbuf[(bt + 1) & 1][r] = __builtin_nontemporal_load((const f32x4*)(rp + v4)); } }
#pragma unroll
        for (int r = 0; r < 8; ++r) { const int d = dr + 4 * (bt * 8 + r); const f32x4 c0 = cbuf[bt & 1][r];
            const f32x4 q4 = *(const LAS f32x4*)(qT + d * 4), kw4 = *(const LAS f32x4*)(kwT + d * 4);
#pragma unroll
            for (int t = 0; t < 4; ++t) acc[t] += q4[t] * c0;
            const f32x4 cn = decay * c0 + kw4[0] * vv[0] + kw4[1] * vv[1] + kw4[2] * vv[2] + kw4[3] * vv[3];
            { float* wp = C1 + (size_t)(4 * (bt * 8 + r)) * 512; __builtin_nontemporal_store(cn, (f32x4*)(wp + v4)); } } }
#pragma unroll
    for (int t = 0; t < 4; ++t) *(LAS f32x4*)(accl + (dr * 4 + t) * 512 + v4) = acc[t];
    __syncthreads();
    float val[4];
    { const int t = dr; f32x4 a = (f32x4){0.f, 0.f, 0.f, 0.f};
#pragma unroll
      for (int r = 0; r < 4; ++r) a += *(const LAS f32x4*)(accl + (r * 4 + t) * 512 + v4);
      f32x4 num = gt[8 + t] * a;
#pragma unroll
      for (int s = 0; s < 4; ++s) num += PSd[t * 4 + s] * vv[s];
      const float dn = fmaxf(fabsf(denS[t]), gt[12 + t]); const int row = rowb + t, col = h * 512 + v4;
      const v2u ow = *(const v2u*)(PROJ + (size_t)row * NPROJ + 8192 + col), zw = *(const v2u*)(PROJ + (size_t)row * NPROJ + 12288 + col);
      const f32x4 o4 = (f32x4){bflo(ow.x), bfhi(ow.x), bflo(ow.y), bfhi(ow.y)}, z4 = (f32x4){bflo(zw.x), bfhi(zw.x), bflo(zw.y), bfhi(zw.y)}; const f32x4 mn = *(const f32x4*)(mnorm + col);
      f32x4 pre; float ss = 0.f;
#pragma unroll
      for (int e = 0; e < 4; ++e) { pre[e] = (num[e] / dn) * sigm(o4[e]); ss += pre[e] * pre[e]; val[e] = pre[e] * mn[e] * silu(z4[e]); }
      ss = wave_sum(ss); if (lane == 0) ssS[wave] = ss; }
    __syncthreads();
    { const float rstd = rsqrtf((ssS[2 * dr] + ssS[2 * dr + 1]) * (1.f / 512.f) + EPS);
      v2u w; w.x = pk2(val[0] * rstd, val[1] * rstd); w.y = pk2(val[2] * rstd, val[3] * rstd); *(v2u*)(MIX + (size_t)(rowb + dr) * LDM + h * 512 + v4) = w; }
    if (tid < 256) { const f32x4 kw = *(const LAS f32x4*)(kwT + tid * 4); A.out[O_SN + (size_t)(seq * 8 + h) * 256 + tid] = decay * n0S[tid] + ((kw[0] + kw[1]) + (kw[2] + kw[3])); }
    __syncthreads();
}

__device__ __forceinline__ void ssd_sample_item(const Args& A, LAS unsigned char* lds, int item, int tid, int lane, int wave) {
    const int seq = item >> 3, gi = item & 7, hd = gi * 8 + wave;
    LAS float* Cf = (LAS float*)lds; LAS float* Bf = Cf + 512; LAS float* xf = Cf + 1024; LAS float* dtS = Cf + 3072; LAS float* acS = Cf + 3104; LAS float* CBs = Cf + 3136;
    LAS float* xw = Cf + 3200; LAS float* yp = Cf + 5248; LAS float* ssS = Cf + 7296;
    const bf16* XBC = (const bf16*)(A.ws + WS_XBC); const bf16* PROJ = (const bf16*)(A.ws + WS_PROJ); const f32x2* SG = (const f32x2*)(A.ws + WS_SG);
    bf16* MIX = (bf16*)(A.ws + WS_MIX); const float* snorm = A.in[I_SNORM];
    const int rowb = MPR + seq * 4;
    { const int t = tid >> 7, n = tid & 127; const bf16* sp = XBC + (size_t)(rowb + t) * 6144 + 4096 + gi * 128 + n; Bf[t * 128 + n] = bf2f(sp[0]); Cf[t * 128 + n] = bf2f(sp[1024]); }
    { const int idx = tid * 4, t = idx >> 9, cidx = idx & 511; const v2u xv = *(const v2u*)(XBC + (size_t)(rowb + t) * 6144 + gi * 512 + cidx);
      *(LAS f32x4*)(xf + t * 512 + cidx) = (f32x4){bflo(xv.x), bfhi(xv.x), bflo(xv.y), bfhi(xv.y)}; }
    if (tid < 32) { const int hh = tid >> 2, t = tid & 3; const f32x2 sg = SG[(size_t)(rowb + t) * 64 + gi * 8 + hh]; dtS[hh * 4 + t] = sg[0]; acS[hh * 4 + t] = sg[1]; }
    __syncthreads();
#pragma unroll
    for (int e = 0; e < 2; ++e) { const int pp = wave * 2 + e, t = pp >> 2, s = pp & 3;
        float part = Cf[t * 128 + lane] * Bf[s * 128 + lane] + Cf[t * 128 + 64 + lane] * Bf[s * 128 + 64 + lane];
        part = wave_sum(part); if (lane == 0) CBs[pp] = part; }
#pragma unroll
    for (int i = 0; i < 4; ++i) { const int idx = tid + NTHREADS * i, hh = idx >> 8, p = (idx >> 2) & 63, s = idx & 3;
        xw[idx] = xf[s * 512 + hh * 64 + p] * dtS[hh * 4 + s] * __expf(acS[hh * 4 + 3] - acS[hh * 4 + s]); }
    __syncthreads();
    { const int n4 = (lane & 31) * 4, half = lane >> 5; f32x4 c4[4], b4[4];
#pragma unroll
      for (int t = 0; t < 4; ++t) { c4[t] = *(const LAS f32x4*)(Cf + t * 128 + n4); b4[t] = *(const LAS f32x4*)(Bf + t * 128 + n4); }
      const float ea = __expf(acS[wave * 4 + 3]);
      const float* H0 = A.in[I_SSSM] + (size_t)((seq * 64 + hd) * 64) * 128; float* H1 = A.out + O_SSSM + (size_t)((seq * 64 + hd) * 64) * 128; const int hoff = half * 128 + n4;
      f32x4 hbuf[2][8];
#pragma unroll
      for (int r = 0; r < 8; ++r) { const float* rp = H0 + (size_t)(2 * r) * 128; hbuf[0][r] = __builtin_nontemporal_load((const f32x4*)(rp + hoff)); }
#pragma unroll
      for (int bt = 0; bt < 4; ++bt) {
          if (bt < 3) {
#pragma unroll
              for (int r = 0; r < 8; ++r) { const float* rp = H0 + (size_t)(2 * ((bt + 1) * 8 + r)) * 128; hbuf[(bt + 1) & 1][r] = __builtin_nontemporal_load((const f32x4*)(rp + hoff)); } }
#pragma unroll
          for (int r = 0; r < 8; ++r) { const int p = half + 2 * (bt * 8 + r); const f32x4 h4 = hbuf[bt & 1][r];
              const f32x4 xw4 = *(const LAS f32x4*)(xw + (wave * 64 + p) * 4);
              const f32x4 hn = ea * h4 + xw4[0] * b4[0] + xw4[1] * b4[1] + xw4[2] * b4[2] + xw4[3] * b4[3];
              { float* wp = H1 + (size_t)(2 * (bt * 8 + r)) * 128; __builtin_nontemporal_store(hn, (f32x4*)(wp + hoff)); }
              float part[4];
#pragma unroll
              for (int t = 0; t < 4; ++t) { part[t] = (c4[t][0] * h4[0] + c4[t][1] * h4[1]) + (c4[t][2] * h4[2] + c4[t][3] * h4[3]);
                  part[t] = sum32_hi(part[t]); }
              if ((lane & 31) == 31) {
#pragma unroll
                  for (int t = 0; t < 4; ++t) yp[(wave * 4 + t) * 64 + p] = part[t]; } } } }
    __syncthreads();
    { const int p = lane; const float dskip = A.in[I_DSKIP][hd]; float pre[4];
#pragma unroll
      for (int t = 0; t < 4; ++t) { float y = __expf(acS[wave * 4 + t]) * yp[(wave * 4 + t) * 64 + p];
#pragma unroll
          for (int s = 0; s < 4; ++s) if (s <= t) y += CBs[t * 4 + s] * __expf(acS[wave * 4 + t] - acS[wave * 4 + s]) * dtS[wave * 4 + s] * xf[s * 512 + wave * 64 + p];
          y += dskip * xf[t * 512 + wave * 64 + p];
          const int row = rowb + t, col = hd * 64 + p; const float z = bf2f(PROJ[(size_t)row * NPROJ + 16384 + col]); pre[t] = y * silu(z);
          const float ss = wave_sum(pre[t] * pre[t]); if (lane == 0) ssS[wave * 4 + t] = ss; }
      __syncthreads();
#pragma unroll
      for (int t = 0; t < 4; ++t) { float tot = 0.f;
#pragma unroll
          for (int w = 0; w < 8; ++w) tot += ssS[w * 4 + t];
          const float rstd = rsqrtf(tot * (1.f / 512.f) + EPS); const int col = hd * 64 + p;
          MIX[(size_t)(rowb + t) * LDM + 4096 + col] = (bf16)f2bf(pre[t] * rstd * snorm[col]); } }
    __syncthreads();
}


__global__ void __launch_bounds__(NTHREADS, 2) mk_fwd(Args args) {
    extern __shared__ __attribute__((aligned(16))) unsigned char lds_raw[];
    LAS unsigned char* lds = (LAS unsigned char*)lds_raw;
    volatile LAS unsigned* MISC = (volatile LAS unsigned*)(lds + LDSCTL_OFF);
    const int tid = threadIdx.x, lane = tid & 63, wave = __builtin_amdgcn_readfirstlane(tid >> 6);
    const int G = gridDim.x, bid = blockIdx.x;
    const int gw = bid * NWAVES + wave, NGW = G * NWAVES, gt = bid * NTHREADS + tid, NGT = G * NTHREADS;
    unsigned char* ws = args.ws;
    unsigned* ctl = (unsigned*)(ws + WS_CTL);
    if (tid < 64) MISC[tid] = 0u;
    __syncthreads();
    XcdBarrier bar; bar.bar = ctl + CW_BAR; bar.x = 0; bar.st = nullptr;
    if (MK_N_LAUNCHES == 1) bar = xcd_barrier_post(ctl + CW_BAR, MISC + 8);
#define GRID_BAR() do { if (MK_N_LAUNCHES == 1) xcd_barrier(bar); } while (0)
#define Q_NEXT(ctr_, dst_) do { __syncthreads(); if (tid == 0) MISC[16] = atomicAdd((ctr_), 1u); __syncthreads(); (dst_) = (int)MISC[16]; } while (0)
    const int lo = args.ph_lo, hi = args.ph_hi;
#define IN(k) (lo <= (k) && (k) < hi)
#define BOTH(k) (IN(k) && IN((k) + 1))

    if (IN(0)) {
#pragma nounroll
        for (int rep = 0; rep < (PROBE_DUP == 0 ? 2 : 1); ++rep) p0_prologue(args, lds, gw, NGW, lane, wave);
        if (BOTH(0)) GRID_BAR(); }
    if (IN(1)) {
        pg8::Gemm g{(const bf16*)(ws + WS_XN), (const bf16*)(ws + WS_W1T), LDX, LDX, DM}; pg8::Order S; S.init(MTOK / 256, NW1 / 256, G, bid, 0, 0, PROBE_DUP == 1 ? 2 : 1); S.quad = 1;
        pg8::EpiProj E{(bf16*)(ws + WS_PROJ), (float*)(ws + WS_GATES)};
        pg8::gemm_phase<pg8::EpiProj, pg8::Order>(lds, g, S, E);
        if (BOTH(1)) GRID_BAR();
    }
    if (IN(2)) {
        const bf16* PROJ = (const bf16*)(ws + WS_PROJ);
#pragma nounroll
        for (int rep = 0; rep < (PROBE_DUP == 2 ? 2 : 1); ++rep) {
        gate_scans(args, gw, NGW, lane);
        conv_part<4096, 16, true>(PROJ, nullptr, args.in[I_MCW], args.in[I_MCB], (bf16*)(ws + WS_UC), LDX, args.out + O_PMCONV, gt, NGT);
        conv_part<4096, 4, false>(PROJ, args.in[I_MCONV], args.in[I_MCW], args.in[I_MCB], (bf16*)(ws + WS_UC), LDX, args.out + O_SMCONV, gt, NGT);
        conv_part<6144, 16, true>(PROJ + 20480, nullptr, args.in[I_SCW], args.in[I_SCB], (bf16*)(ws + WS_XBC), 6144, args.out + O_PSCONV, gt, NGT);
        conv_part<6144, 4, false>(PROJ + 20480, args.in[I_SCONV], args.in[I_SCW], args.in[I_SCB], (bf16*)(ws + WS_XBC), 6144, args.out + O_SSCONV, gt, NGT); }
        if (BOTH(2)) GRID_BAR();
    }
    if (IN(3)) {
        if (bid == 0 && wave == 0) mlstm_m_carry(args, lane);
        { pg8::Gemm g{(const bf16*)(ws + WS_UC), (const bf16*)(ws + WS_WQK), LDX, LDQ, 512}; pg8::Order S; S.init(MTOK / 256, 16, G, bid, 1, 512, PROBE_DUP == 3 ? 2 : 1);
          pg8::EpiBf16 E{(bf16*)(ws + WS_QK), DM};
          pg8::gemm_phase<pg8::EpiBf16, pg8::Order>(lds, g, S, E); }
        { pg8::Gemm g{(const bf16*)(ws + WS_PB), (const bf16*)(ws + WS_WPT), LDP, LDP, 256}; pg8::Order S; S.init(MTOK / 256, 16, G, bid, 0, 0, PROBE_DUP == 3 ? 2 : 1);
          pg8::EpiBf16 E{(bf16*)(ws + WS_PPB), DM};
          pg8::gemm_phase<pg8::EpiBf16, pg8::Order>(lds, g, S, E); }
        if (BOTH(3)) GRID_BAR();
    }
    if (IN(4)) {
        for (;;) { int it; Q_NEXT(ctl + CW_Q4, it); if (it >= 1024 * (PROBE_DUP == 40 ? 2 : 1)) break; m1_unit(args, lds, it & 1023, tid, lane, wave); }
        for (;;) { int it; Q_NEXT(ctl + CW_Q4 + 64, it); if (it >= 1024 * (PROBE_DUP == 41 ? 2 : 1)) break; s1_unit(args, lds, it & 1023, tid, lane, wave); }
        if (BOTH(4)) GRID_BAR();
    }
    if (IN(5)) {
        if (bid >= G - 32) nscan_item(args, bid - (G - 32), tid);
        if (G == 256) {
            if (bid < 128) { const int x = bid & 7, k = bid >> 3;
                m2_item(args, lds, (x * 4 + (k >> 2)) * 4 + (k & 3), tid, lane, wave);
                s2_item(args, lds, x * 16 + k, tid, lane, wave); }
        } else
        for (;;) { int it; Q_NEXT(ctl + CW_Q5, it); if (it >= 256) break;
            if (it < 128) m2_item(args, lds, it, tid, lane, wave); else s2_item(args, lds, it - 128, tid, lane, wave); }
        for (;;) { int it; Q_NEXT(ctl + CW_Q5 + 64, it); if (it >= 1024 * (PROBE_DUP == 52 ? 2 : 1)) break; mlstm_sample_item(args, lds, it & 1023, tid, lane, wave); }
        for (;;) { int it; Q_NEXT(ctl + CW_Q5 + 128, it); if (it >= 1024 * (PROBE_DUP == 53 ? 2 : 1)) break; ssd_sample_item(args, lds, it & 1023, tid, lane, wave); }
        if (BOTH(5)) GRID_BAR();
    }
    if (IN(6)) {
#pragma nounroll
        for (int rep = 0; rep < (PROBE_DUP == 6 ? 2 : 1); ++rep) { m3_pass(args, gw, NGW, lane); s3_pass(args, gw, NGW, lane); }
        if (BOTH(6)) GRID_BAR();
    }
    if (IN(7)) {
        { pg8::Gemm g{(const bf16*)(ws + WS_MIX), (const bf16*)(ws + WS_W2T), LDM, LDM, 8192}; pg8::Order S; S.init(MPR / 256, 16, G, bid, 0, 0, PROBE_DUP == 7 ? 2 : 1);
          pg8::EpiX1 E{args.in[I_XP], args.in[I_XS], args.in[I_PLENORM], (float*)(ws + WS_X1), (bf16*)(ws + WS_X1G), (float*)(ws + WS_RS1), PROBE_DUP == 7 ? 0.5f : 1.f};
          pg8::gemm_phase<pg8::EpiX1, pg8::Order>(lds, g, S, E); }
        { pg8::Gemm g{(const bf16*)(ws + WS_MIX), (const bf16*)(ws + WS_W2T), LDM, LDM, 1024}; pg8::SplitOrder S{G, bid, MPR / 256, 1024};
          pg8::EpiSlab E{(float*)(ws + WS_SLAB2)};
          pg8::gemm_phase<pg8::EpiSlab, pg8::SplitOrder>(lds, g, S, E); }
        if (BOTH(7)) GRID_BAR();
    }
    if (IN(8)) {
        { const float* SL = (const float*)(ws + WS_SLAB2); const float* gn = args.in[I_PLENORM]; float* X1 = (float*)(ws + WS_X1); bf16* X1G = (bf16*)(ws + WS_X1G); float* RS1 = (float*)(ws + WS_RS1);
          for (int it = gw; it < 512 * 4; it += NGW) { const int rl = it >> 2, qd = it & 3, row = MPR + rl; float ss = 0.f;
#pragma unroll
              for (int j = 0; j < 4; ++j) { const int c = qd * 1024 + j * 256 + lane * 4; f32x4 v = *(const f32x4*)(args.in[I_XS] + (size_t)rl * DM + c);
#pragma unroll
                  for (int ks = 0; ks < 8; ++ks) v += *(const f32x4*)(SL + ((size_t)ks * 512 + rl) * DM + c);
                  *(f32x4*)(X1 + (size_t)row * DM + c) = v; ss += (v[0] * v[0] + v[1] * v[1]) + (v[2] * v[2] + v[3] * v[3]);
                  const f32x4 gv = *(const f32x4*)(gn + c); v2u w; w.x = pk2(v[0] * gv[0], v[1] * gv[1]); w.y = pk2(v[2] * gv[2], v[3] * gv[3]); *(v2u*)(X1G + (size_t)row * LDX + c) = w; }
              ss = wave_sum(ss); if (lane == 0) atomicAdd(RS1 + row, ss); } }
        { pg8::Gemm g{(const bf16*)(ws + WS_X1G), (const bf16*)(ws + WS_WGT), LDX, LDX, DM}; pg8::Order S; S.init(MPR / 256, 16, G, bid, 0, 0, PROBE_DUP == 8 ? 2 : 1);
          pg8::EpiGate E{(const float*)(ws + WS_X1), (const bf16*)(ws + WS_PPB), (const float*)(ws + WS_RS1), args.out + O_Y, (float*)(ws + WS_RS2), PROBE_DUP == 8 ? 0.5f : 1.f};
          pg8::gemm_phase<pg8::EpiGate, pg8::Order>(lds, g, S, E); }
        if (BOTH(8)) GRID_BAR();
    }
    if (IN(9)) {
        pg8::Gemm g{(const bf16*)(ws + WS_X1G), (const bf16*)(ws + WS_WGT), LDX, LDX, 512}; pg8::SplitOrder S{G, bid, MPR / 256, 512};
        pg8::EpiSlab E{(float*)(ws + WS_SLAB3)};
        pg8::gemm_phase<pg8::EpiSlab, pg8::SplitOrder>(lds, g, S, E);
        if (BOTH(9)) GRID_BAR();
    }
    if (IN(10)) {
        const float* RS1 = (const float*)(ws + WS_RS1); const float* RS2 = (const float*)(ws + WS_RS2); const float* fn = args.in[I_FNORM]; float* Y = args.out + O_Y;
        { const float* SL = (const float*)(ws + WS_SLAB3); const float* X1 = (const float*)(ws + WS_X1); const bf16* PP = (const bf16*)(ws + WS_PPB);
          for (int rl = gw; rl < 512; rl += NGW) { const int row = MPR + rl; const float rstd1 = rsqrtf(RS1[row] * (1.f / DM) + EPS); f32x4 x2[16]; float ss = 0.f;
#pragma unroll
              for (int j = 0; j < 16; ++j) { const int c = j * 256 + lane * 4; f32x4 a = *(const f32x4*)(SL + (size_t)rl * DM + c);
#pragma unroll
                  for (int ks = 1; ks < 8; ++ks) a += *(const f32x4*)(SL + ((size_t)ks * 512 + rl) * DM + c);
                  const v2u pw = *(const v2u*)(PP + (size_t)row * DM + c); const f32x4 x1 = *(const f32x4*)(X1 + (size_t)row * DM + c); a = a * rstd1; f32x4 v;
                  v[0] = x1[0] + sigm(a[0]) * bflo(pw.x); v[1] = x1[1] + sigm(a[1]) * bfhi(pw.x); v[2] = x1[2] + sigm(a[2]) * bflo(pw.y); v[3] = x1[3] + sigm(a[3]) * bfhi(pw.y);
                  x2[j] = v; ss += (v[0] * v[0] + v[1] * v[1]) + (v[2] * v[2] + v[3] * v[3]); }
              const float rstd = rsqrtf(wave_sum(ss) * (1.f / DM) + EPS);
#pragma unroll
              for (int j = 0; j < 16; ++j) { const int c = j * 256 + lane * 4; const f32x4 g4 = *(const f32x4*)(fn + c); *(f32x4*)(Y + (size_t)row * DM + c) = x2[j] * rstd * g4; } } }
        for (int i = gt; i < MPR * 1024; i += NGT) { const int row = i >> 10, c4 = (i & 1023) * 4;
            const float rstd = rsqrtf(RS2[row] * (1.f / DM) + EPS);
            const f32x4 g4 = *(const f32x4*)(fn + c4); f32x4 v = *(f32x4*)(Y + (size_t)row * DM + c4);
            v = v * rstd * g4; *(f32x4*)(Y + (size_t)row * DM + c4) = v; }
    }
#undef IN
#undef BOTH
#undef GRID_BAR
}

extern "C" void kernel_launch(void* const* d_in, const int* in_sizes, int n_in, void* d_out, int out_size, void* d_ws, size_t ws_size, hipStream_t stream) {
    static int grid = 0;
    if (grid == 0) {
        if (n_in != N_IN || (size_t)out_size != O_END || ws_size < WS_END) { fprintf(stderr, "kernel_launch: unexpected sizes n_in %d out %d ws %zu\n", n_in, out_size, ws_size); grid = -1; return; }
        int dev = 0, cus = 0, per_cu = 0;
        if (hipGetDevice(&dev) != hipSuccess || hipDeviceGetAttribute(&cus, hipDeviceAttributeMultiprocessorCount, dev) != hipSuccess) { grid = -1; return; }
        if (hipFuncSetAttribute((const void*)mk_fwd, hipFuncAttributeMaxDynamicSharedMemorySize, LDS_BYTES) != hipSuccess) { fprintf(stderr, "kernel_launch: hipFuncSetAttribute failed\n"); grid = -1; return; }
        if (hipOccupancyMaxActiveBlocksPerMultiprocessor(&per_cu, (const void*)mk_fwd, NTHREADS, LDS_BYTES) != hipSuccess || per_cu < 1) { fprintf(stderr, "kernel_launch: occupancy query says %d\n", per_cu); }
        (void)hipGetLastError();
        grid = cus;
    }
    if (grid < 0) return;
    if (hipMemsetAsync((char*)d_ws + WS_CTL, 0, CTL_ZERO_BYTES, stream) != hipSuccess) return;
    Args a{};
    for (int i = 0; i < N_IN; ++i) a.in[i] = (const float*)d_in[i];
    a.out = (float*)d_out; a.ws = (unsigned char*)d_ws;
    constexpr int NPH = 11;
    if (MK_N_LAUNCHES == 1) { a.ph_lo = 0; a.ph_hi = NPH; hipLaunchKernelGGL(mk_fwd, dim3(grid), dim3(NTHREADS), LDS_BYTES, stream, a); }
    else for (int p = 0; p < NPH; ++p) { a.ph_lo = p; a.ph_hi = p + 1; hipLaunchKernelGGL(mk_fwd, dim3(grid), dim3(NTHREADS), LDS_BYTES, stream, a); }
}
```

```cpp
#include <hip/hip_runtime.h>
#include <cstdio>

#ifndef PROBE_DUP
#define PROBE_DUP -1
#endif
#ifndef PG8_SP2
#define PG8_SP2 true
#endif
#ifndef MK_N_LAUNCHES
#define MK_N_LAUNCHES 1
#endif

#define GAS __attribute__((address_space(1)))
#define LAS __attribute__((address_space(3)))
typedef unsigned short bf16;
typedef unsigned v4u __attribute__((ext_vector_type(4)));
typedef unsigned v2u __attribute__((ext_vector_type(2)));
typedef float f32x4 __attribute__((ext_vector_type(4)));
typedef float f32x2 __attribute__((ext_vector_type(2)));
typedef short bf16x8 __attribute__((ext_vector_type(8)));

constexpr int NWAVES = 8, NTHREADS = 512;
constexpr int MTOK = 8704, MPR = 8192, DM = 4096, SEQ = 2048;
constexpr int NPROJ = 26624, NW1 = 26880, INCOLS = 26704;
constexpr int LDX = 4160, LDM = 8256, LDP = 320, LDQ = 576;
constexpr float EPS = 1e-6f;
enum { I_XP = 0, I_XS, I_PP, I_PS, I_MC, I_MN, I_MM, I_MCONV, I_SSSM, I_SCONV, I_NORMIN, I_WIN, I_BIG, I_BFG, I_MCW, I_MCB, I_WQ, I_WK, I_MNORM,
       I_SCW, I_SCB, I_DTB, I_ALOG, I_DSKIP, I_SNORM, I_WOUT, I_PLEPROJ, I_PLEGATE, I_PLENORM, I_FNORM, N_IN };
constexpr size_t O_Y = 0, O_PC = 35651584, O_PN = 39845888, O_PM = 39854080, O_PMCONV = 39854112, O_PSSM = 39903264, O_PSCONV = 42000416,
                 O_SC = 42074144, O_SN = 176291872, O_SM = 176554016, O_SMCONV = 176555040, O_SSSM = 178127904, O_SSCONV = 245236768, O_END = 247596064;
constexpr size_t MiB = 1u << 20;
constexpr size_t WS_CTL = 0, CTL_ZERO_BYTES = 4 * MiB;
constexpr size_t WS_NRM = 1 * MiB, WS_RS1 = 2 * MiB, WS_RS2 = 2 * MiB + 65536;
constexpr size_t WS_W1T = 4 * MiB, WS_W2T = 218 * MiB, WS_WGT = 283 * MiB, WS_WPT = 316 * MiB, WS_WQK = 319 * MiB, WS_XN = 324 * MiB, WS_PB = 394 * MiB,
                 WS_PROJ = 400 * MiB, WS_GATES = 842 * MiB, WS_UC = 851 * MiB, WS_QK = 921 * MiB, WS_XBC = 989 * MiB, WS_MG = 1091 * MiB, WS_SG = 1093 * MiB,
                 WS_MIX = 1098 * MiB, WS_X1 = 1236 * MiB, WS_X1G = 1372 * MiB, WS_PPB = 1442 * MiB,
                 WS_KWT = 1510 * MiB, WS_XWT = 1542 * MiB, WS_BMT = 1606 * MiB, WS_KWS = 1622 * MiB, WS_NALL = 1623 * MiB, WS_DENI = 1624 * MiB, WS_CS = 1625 * MiB, WS_MPD = 1626 * MiB, WS_END = 1627 * MiB;
constexpr size_t WS_NUMI = WS_UC, WS_INTER = WS_XN, WS_YI = WS_W1T, WS_YS = WS_W1T + 64 * MiB, WS_VT = WS_W1T + 128 * MiB;
constexpr size_t WS_SLAB2 = WS_W1T, WS_SLAB3 = WS_W1T + 64 * MiB;
constexpr int CW_TMO = 0, CW_BAR = 4096, CW_Q4 = 8192, CW_Q5 = 8512;
constexpr int LDSCTL_OFF = 131072, LDS_BYTES = 147456;

__device__ __forceinline__ unsigned f2bf(float f) { unsigned u = __builtin_bit_cast(unsigned, f); return (u + 0x7fffu + ((u >> 16) & 1u)) >> 16; }
typedef __bf16 bf16x2_t __attribute__((ext_vector_type(2)));
__device__ __forceinline__ unsigned pk2(float lo, float hi) { const f32x2 v = {lo, hi}; return __builtin_bit_cast(unsigned, __builtin_convertvector(v, bf16x2_t)); }
__device__ __forceinline__ float bflo(unsigned w) { return __builtin_bit_cast(float, w << 16); }
__device__ __forceinline__ float bfhi(unsigned w) { return __builtin_bit_cast(float, w & 0xffff0000u); }
__device__ __forceinline__ float bf2f(bf16 b) { return __builtin_bit_cast(float, (unsigned)b << 16); }
__device__ __forceinline__ float sigm(float x) { return 1.f / (1.f + __expf(-x)); }
__device__ __forceinline__ float silu(float x) { return x / (1.f + __expf(-x)); }
__device__ __forceinline__ float silu_fast(float x) { return x * __builtin_amdgcn_rcpf(1.f + __expf(-x)); }
__device__ __forceinline__ float softplus(float x) { return fmaxf(x, 0.f) + log1pf(__expf(-fabsf(x))); }
__device__ __forceinline__ float softcap(float x) { return 15.f * tanhf(x * (1.f / 15.f)); }
#define DPP_ADD(v_, ctrl_, rmask_) (v_) += __builtin_bit_cast(float, __builtin_amdgcn_update_dpp(0, __builtin_bit_cast(int, (v_)), (ctrl_), (rmask_), 0xF, false))
__device__ __forceinline__ float sum8(float v) { DPP_ADD(v, 0xB1, 0xF); DPP_ADD(v, 0x4E, 0xF); DPP_ADD(v, 0x141, 0xF); return v; }
__device__ __forceinline__ float sum16(float v) { v = sum8(v); DPP_ADD(v, 0x140, 0xF); return v; }
__device__ __forceinline__ float sum32_hi(float v) { v = sum16(v); DPP_ADD(v, 0x142, 0xA); return v; }
__device__ __forceinline__ float wave_sum(float v) {
    v = sum16(v); DPP_ADD(v, 0x142, 0xA); DPP_ADD(v, 0x143, 0xC);
    return __builtin_bit_cast(float, __builtin_amdgcn_readlane(__builtin_bit_cast(int, v), 63));
}
#define LDS_WAIT() asm volatile("s_waitcnt lgkmcnt(0)" ::: "memory")

namespace pg8 {
constexpr int BM = 256, BK = 64, HALF = 128, HTB = HALF * BK * 2, STAGE_BYTES = 8 * HTB, NXCD = 8, WGM = 8;
__host__ __device__ __forceinline__ int lds_byte(int r, int c) { const int st = (r >> 4) * 2 + (c >> 5), rr = r & 15, cc = c & 31, ob = rr * 64 + cc * 2; return st * 1024 + (ob ^ (((ob >> 9) & 1) << 5)); }
__host__ __device__ __forceinline__ void stage_rc(int b, int& R, int& C) { const int st = b / 1024, sb = b % 1024, swz = sb ^ (((sb >> 9) & 1) << 5); R = (st >> 1) * 16 + swz / 64; C = (st & 1) * 32 + (swz % 64) / 2; }
__host__ __device__ __forceinline__ int perm32(int rho) { const int n = rho >> 4, i = rho & 15; return 8 * (i >> 2) + 4 * n + (i & 3); }
struct Unit { int pm, pn, ks; };
struct Gemm { const bf16* A; const bf16* Bt; int lda, ldb, K; };
struct Order {
    int nM, nN, nwg, G, c, kshift, kmul, rep, quad;
    __device__ void init(int nM_, int nN_, int G_, int c_, int kshift_ = 0, int kmul_ = 0, int rep_ = 1) { nM = nM_; nN = nN_; nwg = nM * nN; G = G_; c = c_; kshift = kshift_; kmul = kmul_; rep = rep_; quad = 0; }
    __device__ bool next(int i, Unit& u) const {
        const int L = i * G + c; if (L >= nwg * rep) return false;
        int wgid = (rep == 1) ? L : (L % nwg); { const int q = nwg / NXCD, r = nwg % NXCD, xcd = wgid % NXCD, off = wgid / NXCD; wgid = (xcd < r ? xcd * (q + 1) : r * (q + 1) + (xcd - r) * q) + off; }
        if (quad) {
            const int full = (nN >> 2) * (nM * 4);
            if (wgid < full) { const int q = wgid / (nM * 4), rem = wgid % (nM * 4); u.pm = rem >> 2; u.pn = 4 * q + (rem & 3); }
            else { const int rem = wgid - full, nr = nN & 3; u.pm = rem / nr; u.pn = (nN & ~3) + rem % nr; }
            u.ks = 0; return true; }
        const int nig = WGM * nN, gid = wgid / nig, fm = gid * WGM, gsz = (nM - fm) < WGM ? (nM - fm) : WGM;
        u.pm = fm + ((wgid % nig) % gsz); u.pn = (wgid % nig) / gsz; u.ks = 0; return true;
    }
    __device__ __forceinline__ int a_koff(const Unit& u) const { return (u.pn >> kshift) * kmul; }
    __device__ __forceinline__ int b_koff(const Unit&) const { return 0; }
    __device__ __forceinline__ void a_ready(const Unit&) const {}
    __device__ __forceinline__ void done(const Unit&) const {}
};

struct SplitOrder {
    int G, c, pm0, kchunk;
    __device__ bool next(int i, Unit& u) const { const int L = i * G + c; if (L >= 256) return false; u.pm = pm0 + (L >> 7); u.pn = (L >> 3) & 15; u.ks = L & 7; return true; }
    __device__ __forceinline__ int a_koff(const Unit& u) const { return u.ks * kchunk; }
    __device__ __forceinline__ int b_koff(const Unit& u) const { return u.ks * kchunk; }
    __device__ __forceinline__ void a_ready(const Unit&) const {}
    __device__ __forceinline__ void done(const Unit&) const {}
};
template <class Epi, class Sched, bool ALIGN_EPI = true, bool SP2 = PG8_SP2>
__device__ __forceinline__ void gemm_phase(LAS unsigned char* lds, const Gemm g, const Sched& S, const Epi& E) {
    const int tid = threadIdx.x, wid = __builtin_amdgcn_readfirstlane(tid >> 6), lane = tid & 63, wr = wid >> 2, wc = wid & 3, fr = lane & 15, fq = lane >> 4;
    const int K = g.K, nt = K / BK;
    unsigned voffA[2], voffB[2];
#pragma unroll
    for (int i = 0; i < 2; ++i) { int R, C; stage_rc(tid * 16 + i * 8192, R, C); const int Rb = Epi::PERM ? ((R & ~31) + perm32(R & 31)) : R;
        voffA[i] = (unsigned)(R * g.lda + C) * 2u; voffB[i] = (unsigned)(Rb * g.ldb + C) * 2u; }
    const size_t kstep = (size_t)(BK * 2);
    const size_t hstepA = (size_t)HALF * g.lda * 2, hstepB = (size_t)HALF * g.ldb * 2;
    const size_t tstepA = 2 * hstepA, tstepB = 2 * hstepB;
    const unsigned ldsw = (unsigned)wid * 1024u;
    const int aoff = lds_byte(wr * 64 + fr, fq * 8), boff = lds_byte(wc * 32 + fr, fq * 8);
#define PG8_SA(b, h) (((b) * 2 + (h)) * HTB)
#define PG8_SB(b, h) ((4 + (b) * 2 + (h)) * HTB)
#define PG8_STAGE(bufoff, gbase, voff) do { _Pragma("unroll") for (int _i = 0; _i < 2; ++_i) \
        __builtin_amdgcn_global_load_lds((const unsigned*)((const char*)(gbase) + (voff)[_i]), (LAS unsigned*)(lds + (bufoff) + ldsw + _i * 8192), 16, 0, 0); } while (0)
#define PG8_LDA(dst, b, h) do { _Pragma("unroll") for (int m = 0; m < 4; ++m) _Pragma("unroll") for (int k = 0; k < 2; ++k) dst[m][k] = *(const LAS bf16x8*)(lds + PG8_SA(b, h) + aoff + m * 2048 + k * 1024); } while (0)
#define PG8_LDB(dst, b, h) do { _Pragma("unroll") for (int n = 0; n < 2; ++n) _Pragma("unroll") for (int k = 0; k < 2; ++k) dst[n][k] = *(const LAS bf16x8*)(lds + PG8_SB(b, h) + boff + n * 2048 + k * 1024); } while (0)
#define PG8_MMA(ai, bj, At, Bt) do { __builtin_amdgcn_s_setprio(1); _Pragma("unroll") for (int m = 0; m < 4; ++m) _Pragma("unroll") for (int n = 0; n < 2; ++n) _Pragma("unroll") for (int k = 0; k < 2; ++k) \
        acc[ai][bj][m][n] = __builtin_amdgcn_mfma_f32_16x16x32_bf16(Bt[n][k], At[m][k], acc[ai][bj][m][n], 0, 0, 0); __builtin_amdgcn_s_setprio(0); } while (0)
#define PG8_WAIT_V(n) asm volatile("s_waitcnt vmcnt(" #n ")" ::: "memory")
#define PG8_WAIT_L(n) asm volatile("s_waitcnt lgkmcnt(" #n ")" ::: "memory")
#define PG8_BAR __builtin_amdgcn_s_barrier()
#define PG8_SCHED __builtin_amdgcn_sched_barrier(0)
    Unit cur, nxt; int ui = 0;
    if (!S.next(0, cur)) return;
    f32x4 acc[2][2][4][2];
#pragma unroll
    for (int a = 0; a < 2; ++a)
#pragma unroll
        for (int b = 0; b < 2; ++b)
#pragma unroll
            for (int m = 0; m < 4; ++m)
#pragma unroll
                for (int n = 0; n < 2; ++n) acc[a][b][m][n] = (f32x4){0.f, 0.f, 0.f, 0.f};
    bf16x8 At[4][2], B0[2][2], B1[2][2];
    const char* cA = (const char*)g.A + (size_t)cur.pm * tstepA + (size_t)S.a_koff(cur) * 2; const char* cB = (const char*)g.Bt + (size_t)cur.pn * tstepB + (size_t)S.b_koff(cur) * 2;
    S.a_ready(cur);
    if constexpr (SP2) {
    PG8_STAGE(PG8_SB(0, 0), cB, voffB); PG8_STAGE(PG8_SB(0, 1), cB + hstepB, voffB); PG8_STAGE(PG8_SA(0, 0), cA, voffA); PG8_STAGE(PG8_SA(0, 1), cA + hstepA, voffA);
    if (wr == 1) PG8_BAR;
    PG8_WAIT_V(2); PG8_BAR;
    PG8_STAGE(PG8_SB(1, 0), cB + kstep, voffB); PG8_STAGE(PG8_SA(1, 0), cA + kstep, voffA); PG8_STAGE(PG8_SB(1, 1), cB + hstepB + kstep, voffB);
    PG8_WAIT_V(6); PG8_BAR;
    } else {
    PG8_STAGE(PG8_SB(0, 0), cB, voffB); PG8_STAGE(PG8_SA(0, 0), cA, voffA); PG8_STAGE(PG8_SB(0, 1), cB + hstepB, voffB); PG8_STAGE(PG8_SA(0, 1), cA + hstepA, voffA);
    if (wr == 1) PG8_BAR;
    PG8_WAIT_V(4); PG8_BAR;
    PG8_STAGE(PG8_SB(1, 0), cB + kstep, voffB); PG8_STAGE(PG8_SA(1, 0), cA + kstep, voffA); PG8_STAGE(PG8_SB(1, 1), cB + hstepB + kstep, voffB);
    PG8_WAIT_V(6); PG8_BAR;
    }
    for (;;) {
        const bool has_next = S.next(ui + 1, nxt);
        const char* nA = has_next ? (const char*)g.A + (size_t)nxt.pm * tstepA + (size_t)S.a_koff(nxt) * 2 : cA; const char* nB = has_next ? (const char*)g.Bt + (size_t)nxt.pn * tstepB + (size_t)S.b_koff(nxt) * 2 : cB;
        for (int t = 0; t < nt; t += 2) {
            const bool last = (t == nt - 2);
            const char* a1 = cA + (size_t)(t + 1) * kstep;
            const char* a2 = last ? nA : cA + (size_t)(t + 2) * kstep; const char* b2 = last ? nB : cB + (size_t)(t + 2) * kstep;
            const char* a3 = a2 + kstep; const char* b3 = b2 + kstep;
            if (last && has_next) S.a_ready(nxt);
            if constexpr (SP2) {
            PG8_LDB(B0, 0, 0); PG8_LDB(B1, 0, 1); PG8_SCHED; PG8_LDA(At, 0, 0); PG8_STAGE(PG8_SA(1, 1), a1 + hstepA, voffA);
            PG8_WAIT_V(8); PG8_WAIT_L(0); PG8_BAR; PG8_MMA(0, 0, At, B0); PG8_MMA(0, 1, At, B1); PG8_BAR; PG8_SCHED;
            PG8_LDA(At, 0, 1); PG8_STAGE(PG8_SB(0, 0), b2, voffB); PG8_STAGE(PG8_SB(0, 1), b2 + hstepB, voffB); PG8_STAGE(PG8_SA(0, 0), a2, voffA);
            PG8_WAIT_V(8); PG8_WAIT_L(0); PG8_BAR; PG8_MMA(1, 0, At, B0); PG8_MMA(1, 1, At, B1); PG8_BAR; PG8_SCHED;
            PG8_LDB(B0, 1, 0); PG8_LDB(B1, 1, 1); PG8_SCHED; PG8_LDA(At, 1, 0); PG8_STAGE(PG8_SA(0, 1), a2 + hstepA, voffA);
            PG8_WAIT_V(8); PG8_WAIT_L(0); PG8_BAR; PG8_MMA(0, 0, At, B0); PG8_MMA(0, 1, At, B1); PG8_BAR; PG8_SCHED;
            PG8_LDA(At, 1, 1); PG8_STAGE(PG8_SB(1, 0), b3, voffB); PG8_STAGE(PG8_SB(1, 1), b3 + hstepB, voffB); PG8_STAGE(PG8_SA(1, 0), a3, voffA);
            PG8_WAIT_V(8); PG8_WAIT_L(0); PG8_BAR; PG8_MMA(1, 0, At, B0); PG8_MMA(1, 1, At, B1); PG8_BAR; PG8_SCHED;
            } else {
            PG8_LDB(B0, 0, 0); PG8_SCHED; PG8_LDA(At, 0, 0); PG8_STAGE(PG8_SA(1, 1), a1 + hstepA, voffA);
            PG8_WAIT_L(8); PG8_BAR; PG8_WAIT_L(0); PG8_MMA(0, 0, At, B0); PG8_BAR; PG8_SCHED;
            PG8_LDB(B1, 0, 1); PG8_STAGE(PG8_SB(0, 0), b2, voffB);
            PG8_BAR; PG8_WAIT_L(0); PG8_MMA(0, 1, At, B1); PG8_BAR;
            PG8_LDA(At, 0, 1); PG8_STAGE(PG8_SA(0, 0), a2, voffA);
            PG8_BAR; PG8_WAIT_L(0); PG8_MMA(1, 0, At, B0); PG8_BAR; PG8_SCHED;
            PG8_STAGE(PG8_SB(0, 1), b2 + hstepB, voffB);
            PG8_WAIT_V(6); PG8_BAR; PG8_MMA(1, 1, At, B1); PG8_BAR;
            PG8_LDB(B0, 1, 0); PG8_SCHED; PG8_LDA(At, 1, 0); PG8_STAGE(PG8_SA(0, 1), a2 + hstepA, voffA);
            PG8_WAIT_L(8); PG8_BAR; PG8_WAIT_L(0); PG8_MMA(0, 0, At, B0); PG8_BAR; PG8_SCHED;
            PG8_LDB(B1, 1, 1); PG8_STAGE(PG8_SB(1, 0), b3, voffB);
            PG8_BAR; PG8_WAIT_L(0); PG8_MMA(0, 1, At, B1); PG8_BAR;
            PG8_LDA(At, 1, 1); PG8_STAGE(PG8_SA(1, 0), a3, voffA);
            PG8_BAR; PG8_WAIT_L(0); PG8_MMA(1, 0, At, B0); PG8_BAR; PG8_SCHED;
            PG8_STAGE(PG8_SB(1, 1), b3 + hstepB, voffB);
            PG8_WAIT_V(6); PG8_BAR; PG8_MMA(1, 1, At, B1); PG8_BAR;
            }
        }
        if constexpr (ALIGN_EPI) { if (wr == 0) PG8_BAR; }
        E(acc, cur, wr, wc, fr, fq); S.done(cur);
        if (!has_next) break;
#pragma unroll
        for (int a = 0; a < 2; ++a)
#pragma unroll
            for (int b = 0; b < 2; ++b)
#pragma unroll
                for (int m = 0; m < 4; ++m)
#pragma unroll
                    for (int n = 0; n < 2; ++n) acc[a][b][m][n] = (f32x4){0.f, 0.f, 0.f, 0.f};
        cur = nxt; cA = nA; cB = nB; ++ui;
        if constexpr (ALIGN_EPI) { if (wr == 1) PG8_BAR; }
    }
    PG8_WAIT_V(0);
    if constexpr (!ALIGN_EPI) { if (wr == 0) PG8_BAR; }
    PG8_BAR;
#undef PG8_SA
#undef PG8_SB
#undef PG8_STAGE
#undef PG8_LDA
#undef PG8_LDB
#undef PG8_MMA
#undef PG8_WAIT_V
#undef PG8_WAIT_L
#undef PG8_BAR
#undef PG8_SCHED
}

struct EpiBf16 {
    static constexpr bool PERM = true;
    bf16* O; int ldc;
    __device__ __forceinline__ void operator()(const f32x4 (&acc)[2][2][4][2], const Unit& u, int wr, int wc, int fr, int fq) const {
        const int row0 = u.pm * BM + wr * 64 + fr, col0 = u.pn * BM + wc * 32 + 8 * fq;
#pragma unroll
        for (int ai = 0; ai < 2; ++ai)
#pragma unroll
            for (int m = 0; m < 4; ++m) { bf16* rowp = O + (size_t)(row0 + ai * HALF + m * 16) * ldc + col0;
#pragma unroll
                for (int bj = 0; bj < 2; ++bj) { const f32x4 v0 = acc[ai][bj][m][0], v1 = acc[ai][bj][m][1];
                    v4u w; w.x = pk2(v0[0], v0[1]); w.y = pk2(v0[2], v0[3]); w.z = pk2(v1[0], v1[1]); w.w = pk2(v1[2], v1[3]);
                    *(v4u*)(rowp + bj * HALF) = w; } }
    }
};
struct EpiProj {
    static constexpr bool PERM = true;
    bf16* O; float* Gt;
    __device__ __forceinline__ void operator()(const f32x4 (&acc)[2][2][4][2], const Unit& u, int wr, int wc, int fr, int fq) const {
        const int row0 = u.pm * BM + wr * 64 + fr;
        if (u.pn < 104) {
            const int col0 = u.pn * BM + wc * 32 + 8 * fq;
#pragma unroll
            for (int ai = 0; ai < 2; ++ai)
#pragma unroll
                for (int m = 0; m < 4; ++m) { bf16* rowp = O + (size_t)(row0 + ai * HALF + m * 16) * NPROJ + col0;
#pragma unroll
                    for (int bj = 0; bj < 2; ++bj) { const f32x4 v0 = acc[ai][bj][m][0], v1 = acc[ai][bj][m][1];
                        v4u w; w.x = pk2(v0[0], v0[1]); w.y = pk2(v0[2], v0[3]); w.z = pk2(v1[0], v1[1]); w.w = pk2(v1[2], v1[3]);
                        *(v4u*)(rowp + bj * HALF) = w; } }
        } else {
            const int col0 = wc * 32 + 8 * fq;
#pragma unroll
            for (int ai = 0; ai < 2; ++ai)
#pragma unroll
                for (int m = 0; m < 4; ++m) { float* rowp = Gt + (size_t)(row0 + ai * HALF + m * 16) * 256 + col0;
#pragma unroll
                    for (int bj = 0; bj < 2; ++bj)
#pragma unroll
                        for (int n = 0; n < 2; ++n) *(f32x4*)(rowp + bj * HALF + 4 * n) = acc[ai][bj][m][n]; }
        }
    }
};
struct EpiSlab {
    static constexpr bool PERM = false;
    float* slab;
    __device__ __forceinline__ void operator()(const f32x4 (&acc)[2][2][4][2], const Unit& u, int wr, int wc, int fr, int fq) const {
        const int row0 = u.pm * BM - MPR + wr * 64 + fr, col0 = u.pn * BM + wc * 32 + 4 * fq;
#pragma unroll
        for (int ai = 0; ai < 2; ++ai)
#pragma unroll
            for (int m = 0; m < 4; ++m) { float* rowp = slab + ((size_t)u.ks * 512 + row0 + ai * HALF + m * 16) * DM + col0;
#pragma unroll
                for (int bj = 0; bj < 2; ++bj)
#pragma unroll
                    for (int n = 0; n < 2; ++n) *(f32x4*)(rowp + bj * HALF + n * 16) = acc[ai][bj][m][n]; }
    }
};
struct EpiX1 {
    static constexpr bool PERM = false;
    const float* xp; const float* xs; const float* gn; float* X1; bf16* X1G; float* RS; float ssw;
    __device__ __forceinline__ void operator()(const f32x4 (&acc)[2][2][4][2], const Unit& u, int wr, int wc, int fr, int fq) const {
        const int row0 = u.pm * BM + wr * 64 + fr, col0 = u.pn * BM + wc * 32 + 4 * fq;
#pragma unroll
        for (int ai = 0; ai < 2; ++ai)
#pragma unroll
            for (int m = 0; m < 4; ++m) { const int row = row0 + ai * HALF + m * 16;
                const float* xrow = (row < MPR ? xp + (size_t)row * DM : xs + (size_t)(row - MPR) * DM) + col0; const size_t off = (size_t)row * DM + col0; float ss = 0.f;
#pragma unroll
                for (int bj = 0; bj < 2; ++bj)
#pragma unroll
                    for (int n = 0; n < 2; ++n) { const int co = bj * HALF + n * 16; const f32x4 v = *(const f32x4*)(xrow + co) + acc[ai][bj][m][n];
                        *(f32x4*)(X1 + off + co) = v; ss += (v[0] * v[0] + v[1] * v[1]) + (v[2] * v[2] + v[3] * v[3]);
                        const f32x4 gv = *(const f32x4*)(gn + col0 + co); v2u w; w.x = pk2(v[0] * gv[0], v[1] * gv[1]); w.y = pk2(v[2] * gv[2], v[3] * gv[3]);
                        *(v2u*)(X1G + (size_t)row * LDX + col0 + co) = w; }
                ss += __shfl_xor(ss, 16); ss += __shfl_xor(ss, 32);
                if (fq == 0) atomicAdd(RS + row, ss * ssw); }
    }
};
struct EpiGate {
    static constexpr bool PERM = false;
    const float* X1; const bf16* PP; const float* RS1; float* out; float* RS2; float ssw;
    __device__ __forceinline__ void operator()(const f32x4 (&acc)[2][2][4][2], const Unit& u, int wr, int wc, int fr, int fq) const {
        const int row0 = u.pm * BM + wr * 64 + fr, col0 = u.pn * BM + wc * 32 + 4 * fq;
#pragma unroll
        for (int ai = 0; ai < 2; ++ai)
#pragma unroll
            for (int m = 0; m < 4; ++m) { const int row = row0 + ai * HALF + m * 16; const size_t off = (size_t)row * DM + col0; float ss = 0.f;
                const float rstd = rsqrtf(RS1[row] * (1.f / DM) + EPS);
#pragma unroll
                for (int bj = 0; bj < 2; ++bj)
#pragma unroll
                    for (int n = 0; n < 2; ++n) { const int co = bj * HALF + n * 16; const f32x4 a = acc[ai][bj][m][n] * rstd; const v2u pw = *(const v2u*)(PP + off + co);
                        const f32x4 x1 = *(const f32x4*)(X1 + off + co); f32x4 v;
                        v[0] = x1[0] + sigm(a[0]) * bflo(pw.x); v[1] = x1[1] + sigm(a[1]) * bfhi(pw.x); v[2] = x1[2] + sigm(a[2]) * bflo(pw.y); v[3] = x1[3] + sigm(a[3]) * bfhi(pw.y);
                        *(f32x4*)(out + off + co) = v; ss += (v[0] * v[0] + v[1] * v[1]) + (v[2] * v[2] + v[3] * v[3]); }
                ss += __shfl_xor(ss, 16); ss += __shfl_xor(ss, 32);
                if (fq == 0) atomicAdd(RS2 + row, ss * ssw); }
    }
};
}

#define XB_TMO      128
#define XB_XCNT(j)  (256  + 64 * (j))
#define XB_XSUB(j)  (1280 + 64 * (j))
#define XB_XGEN(j)  (2304 + 64 * (j))
#define XB_TOP      3328
#define XB_TOPGEN   3392
#define XCD_BAR_WORDS 3456
#define XB_SPIN_CAP (1u << 18)
__device__ __forceinline__ unsigned xb_ld(unsigned* p)              { return __hip_atomic_load(p, __ATOMIC_RELAXED, __HIP_MEMORY_SCOPE_AGENT); }
__device__ __forceinline__ unsigned xb_add(unsigned* p, unsigned v) { return __hip_atomic_fetch_add(p, v, __ATOMIC_RELAXED, __HIP_MEMORY_SCOPE_AGENT); }
__device__ __forceinline__ unsigned xb_xcc_id() { return (unsigned)__builtin_amdgcn_s_getreg((3 << 11) | 20) & 0xFu; }
#define XB_SPIN(cond, bar) do { unsigned _sp = 0; while (cond) { __builtin_amdgcn_s_sleep(1); \
    if ((++_sp & 255u) == 0u) { if (xb_ld(&(bar)[XB_TMO])) break; if (_sp > XB_SPIN_CAP) { atomicAdd(&(bar)[XB_TMO], 1u); break; } } } } while (0)
struct XcdBarrier { unsigned* bar; unsigned x; volatile LAS unsigned* st; };
__device__ __forceinline__ XcdBarrier xcd_barrier_post(unsigned* bar, volatile LAS unsigned* st) {
    XcdBarrier b; b.bar = bar; b.x = xb_xcc_id(); b.st = st;
    if (threadIdx.x == 0) (void)xb_add(&bar[XB_XCNT(b.x)], 1u);
    return b;
}
__device__ __forceinline__ void xcd_barrier_complete(unsigned* bar, unsigned x, unsigned& nloc, unsigned& nx) {
    const unsigned G = gridDim.x * gridDim.y * gridDim.z;
    unsigned sum, cnt, mine, sp = 0u;
    for (;;) {
        sum = 0u; cnt = 0u; mine = 0u;
#pragma unroll
        for (unsigned j = 0; j < 16; ++j) { const unsigned c = xb_ld(&bar[XB_XCNT(j)]); sum += c; cnt += (c > 0u) ? 1u : 0u; mine = (j == x) ? c : mine; }
        if (sum == G) break;
        __builtin_amdgcn_s_sleep(1);
        if ((++sp & 255u) == 0u) { if (xb_ld(&bar[XB_TMO])) break; if (sp > XB_SPIN_CAP) { atomicAdd(&bar[XB_TMO], 1u); break; } }
    }
    nloc = mine > 0u ? mine : 1u; nx = cnt > 0u ? cnt : 1u;
}
__device__ __forceinline__ void xcd_barrier(const XcdBarrier& b) {
    asm volatile("s_waitcnt vmcnt(0)" ::: "memory");
    __syncthreads();
    if (threadIdx.x == 0) {
        unsigned* bar = b.bar;
        __builtin_amdgcn_s_waitcnt(0);
        unsigned nloc = b.st[0], nx = b.st[1];
        if (nloc == 0u) { xcd_barrier_complete(bar, b.x, nloc, nx); b.st[0] = nloc; b.st[1] = nx; }
        const unsigned old = xb_add(&bar[XB_XSUB(b.x)], 1u);
        const unsigned gen = old / nloc;
        if (old + 1u == (gen + 1u) * nloc) {
            __builtin_amdgcn_fence(__ATOMIC_RELEASE, "agent");
            asm volatile("s_waitcnt vmcnt(0)" ::: "memory");
            const unsigned og = xb_add(&bar[XB_TOP], 1u);
            const unsigned tg = og / nx;
            if (og + 1u == (tg + 1u) * nx) xb_add(&bar[XB_TOPGEN], 1u);
            else XB_SPIN(xb_ld(&bar[XB_TOPGEN]) == tg, bar);
            __builtin_amdgcn_fence(__ATOMIC_ACQUIRE, "agent");
            xb_add(&bar[XB_XGEN(b.x)], 1u);
            asm volatile("s_waitcnt vmcnt(0)" ::: "memory");
        } else {
            XB_SPIN(xb_ld(&bar[XB_XGEN(b.x)]) == gen, bar);
            __builtin_amdgcn_fence(__ATOMIC_ACQUIRE, "agent");
            asm volatile("s_waitcnt vmcnt(0)" ::: "memory");
        }
    }
    __syncthreads();
}

struct Args { const float* in[N_IN]; float* out; unsigned char* ws; int ph_lo, ph_hi; };

template <int K>
__device__ __forceinline__ f32x4 mma_nt(const LAS bf16* X, int ldx, const LAS bf16* Y, int ldy, f32x4 acc, int lane) {
    const int r = lane & 15, kq = (lane >> 4) * 8;
#pragma unroll
    for (int k0 = 0; k0 < K; k0 += 32) {
        const bf16x8 a = *(const LAS bf16x8*)(X + r * ldx + k0 + kq);
        const bf16x8 b = *(const LAS bf16x8*)(Y + r * ldy + k0 + kq);
        acc = __builtin_amdgcn_mfma_f32_16x16x32_bf16(a, b, acc, 0, 0, 0);
    }
    return acc;
}

__device__ __forceinline__ int w1_colmap(int n) { return n < 16384 ? n : (n < 26624 ? n + 16 : (n < 26640 ? n - 26624 + 16384 : (n < INCOLS ? n : -1))); }
struct TItem { const float* W; bf16* WT; int ldw, ldt, k0, n0, map; float scale; };
__device__ __forceinline__ TItem t_decode(const Args& A, int r) {
    constexpr int I1 = 64 * 840, I2 = 128 * 128, I3 = 64 * 128, I4 = 4 * 128;
    unsigned char* ws = A.ws; TItem t; t.map = 0; t.scale = 1.f;
    if (r < I1) { t.W = A.in[I_WIN]; t.ldw = INCOLS; t.WT = (bf16*)(ws + WS_W1T); t.ldt = LDX; t.k0 = (r % 64) * 64; t.n0 = (r / 64) * 32; t.map = 1; return t; } r -= I1;
    if (r < I2) { t.W = A.in[I_WOUT]; t.ldw = DM; t.WT = (bf16*)(ws + WS_W2T); t.ldt = LDM; t.k0 = (r % 128) * 64; t.n0 = (r / 128) * 32; return t; } r -= I2;
    if (r < I3) { t.W = A.in[I_PLEGATE]; t.ldw = DM; t.WT = (bf16*)(ws + WS_WGT); t.ldt = LDX; t.k0 = (r % 64) * 64; t.n0 = (r / 64) * 32; return t; } r -= I3;
    if (r < I4) { t.W = A.in[I_PLEPROJ]; t.ldw = DM; t.WT = (bf16*)(ws + WS_WPT); t.ldt = LDP; t.k0 = (r / 128) * 64; t.n0 = (r % 128) * 32; return t; } r -= I4;
    { const int hw = r >> 6, h = hw >> 1, which = hw & 1, q = r & 63;
      t.W = (which ? A.in[I_WK] : A.in[I_WQ]) + (size_t)h * 512 * 256; t.ldw = 256; t.WT = (bf16*)(ws + WS_WQK) + (size_t)(h * 512 + which * 256) * LDQ; t.ldt = LDQ;
      t.k0 = (q >> 3) * 64; t.n0 = (q & 7) * 32; t.scale = which ? 0.0625f : 1.f; return t; }
}
__device__ __forceinline__ void t_load(const TItem& t, int lane, float (&tv)[32]) {
    const int nn = t.n0 + (lane & 31); const int oc = t.map ? w1_colmap(nn) : nn;
    const int loff = (lane >> 5) * t.ldw + (oc >= 0 ? oc : 0);
#pragma unroll
    for (int i = 0; i < 32; ++i) { const float* rowp = t.W + (size_t)(t.k0 + 2 * i) * t.ldw; tv[i] = rowp[loff]; }
}
__device__ __forceinline__ void t_store(const TItem& t, LAS float* scr, int lane, const float (&tv)[32]) {
    const int nn = t.n0 + (lane & 31); const bool ok = !t.map || w1_colmap(nn) >= 0;
#pragma unroll
    for (int i = 0; i < 32; ++i) { const int kk = 2 * i + (lane >> 5); scr[kk * 33 + (lane & 31)] = ok ? tv[i] * t.scale : 0.f; }
    LDS_WAIT(); asm volatile("" ::: "memory");
    const int c = lane & 7;
#pragma unroll
    for (int j = 0; j < 4; ++j) { const int n = (lane >> 3) + 8 * j; const LAS float* sp = scr + (8 * c) * 33 + n;
        v4u o; o.x = pk2(sp[0 * 33], sp[1 * 33]); o.y = pk2(sp[2 * 33], sp[3 * 33]); o.z = pk2(sp[4 * 33], sp[5 * 33]); o.w = pk2(sp[6 * 33], sp[7 * 33]);
        *(v4u*)(t.WT + (size_t)(t.n0 + n) * t.ldt + t.k0 + 8 * c) = o; }
    LDS_WAIT(); asm volatile("" ::: "memory");
}
__device__ __forceinline__ void p0_prologue(const Args& A, LAS unsigned char* lds, int gw, int NGW, int lane, int wave) {
    LAS float* scr = (LAS float*)(lds + wave * 16384);
    unsigned char* ws = A.ws;
    constexpr int NIT = 64 * 840 + 128 * 128 + 64 * 128 + 4 * 128 + 1024;
    if (gw < NIT) { int it = gw; TItem cur = t_decode(A, it); float tva[32], tvb[32]; t_load(cur, lane, tva);
        for (;;) { const int nit = it + NGW; const bool has = nit < NIT; TItem nxt = cur; if (has) { nxt = t_decode(A, nit); t_load(nxt, lane, tvb); }
            t_store(cur, scr, lane, tva); if (!has) break;
#pragma unroll
            for (int i = 0; i < 32; ++i) tva[i] = tvb[i];
            cur = nxt; it = nit; } }
    const float* gn = A.in[I_NORMIN];
    for (int m = gw; m < MTOK; m += NGW) {
        const float* xrow = m < MPR ? A.in[I_XP] + (size_t)m * DM : A.in[I_XS] + (size_t)(m - MPR) * DM;
        f32x4 v[16]; float s = 0.f;
#pragma unroll
        for (int j = 0; j < 16; ++j) { v[j] = ((const f32x4*)xrow)[lane + 64 * j]; s += (v[j][0] * v[j][0] + v[j][1] * v[j][1]) + (v[j][2] * v[j][2] + v[j][3] * v[j][3]); }
        const float rstd = rsqrtf(wave_sum(s) * (1.f / DM) + EPS);
        bf16* orow = (bf16*)(ws + WS_XN) + (size_t)m * LDX;
#pragma unroll
        for (int j = 0; j < 16; ++j) { const f32x4 g4 = ((const f32x4*)gn)[lane + 64 * j]; v2u w; w.x = pk2(v[j][0] * rstd * g4[0], v[j][1] * rstd * g4[1]); w.y = pk2(v[j][2] * rstd * g4[2], v[j][3] * rstd * g4[3]);
            ((v2u*)orow)[lane + 64 * j] = w; }
    }
    { const int gt = gw * 64 + lane, NGT = NGW * 64;
      for (int i = gt; i < MTOK * 32; i += NGT) { const int row = i >> 5, c8 = (i & 31) * 8;
          const float* src = (row < MPR ? A.in[I_PP] + (size_t)row * 256 : A.in[I_PS] + (size_t)(row - MPR) * 256) + c8;
          const f32x4 a = *(const f32x4*)src, b = *(const f32x4*)(src + 4);
          v4u w; w.x = pk2(a[0], a[1]); w.y = pk2(a[2], a[3]); w.z = pk2(b[0], b[1]); w.w = pk2(b[2], b[3]);
          *(v4u*)((bf16*)(ws + WS_PB) + (size_t)row * LDP + c8) = w; } }
}

template <int NCH, int NT, bool PROMPT>
__device__ __forceinline__ void conv_part(const bf16* src  , const float* state_in, const float* w, const float* bias, bf16* dst, int dst_ld, float* out_state, int gt, int NGT) {
    constexpr int CG = NCH / 8, NBLK = PROMPT ? SEQ / NT : 1, NSEQ = PROMPT ? 4 : 128, NQ = NSEQ * NBLK;
    const int qstep = NGT / CG;
    if (gt >= qstep * CG) return;
    const int cg = gt % CG, c0 = cg * 8;
    float wv[4][8], bv[8];
#pragma unroll
    for (int j = 0; j < 4; ++j) { const f32x4 a = *(const f32x4*)(w + j * NCH + c0), b = *(const f32x4*)(w + j * NCH + c0 + 4);
#pragma unroll
        for (int e = 0; e < 4; ++e) { wv[j][e] = a[e]; wv[j][4 + e] = b[e]; } }
    { const f32x4 a = *(const f32x4*)(bias + c0), b = *(const f32x4*)(bias + c0 + 4);
#pragma unroll
      for (int e = 0; e < 4; ++e) { bv[e] = a[e]; bv[4 + e] = b[e]; } }
    for (int q = gt / CG; q < NQ; q += qstep) {
        const int seq = q / NBLK, blk = q % NBLK;
        const int row0 = PROMPT ? seq * SEQ + blk * NT : MPR + seq * 4;
        v4u rows[NT]; float win[3][8];
#pragma unroll
        for (int i = 0; i < NT; ++i) rows[i] = *(const v4u*)(src + (size_t)(row0 + i) * NPROJ + c0);
        if (PROMPT) {
#pragma unroll
            for (int j = 0; j < 3; ++j) { v4u v = (v4u){0u, 0u, 0u, 0u}; if (blk != 0) v = *(const v4u*)(src + (size_t)(row0 - 3 + j) * NPROJ + c0);
                win[j][0] = bflo(v.x); win[j][1] = bfhi(v.x); win[j][2] = bflo(v.y); win[j][3] = bfhi(v.y); win[j][4] = bflo(v.z); win[j][5] = bfhi(v.z); win[j][6] = bflo(v.w); win[j][7] = bfhi(v.w); }
        } else {
#pragma unroll
            for (int j = 0; j < 3; ++j) { const float* sp = state_in + ((size_t)seq * 3 + j) * NCH + c0; const f32x4 a = *(const f32x4*)sp, b = *(const f32x4*)(sp + 4);
#pragma unroll
                for (int e = 0; e < 4; ++e) { win[j][e] = a[e]; win[j][4 + e] = b[e]; } }
        }
#pragma unroll
        for (int i = 0; i < NT; ++i) {
            const v4u v = rows[i];
            const float cur[8] = {bflo(v.x), bfhi(v.x), bflo(v.y), bfhi(v.y), bflo(v.z), bfhi(v.z), bflo(v.w), bfhi(v.w)};
            float y[8];
#pragma unroll
            for (int e = 0; e < 8; ++e) { y[e] = silu_fast(bv[e] + wv[0][e] * win[0][e] + wv[1][e] * win[1][e] + wv[2][e] * win[2][e] + wv[3][e] * cur[e]); win[0][e] = win[1][e]; win[1][e] = win[2][e]; win[2][e] = cur[e]; }
            v4u o; o.x = pk2(y[0], y[1]); o.y = pk2(y[2], y[3]); o.z = pk2(y[4], y[5]); o.w = pk2(y[6], y[7]);
            *(v4u*)(dst + (size_t)(row0 + i) * dst_ld + c0) = o;
        }
        if (!PROMPT || blk == NBLK - 1) { float* op = out_state + (size_t)seq * 3 * NCH + c0;
#pragma unroll
            for (int j = 0; j < 3; ++j) { *(f32x4*)(op + j * NCH) = (f32x4){win[j][0], win[j][1], win[j][2], win[j][3]}; *(f32x4*)(op + j * NCH + 4) = (f32x4){win[j][4], win[j][5], win[j][6], win[j][7]}; } }
    }
}
template <int W> __device__ __forceinline__ float scan_add(float v, int lane) {
#pragma unroll
    for (int o = 1; o < W; o <<= 1) { const float t = __shfl_up(v, o, W); if ((lane & (W - 1)) >= o) v += t; }
    return v;
}
template <int W> __device__ __forceinline__ float scan_max(float v, int lane) {
#pragma unroll
    for (int o = 1; o < W; o <<= 1) { const float t = __shfl_up(v, o, W); if ((lane & (W - 1)) >= o) v = fmaxf(v, t); }
    return v;
}
__device__ __forceinline__ void gate_scans(const Args& A, int gw, int NGW, int lane) {
    const float* GT = (const float*)(A.ws + WS_GATES);
    f32x4* MG = (f32x4*)(A.ws + WS_MG); f32x2* SG = (f32x2*)(A.ws + WS_SG); f32x2* CS = (f32x2*)(A.ws + WS_CS);
    for (int it = gw; it < 512; it += NGW) {
        if (it < 128) {
            const int seq = it >> 5, c = it & 31, row = seq * SEQ + c * 64 + lane;
            const f32x4 g0 = *(const f32x4*)(GT + (size_t)row * 256), g1 = *(const f32x4*)(GT + (size_t)row * 256 + 4), g2 = *(const f32x4*)(GT + (size_t)row * 256 + 8), g3 = *(const f32x4*)(GT + (size_t)row * 256 + 12);
            const float gi[8] = {g0[0], g0[1], g0[2], g0[3], g1[0], g1[1], g1[2], g1[3]}, gf[8] = {g2[0], g2[1], g2[2], g2[3], g3[0], g3[1], g3[2], g3[3]};
#pragma unroll
            for (int h = 0; h < 8; ++h) {
                const float ig = softcap(gi[h] + A.in[I_BIG][h]), lf = -softplus(-softcap(gf[h] + A.in[I_BFG][h]));
                const float bc = scan_add<64>(lf, lane), g = ig - bc, gmax = scan_max<64>(g, lane);
                MG[(size_t)row * 8 + h] = (f32x4){bc, g, gmax, 0.f};
                if (lane == 63) CS[(seq * 8 + h) * 32 + c] = (f32x2){bc, gmax};
            }
        } else if (it < 256) {
            const int seq = it - 128, h = (lane >> 2) & 7, t = lane & 3, row = MPR + seq * 4 + t;
            const float m = A.in[I_MM][seq * 8 + h];
            const float ig = softcap(GT[(size_t)row * 256 + h] + A.in[I_BIG][h]), lf = -softplus(-softcap(GT[(size_t)row * 256 + 8 + h] + A.in[I_BFG][h]));
            const float bc = scan_add<4>(lf, lane), g = ig - bc, gmax = scan_max<4>(g, lane);
            const float mm = fmaxf(m, gmax), alpha = -mm, a = __expf(m - mm), ex = __expf(alpha - bc);
            if (lane < 32) { MG[(size_t)row * 8 + h] = (f32x4){alpha, g, a, ex}; if (t == 3) A.out[O_SM + seq * 8 + h] = bc + mm; }
        } else if (it < 384) {
            const int q = it - 256, seq = q >> 5, c = q & 31, hd = lane, rowb = seq * SEQ + c * 64;
            const float dtb = A.in[I_DTB][hd], Aneg = -__expf(A.in[I_ALOG][hd]); float ac = 0.f;
            float gv[64];
#pragma unroll
            for (int t = 0; t < 64; ++t) { const float* rp = GT + (size_t)(rowb + t) * 256 + 16; gv[t] = rp[hd]; }
#pragma unroll
            for (int t = 0; t < 64; ++t) { const float dt = softplus(gv[t] + dtb); ac += dt * Aneg; SG[(size_t)(rowb + t) * 64 + hd] = (f32x2){dt, ac}; }
        } else {
            const int seq = it - 384, hd = lane; const float dtb = A.in[I_DTB][hd], Aneg = -__expf(A.in[I_ALOG][hd]); float ac = 0.f;
#pragma unroll
            for (int t = 0; t < 4; ++t) { const int row = MPR + seq * 4 + t; const float dt = softplus(GT[(size_t)row * 256 + 16 + hd] + dtb); ac += dt * Aneg; SG[(size_t)row * 64 + hd] = (f32x2){dt, ac}; }
        }
    }
}
__device__ __forceinline__ void mlstm_m_carry(const Args& A, int lane) {
    if (lane < 32) { const f32x2* CS = (const f32x2*)(A.ws + WS_CS); f32x2* MPD = (f32x2*)(A.ws + WS_MPD); float m = -INFINITY;
        for (int c = 0; c < 32; ++c) { const f32x2 cs = CS[lane * 32 + c]; const float mm = fmaxf(m, cs[1]); MPD[lane * 32 + c] = (f32x2){m, __expf(m - mm)}; m = cs[0] + mm; }
        A.out[O_PM + lane] = m; }
}

__device__ __forceinline__ bf16x8 as_bf16x8(v4u v) { return __builtin_bit_cast(bf16x8, v); }
__device__ __forceinline__ f32x4 mfma16(bf16x8 a, bf16x8 b, f32x4 c) { return __builtin_amdgcn_mfma_f32_16x16x32_bf16(a, b, c, 0, 0, 0); }
__device__ __forceinline__ v4u pack8(f32x4 a, f32x4 b) { v4u r; r.x = pk2(a[0], a[1]); r.y = pk2(a[2], a[3]); r.z = pk2(b[0], b[1]); r.w = pk2(b[2], b[3]); return r; }
__device__ __forceinline__ float sum8bf(v4u v) { return ((bflo(v.x) + bfhi(v.x)) + (bflo(v.y) + bfhi(v.y))) + ((bflo(v.z) + bfhi(v.z)) + (bflo(v.w) + bfhi(v.w))); }

constexpr int M1_Q = 0, M1_K = 33792, M1_VT = 70656, M1_P = 107520, M1_G = 116736;
__device__ __forceinline__ void m1_unit(const Args& A, LAS unsigned char* lds, int unit, int tid, int lane, int wave) {
    const int bh = unit >> 5, c = unit & 31, b = bh >> 3, h = bh & 7, row0 = b * SEQ + c * 64;
    LAS bf16* Qs = (LAS bf16*)(lds + M1_Q); LAS bf16* Ks = (LAS bf16*)(lds + M1_K); LAS bf16* Kw = Ks; LAS bf16* Vt = (LAS bf16*)(lds + M1_VT); LAS bf16* Ps = (LAS bf16*)(lds + M1_P);
    LAS float* aS = (LAS float*)(lds + M1_G); LAS float* gS = aS + 64; LAS float* wkS = aS + 128;
    const bf16* QK = (const bf16*)(A.ws + WS_QK); const bf16* PROJ = (const bf16*)(A.ws + WS_PROJ); const f32x4* MG = (const f32x4*)(A.ws + WS_MG); const f32x2* MPD = (const f32x2*)(A.ws + WS_MPD);
    bf16* NUMI = (bf16*)(A.ws + WS_NUMI); bf16* KWT = (bf16*)(A.ws + WS_KWT) + (size_t)unit * 16384; bf16* VTG = (bf16*)(A.ws + WS_VT) + (size_t)unit * 32768;
    float* KWS = (float*)(A.ws + WS_KWS); float* DENI = (float*)(A.ws + WS_DENI);
    const int l4 = lane >> 4, l15 = lane & 15;
    v4u vr0[4], vr1[4], qr[4], kr[4];
#pragma unroll
    for (int i = 0; i < 4; ++i) { const int piece = tid + NTHREADS * i, r = piece >> 5, cc = piece & 31;
        const bf16* sp = QK + (size_t)(row0 + r) * DM + h * 512 + cc * 8;
        qr[i] = *(const v4u*)sp; kr[i] = *(const v4u*)(sp + 256);
        { const int rv = piece & 63, cv = piece >> 6; const bf16* vp = PROJ + (size_t)(row0 + rv) * NPROJ + 4096 + h * 512 + cv * 8;
          vr0[i] = *(const v4u*)vp; vr1[i] = *(const v4u*)(vp + 256); } }
    __builtin_amdgcn_sched_barrier(0);
#pragma unroll
    for (int i = 0; i < 4; ++i) { const int piece = tid + NTHREADS * i, r = piece >> 5, cc = piece & 31;
        *(LAS v4u*)(Qs + r * 264 + cc * 8) = qr[i]; *(LAS v4u*)(Ks + r * 264 + cc * 8) = kr[i]; }
    if (tid < 64) { const f32x4 mg = MG[(size_t)(row0 + tid) * 8 + h]; const float mp = MPD[unit][0]; aS[tid] = -fmaxf(mp, mg[2]); gS[tid] = mg[1]; }
#define M1_VT_WRITE(vr) do { _Pragma("unroll") for (int i = 0; i < 4; ++i) { const int piece = tid + NTHREADS * i, r = piece & 63, cc = piece >> 6; const unsigned w_[4] = {vr[i].x, vr[i].y, vr[i].z, vr[i].w}; \
        _Pragma("unroll") for (int e = 0; e < 4; ++e) { Vt[(cc * 8 + 2 * e) * 72 + r] = (bf16)(w_[e] & 0xffffu); Vt[(cc * 8 + 2 * e + 1) * 72 + r] = (bf16)(w_[e] >> 16); } } } while (0)
    M1_VT_WRITE(vr0);
    __syncthreads();
    if (tid < 64) wkS[tid] = __expf(aS[63] + gS[tid]);
    { const int mt = wave >> 1;
#pragma unroll
      for (int e = 0; e < 2; ++e) { const int nt = (wave & 1) * 2 + e;
          const f32x4 acc = mma_nt<256>(Qs + mt * 16 * 264, 264, Ks + nt * 16 * 264, 264, (f32x4){0.f, 0.f, 0.f, 0.f}, lane);
#pragma unroll
          for (int i = 0; i < 4; ++i) { const int t = mt * 16 + 4 * l4 + i, s = nt * 16 + l15;
              const float p = (s <= t) ? acc[i] * __expf(aS[t] + gS[s]) : 0.f; Ps[t * 72 + s] = (bf16)f2bf(p); } } }
    unsigned kreg[4][4];
#pragma unroll
    for (int i = 0; i < 4; ++i) { const int pair = tid + NTHREADS * i, d = pair & 255, sg = pair >> 8;
#pragma unroll
        for (int e = 0; e < 4; ++e) kreg[i][e] = (unsigned)Ks[(sg * 8 + 2 * e) * 264 + d] | ((unsigned)Ks[(sg * 8 + 2 * e + 1) * 264 + d] << 16); }
    __syncthreads();
#pragma unroll
    for (int i = 0; i < 4; ++i) { const int pair = tid + NTHREADS * i, d = pair & 255, sg = pair >> 8; v4u w;
        w.x = pk2(bflo(kreg[i][0]) * wkS[sg * 8 + 0], bfhi(kreg[i][0]) * wkS[sg * 8 + 1]); w.y = pk2(bflo(kreg[i][1]) * wkS[sg * 8 + 2], bfhi(kreg[i][1]) * wkS[sg * 8 + 3]);
        w.z = pk2(bflo(kreg[i][2]) * wkS[sg * 8 + 4], bfhi(kreg[i][2]) * wkS[sg * 8 + 5]); w.w = pk2(bflo(kreg[i][3]) * wkS[sg * 8 + 6], bfhi(kreg[i][3]) * wkS[sg * 8 + 7]);
        *(LAS v4u*)(Kw + d * 72 + sg * 8) = w; }
    { const int t = tid >> 3, sg = tid & 7; float ps = sum8bf(*(const LAS v4u*)(Ps + t * 72 + sg * 8));
      ps = sum8(ps);
      if (sg == 0) DENI[(size_t)(row0 + t) * 8 + h] = ps; }
    __syncthreads();
#define M1_NUMI(hf) do { const int tt = wave & 3, vbase = (wave >> 2) * 8; \
        _Pragma("unroll") for (int i = 0; i < 8; ++i) { const int vtile = vbase + i; \
            const f32x4 acc = mma_nt<64>(Vt + vtile * 16 * 72, 72, Ps + tt * 16 * 72, 72, (f32x4){0.f, 0.f, 0.f, 0.f}, lane); \
            v2u w_; w_.x = pk2(acc[0], acc[1]); w_.y = pk2(acc[2], acc[3]); \
            *(v2u*)(NUMI + (size_t)(row0 + tt * 16 + l15) * DM + h * 512 + (hf) * 256 + vtile * 16 + 4 * l4) = w_; } } while (0)
#define M1_VT_EXPORT(hf) do { _Pragma("unroll") for (int i = 0; i < 4; ++i) { const int pair = tid + NTHREADS * i, v = pair >> 3, sg = pair & 7; \
            *(v4u*)(VTG + (size_t)((hf) * 256 + v) * 64 + sg * 8) = *(const LAS v4u*)(Vt + v * 72 + sg * 8); } } while (0)
    M1_NUMI(0);
#pragma unroll
    for (int i = 0; i < 4; ++i) { const int pair = tid + NTHREADS * i, d = pair >> 3, sg = pair & 7; *(v4u*)(KWT + (size_t)d * 64 + sg * 8) = *(const LAS v4u*)(Kw + d * 72 + sg * 8); }
    if (tid < 256) { float s = 0.f;
#pragma unroll
        for (int i = 0; i < 8; ++i) s += sum8bf(*(const LAS v4u*)(Kw + tid * 72 + i * 8));
        KWS[(size_t)unit * 256 + tid] = s; }
    M1_VT_EXPORT(0);
    __syncthreads();
    M1_VT_WRITE(vr1);
    __syncthreads();
    M1_NUMI(1);
    M1_VT_EXPORT(1);
    __syncthreads();
#undef M1_VT_WRITE
#undef M1_NUMI
#undef M1_VT_EXPORT
}

constexpr int S1_C = 0, S1_B = 17408, S1_CB = 0, S1_BT = 34816, S1_XT = 53248, S1_DT = 126976, S1_AC = 129024;
__device__ __forceinline__ void s1_unit(const Args& A, LAS unsigned char* lds, int unit, int tid, int lane, int wave) {
    const int bg = unit >> 5, c = unit & 31, b = bg >> 3, g = bg & 7, row0 = b * SEQ + c * 64;
    LAS bf16* Cs = (LAS bf16*)(lds + S1_C); LAS bf16* Bs = (LAS bf16*)(lds + S1_B); LAS float* CBs = (LAS float*)(lds + S1_CB); LAS bf16* Bt = (LAS bf16*)(lds + S1_BT); LAS bf16* Xt = (LAS bf16*)(lds + S1_XT);
    LAS float* dtS = (LAS float*)(lds + S1_DT); LAS float* acS = (LAS float*)(lds + S1_AC);
    const bf16* XBC = (const bf16*)(A.ws + WS_XBC); const f32x2* SG = (const f32x2*)(A.ws + WS_SG);
    bf16* YI = (bf16*)(A.ws + WS_YI); bf16* BMT = (bf16*)(A.ws + WS_BMT) + (size_t)unit * 8192; bf16* XWT = (bf16*)(A.ws + WS_XWT);
    const int l4 = lane >> 4, l15 = lane & 15;
    v4u bmr[2], cmr[2], xr[8];
#pragma unroll
    for (int i = 0; i < 2; ++i) { const int piece = tid + NTHREADS * i, r = piece & 63, cc = piece >> 6;
        const bf16* sp = XBC + (size_t)(row0 + r) * 6144 + 4096 + g * 128 + cc * 8; bmr[i] = *(const v4u*)sp; cmr[i] = *(const v4u*)(sp + 1024); }
#pragma unroll
    for (int i = 0; i < 8; ++i) { const int piece = tid + NTHREADS * i, r = piece & 63, cc = piece >> 6; xr[i] = *(const v4u*)(XBC + (size_t)(row0 + r) * 6144 + g * 512 + cc * 8); }
    __builtin_amdgcn_sched_barrier(0);
#pragma unroll
    for (int i = 0; i < 2; ++i) { const int piece = tid + NTHREADS * i, r = piece & 63, cc = piece >> 6;
        const v4u bm = bmr[i], cm = cmr[i];
        *(LAS v4u*)(Cs + r * 136 + cc * 8) = cm; *(LAS v4u*)(Bs + r * 136 + cc * 8) = bm;
        const unsigned w[4] = {bm.x, bm.y, bm.z, bm.w};
#pragma unroll
        for (int e = 0; e < 4; ++e) { Bt[(cc * 8 + 2 * e) * 72 + r] = (bf16)(w[e] & 0xffffu); Bt[(cc * 8 + 2 * e + 1) * 72 + r] = (bf16)(w[e] >> 16); } }
#pragma unroll
    for (int i = 0; i < 8; ++i) { const int piece = tid + NTHREADS * i, r = piece & 63, cc = piece >> 6;
        const v4u xv = xr[i]; const unsigned w[4] = {xv.x, xv.y, xv.z, xv.w};
#pragma unroll
        for (int e = 0; e < 4; ++e) { Xt[(cc * 8 + 2 * e) * 72 + r] = (bf16)(w[e] & 0xffffu); Xt[(cc * 8 + 2 * e + 1) * 72 + r] = (bf16)(w[e] >> 16); } }
    { const int hh = tid >> 6, t = tid & 63; const f32x2 sg = SG[(size_t)(row0 + t) * 64 + g * 8 + hh]; dtS[hh * 64 + t] = sg[0]; acS[hh * 64 + t] = sg[1]; }
    __syncthreads();
    f32x4 cb[2];
    { const int mt = wave >> 1;
#pragma unroll
      for (int e = 0; e < 2; ++e) { const int nt = (wave & 1) * 2 + e; cb[e] = mma_nt<128>(Cs + mt * 16 * 136, 136, Bs + nt * 16 * 136, 136, (f32x4){0.f, 0.f, 0.f, 0.f}, lane); } }
    __syncthreads();
    { const int mt = wave >> 1;
#pragma unroll
      for (int e = 0; e < 2; ++e) { const int nt = (wave & 1) * 2 + e;
#pragma unroll
          for (int i = 0; i < 4; ++i) CBs[(mt * 16 + 4 * l4 + i) * 68 + nt * 16 + l15] = cb[e][i]; } }
#pragma unroll
    for (int i = 0; i < 2; ++i) { const int pair = tid + NTHREADS * i, n = pair >> 3, sg = pair & 7; *(v4u*)(BMT + (size_t)n * 64 + sg * 8) = *(const LAS v4u*)(Bt + n * 72 + sg * 8); }
    __syncthreads();
    { const int hh = wave, head = g * 8 + hh; const float a_end = acS[hh * 64 + 63];
      bf16* xw = XWT + (size_t)((b * 64 + head) * 32 + c) * 4096;
#pragma unroll
      for (int i = 0; i < 8; ++i) { const int piece = lane + 64 * i, p = piece >> 3, sg = piece & 7; const v4u xv = *(const LAS v4u*)(Xt + (hh * 64 + p) * 72 + sg * 8);
          float wg[8];
#pragma unroll
          for (int e = 0; e < 8; ++e) wg[e] = dtS[hh * 64 + sg * 8 + e] * __expf(a_end - acS[hh * 64 + sg * 8 + e]);
          v4u o; o.x = pk2(bflo(xv.x) * wg[0], bfhi(xv.x) * wg[1]); o.y = pk2(bflo(xv.y) * wg[2], bfhi(xv.y) * wg[3]); o.z = pk2(bflo(xv.z) * wg[4], bfhi(xv.z) * wg[5]); o.w = pk2(bflo(xv.w) * wg[6], bfhi(xv.w) * wg[7]);
          *(v4u*)(xw + (size_t)p * 64 + sg * 8) = o; }
#pragma unroll
      for (int tt = 0; tt < 4; ++tt) { const int t = tt * 16 + l15; const float act = acS[hh * 64 + t];
          bf16x8 Y[2];
#pragma unroll
          for (int ks = 0; ks < 2; ++ks) { const int s0 = 32 * ks + 8 * l4; const f32x4 c0 = *(const LAS f32x4*)(CBs + t * 68 + s0), c1 = *(const LAS f32x4*)(CBs + t * 68 + s0 + 4); float gv[8];
#pragma unroll
              for (int e = 0; e < 8; ++e) { const int s = s0 + e; const float cbv = e < 4 ? c0[e & 3] : c1[e & 3]; gv[e] = (s <= t) ? cbv * __expf(act - acS[hh * 64 + s]) * dtS[hh * 64 + s] : 0.f; }
              v4u yv; yv.x = pk2(gv[0], gv[1]); yv.y = pk2(gv[2], gv[3]); yv.z = pk2(gv[4], gv[5]); yv.w = pk2(gv[6], gv[7]); Y[ks] = as_bf16x8(yv); }
#pragma unroll
          for (int pt = 0; pt < 4; ++pt) { f32x4 acc = (f32x4){0.f, 0.f, 0.f, 0.f};
#pragma unroll
              for (int ks = 0; ks < 2; ++ks) acc = mfma16(*(const LAS bf16x8*)(Xt + (hh * 64 + pt * 16 + l15) * 72 + 32 * ks + 8 * l4), Y[ks], acc);
              v2u w; w.x = pk2(acc[0], acc[1]); w.y = pk2(acc[2], acc[3]);
              *(v2u*)(YI + (size_t)(row0 + t) * DM + head * 64 + pt * 16 + 4 * l4) = w; } } }
    __syncthreads();
}

__device__ __forceinline__ void nscan_item(const Args& A, int bh, int tid) {
    if (tid < 256) { const float* KWS = (const float*)(A.ws + WS_KWS); const f32x2* MPD = (const f32x2*)(A.ws + WS_MPD); float* NALL = (float*)(A.ws + WS_NALL);
        float kw[32], dc[32];
#pragma unroll
        for (int c = 0; c < 32; ++c) { kw[c] = KWS[(size_t)(bh * 32 + c) * 256 + tid]; dc[c] = MPD[bh * 32 + c][1]; }
        float n = 0.f;
#pragma unroll
        for (int c = 0; c < 32; ++c) { NALL[(size_t)(bh * 32 + c) * 256 + tid] = n; n = dc[c] * n + kw[c]; }
        A.out[O_PN + bh * 256 + tid] = n; }
}

constexpr int M2_Q = 0, M2_KW = 33792, M2_VT = 70656;
__device__ __forceinline__ void m2_item(const Args& A, LAS unsigned char* lds, int item, int tid, int lane, int wave) {
    const int bh = item >> 2, j = item & 3, b = bh >> 3, h = bh & 7;
    LAS bf16* Qs = (LAS bf16*)(lds + M2_Q); LAS bf16* Kw = (LAS bf16*)(lds + M2_KW); LAS bf16* Vt = (LAS bf16*)(lds + M2_VT);
    const bf16* QK = (const bf16*)(A.ws + WS_QK); const bf16* KWT = (const bf16*)(A.ws + WS_KWT); const bf16* VTG = (const bf16*)(A.ws + WS_VT); const f32x2* MPD = (const f32x2*)(A.ws + WS_MPD);
    bf16* INTER = (bf16*)(A.ws + WS_INTER);
    const int l4 = lane >> 4, l15 = lane & 15;
    f32x4 acc[16];
#pragma unroll
    for (int i = 0; i < 16; ++i) acc[i] = (f32x4){0.f, 0.f, 0.f, 0.f};
    v4u rq[4], rk[4], rv[2]; float dnext;
#define M2_LOAD(cc_) do { const int r0_ = b * SEQ + (cc_) * 64; const size_t un_ = (size_t)(bh * 32 + (cc_)); \
        _Pragma("unroll") for (int i = 0; i < 4; ++i) { const int piece = tid + NTHREADS * i; rq[i] = *(const v4u*)(QK + (size_t)(r0_ + (piece >> 5)) * DM + h * 512 + (piece & 31) * 8); rk[i] = *(const v4u*)(KWT + un_ * 16384 + (size_t)piece * 8); } \
        _Pragma("unroll") for (int i = 0; i < 2; ++i) { const int piece = tid + NTHREADS * i; rv[i] = *(const v4u*)(VTG + un_ * 32768 + (size_t)(j * 128) * 64 + (size_t)piece * 8); } \
        dnext = MPD[un_][1]; } while (0)
    M2_LOAD(0);
    for (int c = 0; c < 32; ++c) {
        const int row0 = b * SEQ + c * 64;
#pragma unroll
        for (int i = 0; i < 4; ++i) { const int piece = tid + NTHREADS * i; *(LAS v4u*)(Qs + (piece >> 5) * 264 + (piece & 31) * 8) = rq[i]; *(LAS v4u*)(Kw + (piece >> 3) * 72 + (piece & 7) * 8) = rk[i]; }
#pragma unroll
        for (int i = 0; i < 2; ++i) { const int piece = tid + NTHREADS * i; *(LAS v4u*)(Vt + (piece >> 3) * 72 + (piece & 7) * 8) = rv[i]; }
        const float decay = dnext;
        if (c < 31) M2_LOAD(c + 1);
        __syncthreads();
        f32x4 ia[4];
#pragma unroll
        for (int tt = 0; tt < 4; ++tt) ia[tt] = (f32x4){0.f, 0.f, 0.f, 0.f};
        { v4u yq[2][4];
#define M2_QLD(ks_, buf_) do { _Pragma("unroll") for (int tt = 0; tt < 4; ++tt) { const LAS bf16* qp = Qs + (tt * 16 + l15) * 264 + 32 * (ks_) + 4 * l4; const v2u y0 = *(const LAS v2u*)qp, y1 = *(const LAS v2u*)(qp + 16); yq[buf_][tt] = (v4u){y0.x, y0.y, y1.x, y1.y}; } } while (0)
          M2_QLD(0, 0);
#pragma unroll
          for (int ks = 0; ks < 8; ++ks) { if (ks < 7) M2_QLD(ks + 1, (ks + 1) & 1);
              const bf16x8 X = as_bf16x8(pack8(acc[2 * ks], acc[2 * ks + 1]));
#pragma unroll
              for (int tt = 0; tt < 4; ++tt) ia[tt] = mfma16(X, as_bf16x8(yq[ks & 1][tt]), ia[tt]); }
#undef M2_QLD
        }
#pragma unroll
        for (int tt = 0; tt < 4; ++tt) { v2u w; w.x = pk2(ia[tt][0], ia[tt][1]); w.y = pk2(ia[tt][2], ia[tt][3]);
            *(v2u*)(INTER + (size_t)(row0 + tt * 16 + l15) * DM + h * 512 + j * 128 + wave * 16 + 4 * l4) = w; }
        bf16x8 yv[2];
#pragma unroll
        for (int ks = 0; ks < 2; ++ks) yv[ks] = *(const LAS bf16x8*)(Vt + (wave * 16 + l15) * 72 + ks * 32 + l4 * 8);
        { bf16x8 xk[4][2];
#define M2_KLD(dt_) do { _Pragma("unroll") for (int ks = 0; ks < 2; ++ks) xk[(dt_) & 3][ks] = *(const LAS bf16x8*)(Kw + ((dt_) * 16 + l15) * 72 + ks * 32 + l4 * 8); } while (0)
          M2_KLD(0); M2_KLD(1); M2_KLD(2);
#pragma unroll
          for (int dt = 0; dt < 16; ++dt) { if (dt < 13) M2_KLD(dt + 3);
              acc[dt] = acc[dt] * decay;
#pragma unroll
              for (int ks = 0; ks < 2; ++ks) acc[dt] = mfma16(xk[dt & 3][ks], yv[ks], acc[dt]); }
#undef M2_KLD
        }
        __syncthreads();
    }
#undef M2_LOAD
    float* pC = A.out + O_PC + (size_t)(bh * 256) * 512 + j * 128 + wave * 16 + l15;
#pragma unroll
    for (int dt = 0; dt < 16; ++dt)
#pragma unroll
        for (int i = 0; i < 4; ++i) pC[(size_t)(dt * 16 + 4 * l4 + i) * 512] = acc[dt][i];
}

constexpr int S2_C = 0, S2_BT = 17408, S2_XW = 35840;
__device__ __forceinline__ void s2_item(const Args& A, LAS unsigned char* lds, int item, int tid, int lane, int wave) {
    const int b = item >> 5, pair = item & 31, hsel = wave >> 2, head = pair * 2 + hsel, g = pair >> 2, pt = wave & 3;
    LAS bf16* Cs = (LAS bf16*)(lds + S2_C); LAS bf16* Bt = (LAS bf16*)(lds + S2_BT); LAS bf16* Xw = (LAS bf16*)(lds + S2_XW);
    const bf16* XBC = (const bf16*)(A.ws + WS_XBC); const bf16* BMT = (const bf16*)(A.ws + WS_BMT); const bf16* XWT = (const bf16*)(A.ws + WS_XWT); const f32x2* SG = (const f32x2*)(A.ws + WS_SG);
    bf16* YS = (bf16*)(A.ws + WS_YS);
    const int l4 = lane >> 4, l15 = lane & 15;
    f32x4 acc[8];
#pragma unroll
    for (int i = 0; i < 8; ++i) acc[i] = (f32x4){0.f, 0.f, 0.f, 0.f};
    v4u rcA[2], rbA[2], rxA[2], rcB[2], rbB[2], rxB[2]; float enA, enB;
    const int clo = (tid >> 4) * 6144 + (tid & 15) * 8, klo = tid * 8, slo = l15 * DM + 4 * l4;
#define S2_LOAD(cc_, rc, rb, rx, en) do { const int r0_ = b * SEQ + (cc_) * 64; \
        _Pragma("unroll") for (int i = 0; i < 2; ++i) { const bf16* cb_ = XBC + (size_t)(r0_ + 32 * i) * 6144 + 5120 + g * 128; const bf16* bb_ = BMT + (size_t)((b * 8 + g) * 32 + (cc_)) * 8192 + (size_t)(NTHREADS * i) * 8; \
            const bf16* xb_ = XWT + (size_t)((b * 64 + pair * 2 + i) * 32 + (cc_)) * 4096; rc[i] = *(const v4u*)(cb_ + clo); rb[i] = *(const v4u*)(bb_ + klo); rx[i] = *(const v4u*)(xb_ + klo); } \
        en = SG[(size_t)(r0_ + 63) * 64 + head][1]; } while (0)
#define S2_STEP(c, rc, rb, rx, en) do { \
        const int row0 = b * SEQ + (c) * 64; \
        _Pragma("unroll") for (int i = 0; i < 2; ++i) { const int piece = tid + NTHREADS * i; *(LAS v4u*)(Cs + (piece >> 4) * 136 + (piece & 15) * 8) = rc[i]; *(LAS v4u*)(Bt + (piece >> 3) * 72 + (piece & 7) * 8) = rb[i]; *(LAS v4u*)(Xw + (piece >> 3) * 72 + (piece & 7) * 8) = rx[i]; } \
        const float ea = __expf(en); \
        if ((c) + 2 < 32) S2_LOAD((c) + 2, rc, rb, rx, en); \
        __syncthreads(); \
        f32x4 ia[4]; \
        _Pragma("unroll") for (int tt = 0; tt < 4; ++tt) ia[tt] = (f32x4){0.f, 0.f, 0.f, 0.f}; \
        _Pragma("unroll") for (int ks = 0; ks < 4; ++ks) { const bf16x8 X = as_bf16x8(pack8(acc[2 * ks], acc[2 * ks + 1])); \
            _Pragma("unroll") for (int tt = 0; tt < 4; ++tt) { const LAS bf16* cp = Cs + (tt * 16 + l15) * 136 + 32 * ks + 4 * l4; const v2u y0 = *(const LAS v2u*)cp, y1 = *(const LAS v2u*)(cp + 16); \
                ia[tt] = mfma16(X, as_bf16x8((v4u){y0.x, y0.y, y1.x, y1.y}), ia[tt]); } } \
        _Pragma("unroll") for (int tt = 0; tt < 4; ++tt) { v2u w; w.x = pk2(ia[tt][0], ia[tt][1]); w.y = pk2(ia[tt][2], ia[tt][3]); \
            bf16* yb_ = YS + (size_t)(row0 + tt * 16) * DM + head * 64 + pt * 16; *(v2u*)(yb_ + slo) = w; } \
        bf16x8 yv[2]; \
        _Pragma("unroll") for (int ks = 0; ks < 2; ++ks) yv[ks] = *(const LAS bf16x8*)(Xw + (hsel * 64 + pt * 16 + l15) * 72 + ks * 32 + l4 * 8); \
        _Pragma("unroll") for (int nt = 0; nt < 8; ++nt) { acc[nt] = acc[nt] * ea; \
            _Pragma("unroll") for (int ks = 0; ks < 2; ++ks) acc[nt] = mfma16(*(const LAS bf16x8*)(Bt + (nt * 16 + l15) * 72 + ks * 32 + l4 * 8), yv[ks], acc[nt]); } \
        __syncthreads(); } while (0)
    S2_LOAD(0, rcA, rbA, rxA, enA); S2_LOAD(1, rcB, rbB, rxB, enB);
    for (int c = 0; c < 32; c += 2) { S2_STEP(c, rcA, rbA, rxA, enA); S2_STEP(c + 1, rcB, rbB, rxB, enB); }
#undef S2_STEP
#undef S2_LOAD
    float* pH = A.out + O_PSSM + (size_t)((b * 64 + head) * 64 + pt * 16 + l15) * 128 + 4 * l4;
#pragma unroll
    for (int nt = 0; nt < 8; ++nt) *(f32x4*)(pH + nt * 16) = acc[nt];
}

struct M3In { v4u ni, iw, ow, zw; v2u qw; f32x4 n4, mg, mn0, mn1; float mp, deni; };
__device__ __forceinline__ M3In m3_load(const Args& A, int it, int lane) {
    const bf16* NUMI = (const bf16*)(A.ws + WS_NUMI); const bf16* INTER = (const bf16*)(A.ws + WS_INTER); const bf16* PROJ = (const bf16*)(A.ws + WS_PROJ); const bf16* QK = (const bf16*)(A.ws + WS_QK);
    const f32x4* MG = (const f32x4*)(A.ws + WS_MG); const f32x2* MPD = (const f32x2*)(A.ws + WS_MPD); const float* NALL = (const float*)(A.ws + WS_NALL); const float* DENI = (const float*)(A.ws + WS_DENI);
    const int row = it >> 3, h = it & 7, b = row >> 11, c = (row >> 6) & 31, unit = (b * 8 + h) * 32 + c, col = h * 512 + lane * 8; M3In d;
    d.ni = *(const v4u*)(NUMI + (size_t)row * DM + col); d.iw = *(const v4u*)(INTER + (size_t)row * DM + col);
    d.ow = *(const v4u*)(PROJ + (size_t)row * NPROJ + 8192 + col); d.zw = *(const v4u*)(PROJ + (size_t)row * NPROJ + 12288 + col);
    d.qw = *(const v2u*)(QK + (size_t)row * DM + h * 512 + lane * 4); d.n4 = *(const f32x4*)(NALL + (size_t)unit * 256 + lane * 4);
    d.mg = MG[(size_t)row * 8 + h]; d.mp = MPD[unit][0]; d.deni = DENI[(size_t)row * 8 + h];
    d.mn0 = *(const f32x4*)(A.in[I_MNORM] + col); d.mn1 = *(const f32x4*)(A.in[I_MNORM] + col + 4); return d;
}
__device__ __forceinline__ void m3_compute(const Args& A, const M3In& d, int it, int lane) {
    bf16* MIX = (bf16*)(A.ws + WS_MIX); const int row = it >> 3, h = it & 7, col = h * 512 + lane * 8;
    const float mm = fmaxf(d.mp, d.mg[2]), a = __expf(d.mp - mm), ex = __expf(-mm - d.mg[0]);
    const float qn = wave_sum((bflo(d.qw.x) * d.n4[0] + bfhi(d.qw.x) * d.n4[1]) + (bflo(d.qw.y) * d.n4[2] + bfhi(d.qw.y) * d.n4[3]));
    const float dn = fmaxf(fabsf(d.deni + a * qn), ex), rdn = 1.f / dn;
    const float nv[8] = {bflo(d.ni.x), bfhi(d.ni.x), bflo(d.ni.y), bfhi(d.ni.y), bflo(d.ni.z), bfhi(d.ni.z), bflo(d.ni.w), bfhi(d.ni.w)};
    const float iv[8] = {bflo(d.iw.x), bfhi(d.iw.x), bflo(d.iw.y), bfhi(d.iw.y), bflo(d.iw.z), bfhi(d.iw.z), bflo(d.iw.w), bfhi(d.iw.w)};
    const float ov[8] = {bflo(d.ow.x), bfhi(d.ow.x), bflo(d.ow.y), bfhi(d.ow.y), bflo(d.ow.z), bfhi(d.ow.z), bflo(d.ow.w), bfhi(d.ow.w)};
    const float zv[8] = {bflo(d.zw.x), bfhi(d.zw.x), bflo(d.zw.y), bfhi(d.zw.y), bflo(d.zw.z), bfhi(d.zw.z), bflo(d.zw.w), bfhi(d.zw.w)};
    const float mn[8] = {d.mn0[0], d.mn0[1], d.mn0[2], d.mn0[3], d.mn1[0], d.mn1[1], d.mn1[2], d.mn1[3]};
    float pre[8], ss = 0.f;
#pragma unroll
    for (int e = 0; e < 8; ++e) { pre[e] = (nv[e] + a * iv[e]) * rdn * sigm(ov[e]); ss += pre[e] * pre[e]; }
    const float rstd = rsqrtf(wave_sum(ss) * (1.f / 512.f) + EPS);
    float val[8];
#pragma unroll
    for (int e = 0; e < 8; ++e) val[e] = pre[e] * rstd * mn[e] * silu(zv[e]);
    v4u o; o.x = pk2(val[0], val[1]); o.y = pk2(val[2], val[3]); o.z = pk2(val[4], val[5]); o.w = pk2(val[6], val[7]);
    *(v4u*)(MIX + (size_t)row * LDM + col) = o;
}
__device__ __forceinline__ void m3_pass(const Args& A, int gw, int NGW, int lane) {
    int it = gw; if (it >= MPR * 8) return;
    M3In cur = m3_load(A, it, lane);
    for (;;) { const int nit = it + NGW; const bool has = nit < MPR * 8; M3In nxt; if (has) nxt = m3_load(A, nit, lane);
        m3_compute(A, cur, it, lane); if (!has) break; cur = nxt; it = nit; }
}
struct S3In { v4u yi, ys, xw, zw; f32x2 sg; f32x4 sn0, sn1; float dsk; };
__device__ __forceinline__ S3In s3_load(const Args& A, int it, int lane) {
    const bf16* YI = (const bf16*)(A.ws + WS_YI); const bf16* YS = (const bf16*)(A.ws + WS_YS); const bf16* PROJ = (const bf16*)(A.ws + WS_PROJ); const bf16* XBC = (const bf16*)(A.ws + WS_XBC);
    const f32x2* SG = (const f32x2*)(A.ws + WS_SG);
    const int row = it >> 3, g = it & 7, col = g * 512 + lane * 8, head = g * 8 + (lane >> 3); S3In d;
    d.yi = *(const v4u*)(YI + (size_t)row * DM + col); d.ys = *(const v4u*)(YS + (size_t)row * DM + col);
    d.xw = *(const v4u*)(XBC + (size_t)row * 6144 + col); d.zw = *(const v4u*)(PROJ + (size_t)row * NPROJ + 16384 + col);
    d.sg = SG[(size_t)row * 64 + head]; d.dsk = A.in[I_DSKIP][head];
    d.sn0 = *(const f32x4*)(A.in[I_SNORM] + col); d.sn1 = *(const f32x4*)(A.in[I_SNORM] + col + 4); return d;
}
__device__ __forceinline__ void s3_compute(const Args& A, const S3In& d, int it, int lane) {
    bf16* MIX = (bf16*)(A.ws + WS_MIX); const int row = it >> 3, g = it & 7, col = g * 512 + lane * 8; const float eac = __expf(d.sg[1]);
    const float a1[8] = {bflo(d.yi.x), bfhi(d.yi.x), bflo(d.yi.y), bfhi(d.yi.y), bflo(d.yi.z), bfhi(d.yi.z), bflo(d.yi.w), bfhi(d.yi.w)};
    const float a2[8] = {bflo(d.ys.x), bfhi(d.ys.x), bflo(d.ys.y), bfhi(d.ys.y), bflo(d.ys.z), bfhi(d.ys.z), bflo(d.ys.w), bfhi(d.ys.w)};
    const float xv[8] = {bflo(d.xw.x), bfhi(d.xw.x), bflo(d.xw.y), bfhi(d.xw.y), bflo(d.xw.z), bfhi(d.xw.z), bflo(d.xw.w), bfhi(d.xw.w)};
    const float zv[8] = {bflo(d.zw.x), bfhi(d.zw.x), bflo(d.zw.y), bfhi(d.zw.y), bflo(d.zw.z), bfhi(d.zw.z), bflo(d.zw.w), bfhi(d.zw.w)};
    const float sn[8] = {d.sn0[0], d.sn0[1], d.sn0[2], d.sn0[3], d.sn1[0], d.sn1[1], d.sn1[2], d.sn1[3]};
    float pre[8], ss = 0.f;
#pragma unroll
    for (int e = 0; e < 8; ++e) { pre[e] = (a1[e] + eac * a2[e] + d.dsk * xv[e]) * silu(zv[e]); ss += pre[e] * pre[e]; }
    const float rstd = rsqrtf(wave_sum(ss) * (1.f / 512.f) + EPS);
    v4u o; o.x = pk2(pre[0] * rstd * sn[0], pre[1] * rstd * sn[1]); o.y = pk2(pre[2] * rstd * sn[2], pre[3] * rstd * sn[3]); o.z = pk2(pre[4] * rstd * sn[4], pre[5] * rstd * sn[5]); o.w = pk2(pre[6] * rstd * sn[6], pre[7] * rstd * sn[7]);
    *(v4u*)(MIX + (size_t)row * LDM + 4096 + col) = o;
}
__device__ __forceinline__ void s3_pass(const Args& A, int gw, int NGW, int lane) {
    int it = gw; if (it >= MPR * 8) return;
    S3In cur = s3_load(A, it, lane);
    for (;;) { const int nit = it + NGW; const bool has = nit < MPR * 8; S3In nxt; if (has) nxt = s3_load(A, nit, lane);
        s3_compute(A, cur, it, lane); if (!has) break; cur = nxt; it = nit; }
}

__device__ __forceinline__ void mlstm_sample_item(const Args& A, LAS unsigned char* lds, int item, int tid, int lane, int wave) {
    const int seq = item >> 3, h = item & 7;
    LAS float* qT = (LAS float*)lds; LAS float* kT = qT + 1024; LAS float* kwT = qT + 2048; LAS float* vS = qT + 3072; LAS float* n0S = qT + 5120; LAS float* gt = qT + 5376;
    LAS float* SSd = qT + 5408; LAS float* PSd = qT + 5440; LAS float* denS = qT + 5472; LAS float* wkS = qT + 5480; LAS float* ssS = qT + 5488; LAS float* accl = qT + 6144;
    const bf16* QK = (const bf16*)(A.ws + WS_QK); const bf16* PROJ = (const bf16*)(A.ws + WS_PROJ); const float* MG = (const float*)(A.ws + WS_MG);
    bf16* MIX = (bf16*)(A.ws + WS_MIX); const float* mnorm = A.in[I_MNORM];
    const int rowb = MPR + seq * 4;
    { const int idx = tid * 2, t = idx >> 8, d = idx & 255; const bf16* sp = QK + (size_t)(rowb + t) * DM + h * 512 + d;
      const unsigned qw = *(const unsigned*)sp, kw = *(const unsigned*)(sp + 256);
      qT[d * 4 + t] = bflo(qw); qT[(d + 1) * 4 + t] = bfhi(qw); kT[d * 4 + t] = bflo(kw); kT[(d + 1) * 4 + t] = bfhi(kw); }
    { const int idx = tid * 4, t = idx >> 9, v = idx & 511; const v2u vw = *(const v2u*)(PROJ + (size_t)(rowb + t) * NPROJ + 4096 + h * 512 + v);
      *(LAS f32x4*)(vS + t * 512 + v) = (f32x4){bflo(vw.x), bfhi(vw.x), bflo(vw.y), bfhi(vw.y)}; }
    if (tid < 256) n0S[tid] = A.in[I_MN][(size_t)(seq * 8 + h) * 256 + tid];
    if (tid < 16) { const int comp = tid >> 2, t = tid & 3; gt[comp * 4 + t] = MG[((size_t)(rowb + t) * 8 + h) * 4 + comp]; }
    __syncthreads();
    for (int pp = wave; pp < 20; pp += NWAVES) { float part = 0.f;
        if (pp < 16) { const int t = pp >> 2, s = pp & 3;
#pragma unroll
            for (int i = 0; i < 4; ++i) part += qT[(lane + 64 * i) * 4 + t] * kT[(lane + 64 * i) * 4 + s]; }
        else { const int t = pp - 16;
#pragma unroll
            for (int i = 0; i < 4; ++i) part += qT[(lane + 64 * i) * 4 + t] * n0S[lane + 64 * i]; }
        part = wave_sum(part); if (lane == 0) SSd[pp] = part; }
    __syncthreads();
    if (tid < 16) { const int t = tid >> 2, s = tid & 3; PSd[tid] = (s <= t) ? SSd[tid] * __expf(gt[t] + gt[4 + s]) : 0.f; }
    if (tid >= 64 && tid < 68) { const int s = tid - 64; wkS[s] = __expf(gt[3] + gt[4 + s]); }
    __syncthreads();
    if (tid < 4) denS[tid] = (PSd[tid * 4] + PSd[tid * 4 + 1]) + (PSd[tid * 4 + 2] + PSd[tid * 4 + 3]) + gt[8 + tid] * SSd[16 + tid];
    { const int i0 = tid * 2; kwT[i0] = kT[i0] * wkS[i0 & 3]; kwT[i0 + 1] = kT[i0 + 1] * wkS[(i0 + 1) & 3]; }
    __syncthreads();
    const float decay = gt[8 + 3];
    const int dr = wave >> 1, v4 = (tid & 127) * 4;
    f32x4 vv[4], acc[4];
#pragma unroll
    for (int s = 0; s < 4; ++s) { vv[s] = *(const LAS f32x4*)(vS + s * 512 + v4); acc[s] = (f32x4){0.f, 0.f, 0.f, 0.f}; }
    const float* C0 = A.in[I_MC] + (size_t)((seq * 8 + h) * 256 + dr) * 512; float* C1 = A.out + O_SC + (size_t)((seq * 8 + h) * 256 + dr) * 512;
    f32x4 cbuf[2][8];
#pragma unroll
    for (int r = 0; r < 8; ++r) { const float* rp = C0 + (size_t)(4 * r) * 512; cbuf[0][r] = __builtin_nontemporal_load((const f32x4*)(rp + v4)); }
#pragma unroll
    for (int bt = 0; bt < 8; ++bt) {
        if (bt < 7) {
#pragma unroll
            for (int r = 0; r < 8; ++r) { const float* rp = C0 + (size_t)(4 * ((bt + 1) * 8 + r)) * 512; cbuf[(bt + 1) & 1][r] = __builtin_nontemporal_load((const f32x4*)(rp + v4)); } }
#pragma unroll
        for (int r = 0; r < 8; ++r) { const int d = dr + 4 * (bt * 8 + r); const f32x4 c0 = cbuf[bt & 1][r];
            const f32x4 q4 = *(const LAS f32x4*)(qT + d * 4), kw4 = *(const LAS f32x4*)(kwT + d * 4);
#pragma unroll
            for (int t = 0; t < 4; ++t) acc[t] += q4[t] * c0;
            const f32x4 cn = decay * c0 + kw4[0] * vv[0] + kw4[1] * vv[1] + kw4[2] * vv[2] + kw4[3] * vv[3];
            { float* wp = C1 + (size_t)(4 * (bt * 8 + r)) * 512; __builtin_nontemporal_store(cn, (f32x4*)(wp + v4)); } } }
#pragma unroll
    for (int t = 0; t < 4; ++t) *(LAS f32x4*)(accl + (dr * 4 + t) * 512 + v4) = acc[t];
    __syncthreads();
    float val[4];
    { const int t = dr; f32x4 a = (f32x4){0.f, 0.f, 0.f, 0.f};
#pragma unroll
      for (int r = 0; r < 4; ++r) a += *(const LAS f32x4*)(accl + (r * 4 + t) * 512 + v4);
      f32x4 num = gt[8 + t] * a;
#pragma unroll
      for (int s = 0; s < 4; ++s) num += PSd[t * 4 + s] * vv[s];
      const float dn = fmaxf(fabsf(denS[t]), gt[12 + t]); const int row = rowb + t, col = h * 512 + v4;
      const v2u ow = *(const v2u*)(PROJ + (size_t)row * NPROJ + 8192 + col), zw = *(const v2u*)(PROJ + (size_t)row * NPROJ + 12288 + col);
      const f32x4 o4 = (f32x4){bflo(ow.x), bfhi(ow.x), bflo(ow.y), bfhi(ow.y)}, z4 = (f32x4){bflo(zw.x), bfhi(zw.x), bflo(zw.y), bfhi(zw.y)}; const f32x4 mn = *(const f32x4*)(mnorm + col);
      f32x4 pre; float ss = 0.f;
#pragma unroll
      for (int e = 0; e < 4; ++e) { pre[e] = (num[e] / dn) * sigm(o4[e]); ss += pre[e] * pre[e]; val[e] = pre[e] * mn[e] * silu(z4[e]); }
      ss = wave_sum(ss); if (lane == 0) ssS[wave] = ss; }
    __syncthreads();
    { const float rstd = rsqrtf((ssS[2 * dr] + ssS[2 * dr + 1]) * (1.f / 512.f) + EPS);
      v2u w; w.x = pk2(val[0] * rstd, val[1] * rstd); w.y = pk2(val[2] * rstd, val[3] * rstd); *(v2u*)(MIX + (size_t)(rowb + dr) * LDM + h * 512 + v4) = w; }
    if (tid < 256) { const f32x4 kw = *(const LAS f32x4*)(kwT + tid * 4); A.out[O_SN + (size_t)(seq * 8 + h) * 256 + tid] = decay * n0S[tid] + ((kw[0] + kw[1]) + (kw[2] + kw[3])); }
    __syncthreads();
}

__device__ __forceinline__ void ssd_sample_item(const Args& A, LAS unsigned char* lds, int item, int tid, int lane, int wave) {
    const int seq = item >> 3, gi = item & 7, hd = gi * 8 + wave;
    LAS float* Cf = (LAS float*)lds; LAS float* Bf = Cf + 512; LAS float* xf = Cf + 1024; LAS float* dtS = Cf + 3072; LAS float* acS = Cf + 3104; LAS float* CBs = Cf + 3136;
    LAS float* xw = Cf + 3200; LAS float* yp = Cf + 5248; LAS float* ssS = Cf + 7296;
    const bf16* XBC = (const bf16*)(A.ws + WS_XBC); const bf16* PROJ = (const bf16*)(A.ws + WS_PROJ); const f32x2* SG = (const f32x2*)(A.ws + WS_SG);
    bf16* MIX = (bf16*)(A.ws + WS_MIX); const float* snorm = A.in[I_SNORM];
    const int rowb = MPR + seq * 4;
    { const int t = tid >> 7, n = tid & 127; const bf16* sp = XBC + (size_t)(rowb + t) * 6144 + 4096 + gi * 128 + n; Bf[t * 128 + n] = bf2f(sp[0]); Cf[t * 128 + n] = bf2f(sp[1024]); }
    { const int idx = tid * 4, t = idx >> 9, cidx = idx & 511; const v2u xv = *(const v2u*)(XBC + (size_t)(rowb + t) * 6144 + gi * 512 + cidx);
      *(LAS f32x4*)(xf + t * 512 + cidx) = (f32x4){bflo(xv.x), bfhi(xv.x), bflo(xv.y), bfhi(xv.y)}; }
    if (tid < 32) { const int hh = tid >> 2, t = tid & 3; const f32x2 sg = SG[(size_t)(rowb + t) * 64 + gi * 8 + hh]; dtS[hh * 4 + t] = sg[0]; acS[hh * 4 + t] = sg[1]; }
    __syncthreads();
#pragma unroll
    for (int e = 0; e < 2; ++e) { const int pp = wave * 2 + e, t = pp >> 2, s = pp & 3;
        float part = Cf[t * 128 + lane] * Bf[s * 128 + lane] + Cf[t * 128 + 64 + lane] * Bf[s * 128 + 64 + lane];
        part = wave_sum(part); if (lane == 0) CBs[pp] = part; }
#pragma unroll
    for (int i = 0; i < 4; ++i) { const int idx = tid + NTHREADS * i, hh = idx >> 8, p = (idx >> 2) & 63, s = idx & 3;
        xw[idx] = xf[s * 512 + hh * 64 + p] * dtS[hh * 4 + s] * __expf(acS[hh * 4 + 3] - acS[hh * 4 + s]); }
    __syncthreads();
    { const int n4 = (lane & 31) * 4, half = lane >> 5; f32x4 c4[4], b4[4];
#pragma unroll
      for (int t = 0; t < 4; ++t) { c4[t] = *(const LAS f32x4*)(Cf + t * 128 + n4); b4[t] = *(const LAS f32x4*)(Bf + t * 128 + n4); }
      const float ea = __expf(acS[wave * 4 + 3]);
      const float* H0 = A.in[I_SSSM] + (size_t)((seq * 64 + hd) * 64) * 128; float* H1 = A.out + O_SSSM + (size_t)((seq * 64 + hd) * 64) * 128; const int hoff = half * 128 + n4;
      f32x4 hbuf[2][8];
#pragma unroll
      for (int r = 0; r < 8; ++r) { const float* rp = H0 + (size_t)(2 * r) * 128; hbuf[0][r] = __builtin_nontemporal_load((const f32x4*)(rp + hoff)); }
#pragma unroll
      for (int bt = 0; bt < 4; ++bt) {
          if (bt < 3) {
#pragma unroll
              for (int r = 0; r < 8; ++r) { const float* rp = H0 + (size_t)(2 * ((bt + 1) * 8 + r)) * 128; hbuf[(bt + 1) & 1][r] = __builtin_nontemporal_load((const f32x4*)(rp + hoff)); } }
#pragma unroll
          for (int r = 0; r < 8; ++r) { const int p = half + 2 * (bt * 8 + r); const f32x4 h4 = hbuf[bt & 1][r];
              const f32x4 xw4 = *(const LAS f32x4*)(xw + (wave * 64 + p) * 4);
              const f32x4 hn = ea * h4 + xw4[0] * b4[0] + xw4[1] * b4[1] + xw4[2] * b4[2] + xw4[3] * b4[3];
              { float* wp = H1 + (size_t)(2 * (bt * 8 + r)) * 128; __builtin_nontemporal_store(hn, (f32x4*)(wp + hoff)); }
              float part[4];
#pragma unroll
              for (int t = 0; t < 4; ++t) { part[t] = (c4[t][0] * h4[0] + c4[t][1] * h4[1]) + (c4[t][2] * h4[2] + c4[t][3] * h4[3]);
                  part[t] = sum32_hi(part[t]); }
              if ((lane & 31) == 31) {
#pragma unroll
                  for (int t = 0; t < 4; ++t) yp[(wave * 4 + t) * 64 + p] = part[t]; } } } }
    __syncthreads();
    { const int p = lane; const float dskip = A.in[I_DSKIP][hd]; float pre[4];
#pragma unroll
      for (int t = 0; t < 4; ++t) { float y = __expf(acS[wave * 4 + t]) * yp[(wave * 4 + t) * 64 + p];
#pragma unroll
          for (int s = 0; s < 4; ++s) if (s <= t) y += CBs[t * 4 + s] * __expf(acS[wave * 4 + t] - acS[wave * 4 + s]) * dtS[wave * 4 + s] * xf[s * 512 + wave * 64 + p];
          y += dskip * xf[t * 512 + wave * 64 + p];
          const int row = rowb + t, col = hd * 64 + p; const float z = bf2f(PROJ[(size_t)row * NPROJ + 16384 + col]); pre[t] = y * silu(z);
          const float ss = wave_sum(pre[t] * pre[t]); if (lane == 0) ssS[wave * 4 + t] = ss; }
      __syncthreads();
#pragma unroll
      for (int t = 0; t < 4; ++t) { float tot = 0.f;
#pragma unroll
          for (int w = 0; w < 8; ++w) tot += ssS[w * 4 + t];
          const float rstd = rsqrtf(tot * (1.f / 512.f) + EPS); const int col = hd * 64 + p;
          MIX[(size_t)(rowb + t) * LDM + 4096 + col] = (bf16)f2bf(pre[t] * rstd * snorm[col]); } }
    __syncthreads();
}


__global__ void __launch_bounds__(NTHREADS, 2) mk_fwd(Args args) {
    extern __shared__ __attribute__((aligned(16))) unsigned char lds_raw[];
    LAS unsigned char* lds = (LAS unsigned char*)lds_raw;
    volatile LAS unsigned* MISC = (volatile LAS unsigned*)(lds + LDSCTL_OFF);
    const int tid = threadIdx.x, lane = tid & 63, wave = __builtin_amdgcn_readfirstlane(tid >> 6);
    const int G = gridDim.x, bid = blockIdx.x;
    const int gw = bid * NWAVES + wave, NGW = G * NWAVES, gt = bid * NTHREADS + tid, NGT = G * NTHREADS;
    unsigned char* ws = args.ws;
    unsigned* ctl = (unsigned*)(ws + WS_CTL);
    if (tid < 64) MISC[tid] = 0u;
    __syncthreads();
    XcdBarrier bar; bar.bar = ctl + CW_BAR; bar.x = 0; bar.st = nullptr;
    if (MK_N_LAUNCHES == 1) bar = xcd_barrier_post(ctl + CW_BAR, MISC + 8);
#define GRID_BAR() do { if (MK_N_LAUNCHES == 1) xcd_barrier(bar); } while (0)
#define Q_NEXT(ctr_, dst_) do { __syncthreads(); if (tid == 0) MISC[16] = atomicAdd((ctr_), 1u); __syncthreads(); (dst_) = (int)MISC[16]; } while (0)
    const int lo = args.ph_lo, hi = args.ph_hi;
#define IN(k) (lo <= (k) && (k) < hi)
#define BOTH(k) (IN(k) && IN((k) + 1))

    if (IN(0)) {
#pragma nounroll
        for (int rep = 0; rep < (PROBE_DUP == 0 ? 2 : 1); ++rep) p0_prologue(args, lds, gw, NGW, lane, wave);
        if (BOTH(0)) GRID_BAR(); }
    if (IN(1)) {
        pg8::Gemm g{(const bf16*)(ws + WS_XN), (const bf16*)(ws + WS_W1T), LDX, LDX, DM}; pg8::Order S; S.init(MTOK / 256, NW1 / 256, G, bid, 0, 0, PROBE_DUP == 1 ? 2 : 1); S.quad = 1;
        pg8::EpiProj E{(bf16*)(ws + WS_PROJ), (float*)(ws + WS_GATES)};
        pg8::gemm_phase<pg8::EpiProj, pg8::Order>(lds, g, S, E);
        if (BOTH(1)) GRID_BAR();
    }
    if (IN(2)) {
        const bf16* PROJ = (const bf16*)(ws + WS_PROJ);
#pragma nounroll
        for (int rep = 0; rep < (PROBE_DUP == 2 ? 2 : 1); ++rep) {
        gate_scans(args, gw, NGW, lane);
        conv_part<4096, 16, true>(PROJ, nullptr, args.in[I_MCW], args.in[I_MCB], (bf16*)(ws + WS_UC), LDX, args.out + O_PMCONV, gt, NGT);
        conv_part<4096, 4, false>(PROJ, args.in[I_MCONV], args.in[I_MCW], args.in[I_MCB], (bf16*)(ws + WS_UC), LDX, args.out + O_SMCONV, gt, NGT);
        conv_part<6144, 16, true>(PROJ + 20480, nullptr, args.in[I_SCW], args.in[I_SCB], (bf16*)(ws + WS_XBC), 6144, args.out + O_PSCONV, gt, NGT);
        conv_part<6144, 4, false>(PROJ + 20480, args.in[I_SCONV], args.in[I_SCW], args.in[I_SCB], (bf16*)(ws + WS_XBC), 6144, args.out + O_SSCONV, gt, NGT); }
        if (BOTH(2)) GRID_BAR();
    }
    if (IN(3)) {
        if (bid == 0 && wave == 0) mlstm_m_carry(args, lane);
        { pg8::Gemm g{(const bf16*)(ws + WS_UC), (const bf16*)(ws + WS_WQK), LDX, LDQ, 512}; pg8::Order S; S.init(MTOK / 256, 16, G, bid, 1, 512, PROBE_DUP == 3 ? 2 : 1);
          pg8::EpiBf16 E{(bf16*)(ws + WS_QK), DM};
          pg8::gemm_phase<pg8::EpiBf16, pg8::Order>(lds, g, S, E); }
        { pg8::Gemm g{(const bf16*)(ws + WS_PB), (const bf16*)(ws + WS_WPT), LDP, LDP, 256}; pg8::Order S; S.init(MTOK / 256, 16, G, bid, 0, 0, PROBE_DUP == 3 ? 2 : 1);
          pg8::EpiBf16 E{(bf16*)(ws + WS_PPB), DM};
          pg8::gemm_phase<pg8::EpiBf16, pg8::Order>(lds, g, S, E); }
        if (BOTH(3)) GRID_BAR();
    }
    if (IN(4)) {
        for (;;) { int it; Q_NEXT(ctl + CW_Q4, it); if (it >= 1024 * (PROBE_DUP == 40 ? 2 : 1)) break; m1_unit(args, lds, it & 1023, tid, lane, wave); }
        for (;;) { int it; Q_NEXT(ctl + CW_Q4 + 64, it); if (it >= 1024 * (PROBE_DUP == 41 ? 2 : 1)) break; s1_unit(args, lds, it & 1023, tid, lane, wave); }
        if (BOTH(4)) GRID_BAR();
    }
    if (IN(5)) {
        if (bid >= G - 32) nscan_item(args, bid - (G - 32), tid);
        if (G == 256) {
            if (bid < 128) { const int x = bid & 7, k = bid >> 3;
                m2_item(args, lds, (x * 4 + (k >> 2)) * 4 + (k & 3), tid, lane, wave);
                s2_item(args, lds, x * 16 + k, tid, lane, wave); }
        } else
        for (;;) { int it; Q_NEXT(ctl + CW_Q5, it); if (it >= 256) break;
            if (it < 128) m2_item(args, lds, it, tid, lane, wave); else s2_item(args, lds, it - 128, tid, lane, wave); }
        for (;;) { int it; Q_NEXT(ctl + CW_Q5 + 64, it); if (it >= 1024 * (PROBE_DUP == 52 ? 2 : 1)) break; mlstm_sample_item(args, lds, it & 1023, tid, lane, wave); }
        for (;;) { int it; Q_NEXT(ctl + CW_Q5 + 128, it); if (it >= 1024 * (PROBE_DUP == 53 ? 2 : 1)) break; ssd_sample_item(args, lds, it & 1023, tid, lane, wave); }
        if (BOTH(5)) GRID_BAR();
    }
    if (IN(6)) {
#pragma nounroll
        for (int rep = 0; rep < (PROBE_DUP == 6 ? 2 : 1); ++rep) { m3_pass(args, gw, NGW, lane); s3_pass(args, gw, NGW, lane); }
        if (BOTH(6)) GRID_BAR();
    }
    if (IN(7)) {
        { pg8::Gemm g{(const bf16*)(ws + WS_MIX), (const bf16*)(ws + WS_W2T), LDM, LDM, 8192}; pg8::Order S; S.init(MPR / 256, 16, G, bid, 0, 0, PROBE_DUP == 7 ? 2 : 1);
          pg8::EpiX1 E{args.in[I_XP], args.in[I_XS], args.in[I_PLENORM], (float*)(ws + WS_X1), (bf16*)(ws + WS_X1G), (float*)(ws + WS_RS1), PROBE_DUP == 7 ? 0.5f : 1.f};
          pg8::gemm_phase<pg8::EpiX1, pg8::Order>(lds, g, S, E); }
        { pg8::Gemm g{(const bf16*)(ws + WS_MIX), (const bf16*)(ws + WS_W2T), LDM, LDM, 1024}; pg8::SplitOrder S{G, bid, MPR / 256, 1024};
          pg8::EpiSlab E{(float*)(ws + WS_SLAB2)};
          pg8::gemm_phase<pg8::EpiSlab, pg8::SplitOrder>(lds, g, S, E); }
        if (BOTH(7)) GRID_BAR();
    }
    if (IN(8)) {
        { const float* SL = (const float*)(ws + WS_SLAB2); const float* gn = args.in[I_PLENORM]; float* X1 = (float*)(ws + WS_X1); bf16* X1G = (bf16*)(ws + WS_X1G); float* RS1 = (float*)(ws + WS_RS1);
          for (int it = gw; it < 512 * 4; it += NGW) { const int rl = it >> 2, qd = it & 3, row = MPR + rl; float ss = 0.f;
#pragma unroll
              for (int j = 0; j < 4; ++j) { const int c = qd * 1024 + j * 256 + lane * 4; f32x4 v = *(const f32x4*)(args.in[I_XS] + (size_t)rl * DM + c);
#pragma unroll
                  for (int ks = 0; ks < 8; ++ks) v += *(const f32x4*)(SL + ((size_t)ks * 512 + rl) * DM + c);
                  *(f32x4*)(X1 + (size_t)row * DM + c) = v; ss += (v[0] * v[0] + v[1] * v[1]) + (v[2] * v[2] + v[3] * v[3]);
                  const f32x4 gv = *(const f32x4*)(gn + c); v2u w; w.x = pk2(v[0] * gv[0], v[1] * gv[1]); w.y = pk2(v[2] * gv[2], v[3] * gv[3]); *(v2u*)(X1G + (size_t)row * LDX + c) = w; }
              ss = wave_sum(ss); if (lane == 0) atomicAdd(RS1 + row, ss); } }
        { pg8::Gemm g{(const bf16*)(ws + WS_X1G), (const bf16*)(ws + WS_WGT), LDX, LDX, DM}; pg8::Order S; S.init(MPR / 256, 16, G, bid, 0, 0, PROBE_DUP == 8 ? 2 : 1);
          pg8::EpiGate E{(const float*)(ws + WS_X1), (const bf16*)(ws + WS_PPB), (const float*)(ws + WS_RS1), args.out + O_Y, (float*)(ws + WS_RS2), PROBE_DUP == 8 ? 0.5f : 1.f};
          pg8::gemm_phase<pg8::EpiGate, pg8::Order>(lds, g, S, E); }
        if (BOTH(8)) GRID_BAR();
    }
    if (IN(9)) {
        pg8::Gemm g{(const bf16*)(ws + WS_X1G), (const bf16*)(ws + WS_WGT), LDX, LDX, 512}; pg8::SplitOrder S{G, bid, MPR / 256, 512};
        pg8::EpiSlab E{(float*)(ws + WS_SLAB3)};
        pg8::gemm_phase<pg8::EpiSlab, pg8::SplitOrder>(lds, g, S, E);
        if (BOTH(9)) GRID_BAR();
    }
    if (IN(10)) {
        const float* RS1 = (const float*)(ws + WS_RS1); const float* RS2 = (const float*)(ws + WS_RS2); const float* fn = args.in[I_FNORM]; float* Y = args.out + O_Y;
        { const float* SL = (const float*)(ws + WS_SLAB3); const float* X1 = (const float*)(ws + WS_X1); const bf16* PP = (const bf16*)(ws + WS_PPB);
          for (int rl = gw; rl < 512; rl += NGW) { const int row = MPR + rl; const float rstd1 = rsqrtf(RS1[row] * (1.f / DM) + EPS); f32x4 x2[16]; float ss = 0.f;
#pragma unroll
              for (int j = 0; j < 16; ++j) { const int c = j * 256 + lane * 4; f32x4 a = *(const f32x4*)(SL + (size_t)rl * DM + c);
#pragma unroll
                  for (int ks = 1; ks < 8; ++ks) a += *(const f32x4*)(SL + ((size_t)ks * 512 + rl) * DM + c);
                  const v2u pw = *(const v2u*)(PP + (size_t)row * DM + c); const f32x4 x1 = *(const f32x4*)(X1 + (size_t)row * DM + c); a = a * rstd1; f32x4 v;
                  v[0] = x1[0] + sigm(a[0]) * bflo(pw.x); v[1] = x1[1] + sigm(a[1]) * bfhi(pw.x); v[2] = x1[2] + sigm(a[2]) * bflo(pw.y); v[3] = x1[3] + sigm(a[3]) * bfhi(pw.y);
                  x2[j] = v; ss += (v[0] * v[0] + v[1] * v[1]) + (v[2] * v[2] + v[3] * v[3]); }
              const float rstd = rsqrtf(wave_sum(ss) * (1.f / DM) + EPS);
#pragma unroll
              for (int j = 0; j < 16; ++j) { const int c = j * 256 + lane * 4; const f32x4 g4 = *(const f32x4*)(fn + c); *(f32x4*)(Y + (size_t)row * DM + c) = x2[j] * rstd * g4; } } }
        for (int i = gt; i < MPR * 1024; i += NGT) { const int row = i >> 10, c4 = (i & 1023) * 4;
            const float rstd = rsqrtf(RS2[row] * (1.f / DM) + EPS);
            const f32x4 g4 = *(const f32x4*)(fn + c4); f32x4 v = *(f32x4*)(Y + (size_t)row * DM + c4);
            v = v * rstd * g4; *(f32x4*)(Y + (size_t)row * DM + c4) = v; }
    }
#undef IN
#undef BOTH
#undef GRID_BAR
}

extern "C" void kernel_launch(void* const* d_in, const int* in_sizes, int n_in, void* d_out, int out_size, void* d_ws, size_t ws_size, hipStream_t stream) {
    static int grid = 0;
    if (grid == 0) {
        if (n_in != N_IN || (size_t)out_size != O_END || ws_size < WS_END) { fprintf(stderr, "kernel_launch: unexpected sizes n_in %d out %d ws %zu\n", n_in, out_size, ws_size); grid = -1; return; }
        int dev = 0, cus = 0, per_cu = 0;
        if (hipGetDevice(&dev) != hipSuccess || hipDeviceGetAttribute(&cus, hipDeviceAttributeMultiprocessorCount, dev) != hipSuccess) { grid = -1; return; }
        if (hipFuncSetAttribute((const void*)mk_fwd, hipFuncAttributeMaxDynamicSharedMemorySize, LDS_BYTES) != hipSuccess) { fprintf(stderr, "kernel_launch: hipFuncSetAttribute failed\n"); grid = -1; return; }
        if (hipOccupancyMaxActiveBlocksPerMultiprocessor(&per_cu, (const void*)mk_fwd, NTHREADS, LDS_BYTES) != hipSuccess || per_cu < 1) { fprintf(stderr, "kernel_launch: occupancy query says %d\n", per_cu); }
        (void)hipGetLastError();
        grid = cus;
    }
    if (grid < 0) return;
    if (hipMemsetAsync((char*)d_ws + WS_CTL, 0, CTL_ZERO_BYTES, stream) != hipSuccess) return;
    Args a{};
    for (int i = 0; i < N_IN; ++i) a.in[i] = (const float*)d_in[i];
    a.out = (float*)d_out; a.ws = (unsigned char*)d_ws;
    constexpr int NPH = 11;
    if (MK_N_LAUNCHES == 1) { a.ph_lo = 0; a.ph_hi = NPH; hipLaunchKernelGGL(mk_fwd, dim3(grid), dim3(NTHREADS), LDS_BYTES, stream, a); }
    else for (int p = 0; p < NPH; ++p) { a.ph_lo = p; a.ph_hi = p + 1; hipLaunchKernelGGL(mk_fwd, dim3(grid), dim3(NTHREADS), LDS_BYTES, stream, a); }
}
```
